# Optimizing an MI355X kernel written in HIP

```python
import math, functools
import jax, jax.numpy as jnp
from jax import lax
import numpy as np


D_MODEL = 2048
BATCH = 2
SEQ = 8192
DEPTH = 4

GRID_W = 64
CTX_LEN = 256
N_MIXERS = 2
N_MOD = 6
MLA_HEADS = 16
MLA_Q_RANK = 512
MLA_KV_RANK = 512
MLA_NOPE = 128
MLA_ROPE = 64
MLA_V = 128
GQA_HEADS = 16
GQA_KV_HEADS = 4
GQA_HEAD_DIM = 128
D_FF = 5632
CONV_W = 3

ROPE_BASE = 10000.0
EPS = 1e-6
Q_BLOCK = 128
N_MLA_LAYERS = (DEPTH + N_MIXERS - 1) // N_MIXERS
N_GQA_LAYERS = DEPTH // N_MIXERS
MLA_SCALE = 1.0 / math.sqrt(MLA_NOPE + MLA_ROPE)
GQA_SCALE = 1.0 / math.sqrt(GQA_HEAD_DIM)

kernel_name = "hybrid_mla_gqa_convffn_dit"


def rms_norm(x, g):
    xf = x.astype(jnp.float32)
    y = xf * lax.rsqrt(jnp.mean(xf * xf, axis=-1, keepdims=True) + EPS)
    return (y * g.astype(jnp.float32)).astype(x.dtype)


def modulate(x, g, shift, scale):
    return rms_norm(x, g) * (1.0 + scale) + shift


def axial_rope_tables(rows, cols, rot_dim):
    axis_dim = rot_dim // 2
    inv = jnp.power(ROPE_BASE, -jnp.arange(0, axis_dim, 2, dtype=jnp.float32) / axis_dim)
    ang_r = rows.astype(jnp.float32)[:, None] * inv
    ang_c = cols.astype(jnp.float32)[:, None] * inv
    ang = jnp.concatenate([ang_r, ang_r, ang_c, ang_c], axis=-1)
    return jnp.cos(ang), jnp.sin(ang)


def rotate_half(x):
    x1, x2 = jnp.split(x, 2, axis=-1)
    return jnp.concatenate([-x2, x1], axis=-1)


def apply_axial_rope(x, cos, sin):
    half = x.shape[-1] // 2
    rot = jnp.concatenate([rotate_half(x[..., :half]), rotate_half(x[..., half:])], axis=-1)
    return (x * cos[:, None, :] + rot * sin[:, None, :]).astype(x.dtype)


def attend(q, k, v, scale):
    B, Q, H, Dq = q.shape
    Hk = k.shape[2]
    qg = q.reshape(B, Q, Hk, H // Hk, Dq)
    s = jnp.einsum("bqkgd,btkd->bkgqt", qg, k, preferred_element_type=jnp.float32) * scale
    p = jax.nn.softmax(s, axis=-1)
    o = jnp.einsum("bkgqt,btkd->bqkgd", p.astype(v.dtype), v, preferred_element_type=jnp.float32)
    return o.reshape(B, Q, H, v.shape[-1]).astype(q.dtype)


def blocked_attention(q, k, v, scale):
    B, S, H, Dq = q.shape
    nb = S // Q_BLOCK
    qs = q.reshape(B, nb, Q_BLOCK, H, Dq).swapaxes(0, 1)
    o = lax.map(lambda qb: attend(qb, k, v, scale), qs)
    return o.swapaxes(0, 1).reshape(B, S, H, v.shape[-1])


def mla_queries(h, rope, w_dq, g_dq, w_uq, g_q_nope, g_q_pe):
    B, S, _ = h.shape
    cq = rms_norm(h @ w_dq, g_dq)
    q = (cq @ w_uq).reshape(B, S, MLA_HEADS, MLA_NOPE + MLA_ROPE)
    q_nope = rms_norm(q[..., :MLA_NOPE], g_q_nope)
    q_pe = rms_norm(q[..., MLA_NOPE:], g_q_pe)
    if rope is not None:
        q_pe = apply_axial_rope(q_pe, *rope)
    return jnp.concatenate([q_nope, q_pe], axis=-1)


def mla_keys_values(h, rope, w_dkv, g_dkv, g_k_pe, w_ukv, g_k_nope):
    B, S, _ = h.shape
    kv_a = h @ w_dkv
    c_kv = rms_norm(kv_a[..., :MLA_KV_RANK], g_dkv)
    k_pe = rms_norm(kv_a[..., MLA_KV_RANK:], g_k_pe)[:, :, None, :]
    if rope is not None:
        k_pe = apply_axial_rope(k_pe, *rope)
    kv = (c_kv @ w_ukv).reshape(B, S, MLA_HEADS, MLA_NOPE + MLA_V)
    k_nope = rms_norm(kv[..., :MLA_NOPE], g_k_nope)
    v = kv[..., MLA_NOPE:]
    k = jnp.concatenate([k_nope, jnp.broadcast_to(k_pe, (B, S, MLA_HEADS, MLA_ROPE))], axis=-1)
    return k, v


def gqa_queries(h, rope, w_q, g_q):
    B, S, _ = h.shape
    q = rms_norm((h @ w_q).reshape(B, S, GQA_HEADS, GQA_HEAD_DIM), g_q)
    if rope is not None:
        q = apply_axial_rope(q, *rope)
    return q


def gqa_keys_values(h, rope, w_kv, g_k):
    B, S, _ = h.shape
    kv = (h @ w_kv).reshape(B, S, 2, GQA_KV_HEADS, GQA_HEAD_DIM)
    k = rms_norm(kv[:, :, 0], g_k)
    v = kv[:, :, 1]
    if rope is not None:
        k = apply_axial_rope(k, *rope)
    return k, v


def depthwise_conv_centred(u, w, b):
    S = u.shape[1]
    pad = CONV_W // 2
    up = jnp.pad(u, ((0, 0), (pad, pad), (0, 0)))
    return sum(up[:, k:k + S] * w[k] for k in range(CONV_W)) + b


def conv_ffn(h, w_up, conv_w, conv_b, w_down):
    u = h @ w_up
    gate, val = u[..., :D_FF], u[..., D_FF:]
    gate = depthwise_conv_centred(gate, conv_w, conv_b)
    return (jax.nn.silu(gate) * val) @ w_down


def setup_inputs(seed: int = 0) -> dict:
    key = jax.random.key(seed)
    ks = iter(jax.random.split(key, 40))
    D, L, LA, LB = D_MODEL, DEPTH, N_MLA_LAYERS, N_GQA_LAYERS

    def nrm(shape, scale):
        return jax.random.normal(next(ks), shape, jnp.float32) * scale

    def gain(shape):
        return 1.0 + nrm(shape, 0.02)

    return {
        "x": nrm((BATCH, SEQ, D), 1.0),
        "c": nrm((BATCH, D), 1.0),
        "ctx": nrm((BATCH, CTX_LEN, D), 1.0),
        "c_ctx": nrm((D,), 1.0),
        "w_mod": nrm((L, D, N_MOD * D), 0.5 * D ** -0.5),
        "b_mod": nrm((L, N_MOD * D), 0.01),
        "norm_mix": gain((L, D)),
        "norm_ffn": gain((L, D)),
        "mla_w_dq": nrm((LA, D, MLA_Q_RANK), D ** -0.5),
        "mla_g_dq": gain((LA, MLA_Q_RANK)),
        "mla_w_uq": nrm((LA, MLA_Q_RANK, MLA_HEADS * (MLA_NOPE + MLA_ROPE)), MLA_Q_RANK ** -0.5),
        "mla_g_q_nope": gain((LA, MLA_NOPE)),
        "mla_g_q_pe": gain((LA, MLA_ROPE)),
        "mla_w_dkv": nrm((LA, D, MLA_KV_RANK + MLA_ROPE), D ** -0.5),
        "mla_g_dkv": gain((LA, MLA_KV_RANK)),
        "mla_g_k_pe": gain((LA, MLA_ROPE)),
        "mla_w_ukv": nrm((LA, MLA_KV_RANK, MLA_HEADS * (MLA_NOPE + MLA_V)), MLA_KV_RANK ** -0.5),
        "mla_g_k_nope": gain((LA, MLA_NOPE)),
        "mla_w_o": nrm((LA, MLA_HEADS * MLA_V, D), (MLA_HEADS * MLA_V) ** -0.5),
        "gqa_w_q": nrm((LB, D, GQA_HEADS * GQA_HEAD_DIM), D ** -0.5),
        "gqa_g_q": gain((LB, GQA_HEAD_DIM)),
        "gqa_w_kv": nrm((LB, D, 2 * GQA_KV_HEADS * GQA_HEAD_DIM), D ** -0.5),
        "gqa_g_k": gain((LB, GQA_HEAD_DIM)),
        "gqa_w_o": nrm((LB, GQA_HEADS * GQA_HEAD_DIM, D), (GQA_HEADS * GQA_HEAD_DIM) ** -0.5),
        "ffn_w_up": nrm((L, D, 2 * D_FF), D ** -0.5),
        "ffn_conv_w": nrm((L, CONV_W, D_FF), CONV_W ** -0.5),
        "ffn_conv_b": nrm((L, D_FF), 0.01),
        "ffn_w_down": nrm((L, D_FF, D), D_FF ** -0.5),
    }


def reference(x, c, ctx, c_ctx, w_mod, b_mod, norm_mix, norm_ffn,
              mla_w_dq, mla_g_dq, mla_w_uq, mla_g_q_nope, mla_g_q_pe,
              mla_w_dkv, mla_g_dkv, mla_g_k_pe, mla_w_ukv, mla_g_k_nope, mla_w_o,
              gqa_w_q, gqa_g_q, gqa_w_kv, gqa_g_k, gqa_w_o,
              ffn_w_up, ffn_conv_w, ffn_conv_b, ffn_w_down):
    B, S, _ = x.shape
    C = ctx.shape[1]
    ROWS = S // GRID_W
    rows = jnp.repeat(jnp.arange(ROWS, dtype=jnp.int32), GRID_W)
    cols = jnp.tile(jnp.arange(GRID_W, dtype=jnp.int32), ROWS)
    rope_mla = axial_rope_tables(rows, cols, MLA_ROPE)
    rope_gqa = axial_rope_tables(rows, cols, GQA_HEAD_DIM)
    silu_c = jax.nn.silu(c)
    silu_cc = jax.nn.silu(c_ctx)

    for i in range(DEPTH):
        last = i == DEPTH - 1
        j = i // N_MIXERS
        mod = (silu_c @ w_mod[i] + b_mod[i])[:, None, :]
        mod_c = silu_cc @ w_mod[i] + b_mod[i]
        sh1, sc1, g1, sh2, sc2, g2 = jnp.split(mod, N_MOD, axis=-1)
        csh1, csc1, cg1, csh2, csc2, cg2 = jnp.split(mod_c, N_MOD, axis=-1)

        h = modulate(x, norm_mix[i], sh1, sc1)
        hc = modulate(ctx, norm_mix[i], csh1, csc1)
        if i % N_MIXERS == 0:
            q_fn = functools.partial(mla_queries, w_dq=mla_w_dq[j], g_dq=mla_g_dq[j], w_uq=mla_w_uq[j],
                                     g_q_nope=mla_g_q_nope[j], g_q_pe=mla_g_q_pe[j])
            kv_fn = functools.partial(mla_keys_values, w_dkv=mla_w_dkv[j], g_dkv=mla_g_dkv[j],
                                      g_k_pe=mla_g_k_pe[j], w_ukv=mla_w_ukv[j], g_k_nope=mla_g_k_nope[j])
            w_o, rope, scale = mla_w_o[j], rope_mla, MLA_SCALE
        else:
            q_fn = functools.partial(gqa_queries, w_q=gqa_w_q[j], g_q=gqa_g_q[j])
            kv_fn = functools.partial(gqa_keys_values, w_kv=gqa_w_kv[j], g_k=gqa_g_k[j])
            w_o, rope, scale = gqa_w_o[j], rope_gqa, GQA_SCALE

        k_lat, v_lat = kv_fn(h, rope)
        k_ctx, v_ctx = kv_fn(hc, None)
        o = blocked_attention(q_fn(h, rope),
                              jnp.concatenate([k_lat, k_ctx], axis=1),
                              jnp.concatenate([v_lat, v_ctx], axis=1), scale)
        x = x + g1 * (o.reshape(B, S, -1) @ w_o)
        if not last:
            oc = attend(q_fn(hc, None), k_ctx, v_ctx, scale)
            ctx = ctx + cg1 * (oc.reshape(B, C, -1) @ w_o)

        x = x + g2 * conv_ffn(modulate(x, norm_ffn[i], sh2, sc2),
                              ffn_w_up[i], ffn_conv_w[i], ffn_conv_b[i], ffn_w_down[i])
        if not last:
            ctx = ctx + cg2 * conv_ffn(modulate(ctx, norm_ffn[i], csh2, csc2),
                                       ffn_w_up[i], ffn_conv_w[i], ffn_conv_b[i], ffn_w_down[i])
    return x
```

```cpp
#include <hip/hip_runtime.h>
#include <cstdio>
#include <cstdint>
namespace pg8 {
#define PG8_LAS __attribute__((address_space(3)))
typedef unsigned short bf16_t;
typedef short bf16x8 __attribute__((ext_vector_type(8)));
typedef float f32x4 __attribute__((ext_vector_type(4)));
typedef unsigned u32x4 __attribute__((ext_vector_type(4)));
typedef unsigned u32x2 __attribute__((ext_vector_type(2)));
typedef int v8i_t __attribute__((ext_vector_type(8)));
struct Frag2 { v8i_t w;
    __device__ __forceinline__ void ld(PG8_LAS unsigned char* p) { typedef int v4i_t __attribute__((ext_vector_type(4))); const v4i_t a = *(const PG8_LAS v4i_t*)p, b = *(const PG8_LAS v4i_t*)(p + 1024); w = (v8i_t){a[0], a[1], a[2], a[3], b[0], b[1], b[2], b[3]}; }
    __device__ __forceinline__ bf16x8 k0() const { typedef int v4i_t __attribute__((ext_vector_type(4))); const v4i_t a = {w[0], w[1], w[2], w[3]}; return __builtin_bit_cast(bf16x8, a); }
    __device__ __forceinline__ bf16x8 k1() const { typedef int v4i_t __attribute__((ext_vector_type(4))); const v4i_t a = {w[4], w[5], w[6], w[7]}; return __builtin_bit_cast(bf16x8, a); } };
__device__ __forceinline__ v8i_t pg8_cat(bf16x8 lo, bf16x8 hi) { typedef int v4i_t __attribute__((ext_vector_type(4))); const v4i_t a = __builtin_bit_cast(v4i_t, lo), b = __builtin_bit_cast(v4i_t, hi); return (v8i_t){a[0], a[1], a[2], a[3], b[0], b[1], b[2], b[3]}; }
constexpr int BM = 256, BK = 64, HALF = 128, HTB = HALF * BK * 2  , STAGE_BYTES = 8 * HTB, NXCD = 8, WGM = 8;

__host__ __device__ __forceinline__ int lds_byte(int r, int c) { const int st = (r >> 4) * 2 + (c >> 5), rr = r & 15, cc = c & 31, ob = rr * 64 + cc * 2; return st * 1024 + (ob ^ (((ob >> 9) & 1) << 5)); }
__host__ __device__ __forceinline__ void stage_rc(int b, int& R, int& C) { const int st = b / 1024, sb = b % 1024, swz = sb ^ (((sb >> 9) & 1) << 5); R = (st >> 1) * 16 + swz / 64; C = (st & 1) * 32 + (swz % 64) / 2; }
__host__ __device__ __forceinline__ int perm32(int rho) { const int n = rho >> 4, i = rho & 15; return 8 * (i >> 2) + 4 * n + (i & 3); }

struct Unit { int pm, pn, kt0, nkt; };
struct Gemm { const bf16_t* A; const bf16_t* Bt; int M, N, K; int sa, sb; };

struct StaticOrder {
    int nM, nN, nwg, G, c;
    __host__ __device__ void init(int M, int N, int G_, int c_) { nM = M / BM; nN = N / BM; nwg = nM * nN; G = G_; c = c_; }
    __host__ __device__ bool next(int i, Unit& u) const {
        const int L = i * G + c; if (L >= nwg) return false;
        int wgid = L; { const int q = nwg / NXCD, r = nwg % NXCD, xcd = wgid % NXCD, off = wgid / NXCD; wgid = (xcd < r ? xcd * (q + 1) : r * (q + 1) + (xcd - r) * q) + off; }
        const int nig = WGM * nN, gid = wgid / nig, fm = gid * WGM, gsz = (nM - fm) < WGM ? (nM - fm) : WGM;
        u.pm = fm + ((wgid % nig) % gsz); u.pn = (wgid % nig) / gsz; return true;
    }
    __device__ __forceinline__ void a_ready(const Unit&) const {}
    __device__ __forceinline__ void done(const Unit&) const {}
};
__device__ __forceinline__ unsigned cvt_pk_bf16(float lo, float hi) { unsigned r; asm volatile("v_cvt_pk_bf16_f32 %0, %1, %2" : "=v"(r) : "v"(lo), "v"(hi)); return r; }
__device__ __forceinline__ void row_scales(const float* stat, const Unit& u, int wr, int fr, float (&r)[2][4]) {
#pragma unroll
    for (int ai = 0; ai < 2; ++ai)
#pragma unroll
        for (int m = 0; m < 4; ++m) r[ai][m] = stat ? __builtin_amdgcn_rsqf(stat[u.pm * BM + ai * HALF + wr * 64 + m * 16 + fr] * (1.0f / 2048.0f) + 1e-6f) : 1.0f;
}
__device__ __forceinline__ int panel_variant(const Unit& u) { const int b = u.pm / 33; return (u.pm - b * 33) == 32 ? 2 : b; }
constexpr int CBN_ = 11264;
struct EpiF32 {
    static constexpr bool PERM = false, AFTER_DRAIN = false;
    float* C; int ldc; const float* stat; const float* cb;
    __device__ __forceinline__ void operator()(const f32x4 (&acc)[2][2][4][2], const Unit& u, int wr, int wc, int fr, int fq) const {
        const int row0 = u.pm * BM + wr * 64 + fr, col0 = u.pn * BM + wc * 32 + 4 * fq;
        float r[2][4]; row_scales(stat, u, wr, fr, r);
        f32x4 cv[2][2];
#pragma unroll
        for (int bj = 0; bj < 2; ++bj)
#pragma unroll
            for (int n = 0; n < 2; ++n) cv[bj][n] = stat ? *(const f32x4*)(cb + (size_t)panel_variant(u) * CBN_ + col0 + bj * HALF + n * 16) : (f32x4){0.f, 0.f, 0.f, 0.f};
#pragma unroll
        for (int ai = 0; ai < 2; ++ai)
#pragma unroll
            for (int m = 0; m < 4; ++m) { float* rowp = C + (size_t)(row0 + ai * HALF + m * 16) * ldc + col0;
#pragma unroll
                for (int bj = 0; bj < 2; ++bj)
#pragma unroll
                    for (int n = 0; n < 2; ++n) *(f32x4*)(rowp + bj * HALF + n * 16) = acc[ai][bj][m][n] * r[ai][m] + cv[bj][n]; }
    }
};
struct EpiBf16 {
    static constexpr bool PERM = true, AFTER_DRAIN = false;
    bf16_t* O; int ldc; const float* stat; const float* cb;
    __device__ __forceinline__ void operator()(const f32x4 (&acc)[2][2][4][2], const Unit& u, int wr, int wc, int fr, int fq) const {
        const int row0 = u.pm * BM + wr * 64 + fr, col0 = u.pn * BM + wc * 32 + 8 * fq;
        float r[2][4]; row_scales(stat, u, wr, fr, r);
        f32x4 cv[2][2];
#pragma unroll
        for (int bj = 0; bj < 2; ++bj)
#pragma unroll
            for (int n = 0; n < 2; ++n) cv[bj][n] = stat ? *(const f32x4*)(cb + (size_t)panel_variant(u) * CBN_ + col0 + bj * HALF + 4 * n) : (f32x4){0.f, 0.f, 0.f, 0.f};
#pragma unroll
        for (int ai = 0; ai < 2; ++ai)
#pragma unroll
            for (int m = 0; m < 4; ++m) { bf16_t* rowp = O + (size_t)(row0 + ai * HALF + m * 16) * ldc + col0;
#pragma unroll
                for (int bj = 0; bj < 2; ++bj) { const f32x4 v0 = acc[ai][bj][m][0] * r[ai][m] + cv[bj][0], v1 = acc[ai][bj][m][1] * r[ai][m] + cv[bj][1];
                    u32x4 w; w.x = cvt_pk_bf16(v0[0], v0[1]); w.y = cvt_pk_bf16(v0[2], v0[3]); w.z = cvt_pk_bf16(v1[0], v1[1]); w.w = cvt_pk_bf16(v1[2], v1[3]);
                    *(u32x4*)(rowp + bj * HALF) = w; } }
    }
};
__device__ __forceinline__ float dpp_ror1(float v) { return __builtin_bit_cast(float, __builtin_amdgcn_update_dpp(0, __builtin_bit_cast(int, v), 0x121, 0xf, 0xf, false)); }
__device__ __forceinline__ float dpp_rol1(float v) { return __builtin_bit_cast(float, __builtin_amdgcn_update_dpp(0, __builtin_bit_cast(int, v), 0x12f, 0xf, 0xf, false)); }
struct EpiConv {
    static constexpr bool PERM = true, AFTER_DRAIN = false;
    bf16_t* ACT; float* GH; float* VH; const float* cw; const float* cb; const float* stat; const float* cvec;
    __device__ __forceinline__ void operator()(const f32x4 (&acc_)[2][2][4][2], const Unit& u, int wr, int wc, int fr, int fq) const {
        constexpr int FF = 5632;
        const int f0 = u.pn * 128 + wc * 32 + 8 * fq;
        f32x4 acc[2][2][4][2];
        { float r[2][4]; row_scales(stat, u, wr, fr, r); const float* cp = cvec + (size_t)panel_variant(u) * CBN_ + u.pn * BM + wc * 32 + 8 * fq;
#pragma unroll
          for (int bj = 0; bj < 2; ++bj)
#pragma unroll
            for (int n = 0; n < 2; ++n) { const f32x4 cv = *(const f32x4*)(cp + bj * HALF + 4 * n);
#pragma unroll
              for (int ai = 0; ai < 2; ++ai)
#pragma unroll
                for (int m = 0; m < 4; ++m) acc[ai][bj][m][n] = acc_[ai][bj][m][n] * r[ai][m] + cv; } }
        float w0[8], w1[8], w2[8], bb[8];
#pragma unroll
        for (int h = 0; h < 2; ++h) { const f32x4 a = *(const f32x4*)(cw + f0 + 4 * h), b = *(const f32x4*)(cw + FF + f0 + 4 * h), c = *(const f32x4*)(cw + 2 * FF + f0 + 4 * h), d = *(const f32x4*)(cb + f0 + 4 * h);
#pragma unroll
            for (int i = 0; i < 4; ++i) { w0[4 * h + i] = a[i]; w1[4 * h + i] = b[i]; w2[4 * h + i] = c[i]; bb[4 * h + i] = d[i]; } }
#pragma unroll
        for (int ai = 0; ai < 2; ++ai) {
            const int sid = u.pm * 4 + ai * 2 + wr, row0 = u.pm * BM + ai * HALF + wr * 64 + fr;
#pragma unroll
            for (int m = 0; m < 4; ++m) {
                float o[8];
#pragma unroll
                for (int i = 0; i < 8; ++i) {
                    const float g = acc[ai][0][m][i >> 2][i & 3], v = acc[ai][1][m][i >> 2][i & 3];
                    const float pa = dpp_ror1(g), pb = m > 0 ? dpp_ror1(acc[ai][0][m > 0 ? m - 1 : 0][i >> 2][i & 3]) : 0.f;
                    const float na = dpp_rol1(g), nb = m < 3 ? dpp_rol1(acc[ai][0][m < 3 ? m + 1 : 3][i >> 2][i & 3]) : 0.f;
                    const float pv = fr == 0 ? pb : pa, nx = fr == 15 ? nb : na;
                    const float a = fmaf(w0[i], pv, fmaf(w1[i], g, fmaf(w2[i], nx, bb[i])));
                    o[i] = a * __builtin_amdgcn_rcpf(1.f + __builtin_amdgcn_exp2f(a * -1.4426950408889634f)) * v;
                }
                const bool edge = (m == 0 && fr == 0) || (m == 3 && fr == 15);
                if (!edge) { u32x4 w; w.x = cvt_pk_bf16(o[0], o[1]); w.y = cvt_pk_bf16(o[2], o[3]); w.z = cvt_pk_bf16(o[4], o[5]); w.w = cvt_pk_bf16(o[6], o[7]);
                    *(u32x4*)(ACT + (size_t)(row0 + m * 16) * FF + f0) = w; }
                if (m == 0 && fr < 2) { float* p = GH + ((size_t)sid * 4 + fr) * FF + f0; *(f32x4*)p = acc[ai][0][0][0]; *(f32x4*)(p + 4) = acc[ai][0][0][1]; }
                if (m == 3 && fr >= 14) { float* p = GH + ((size_t)sid * 4 + 2 + (fr - 14)) * FF + f0; *(f32x4*)p = acc[ai][0][3][0]; *(f32x4*)(p + 4) = acc[ai][0][3][1]; }
                if (m == 0 && fr == 0) { float* p = VH + ((size_t)sid * 2) * FF + f0; *(f32x4*)p = acc[ai][1][0][0]; *(f32x4*)(p + 4) = acc[ai][1][0][1]; }
                if (m == 3 && fr == 15) { float* p = VH + ((size_t)sid * 2 + 1) * FF + f0; *(f32x4*)p = acc[ai][1][3][0]; *(f32x4*)(p + 4) = acc[ai][1][3][1]; }
            }
        }
    }
};
struct EpiRes {
    static constexpr bool PERM = true, AFTER_DRAIN = false;
    const float* base; float* out; const float* gates; int to_out; float* part; int nkt_full;
    bf16_t* XS; const float* av; float* stat; unsigned char* XS8;
    __device__ __forceinline__ void operator()(const f32x4 (&acc)[2][2][4][2], const Unit& u, int wr, int wc, int fr, int fq) const {
        const int b = u.pm / 33, isctx = (u.pm - b * 33) == 32, v = isctx ? 2 : b;
        const float* g = gates + (size_t)v * 12288;
        const int row0 = u.pm * BM + wr * 64 + fr, col0 = u.pn * BM + wc * 32 + 8 * fq;
        const int orow0 = to_out ? row0 - 256 * b : row0;
        if (u.nkt != nkt_full) {
            float* pp = part + ((size_t)(u.kt0 / u.nkt) * 512 + 256 * b + wr * 64 + fr) * 2048 + u.pn * BM + wc * 32 + 8 * fq;
#pragma unroll
            for (int bj = 0; bj < 2; ++bj)
#pragma unroll
                for (int n = 0; n < 2; ++n) { const f32x4 gvv = *(const f32x4*)(g + col0 + bj * HALF + n * 4);
#pragma unroll
                    for (int ai = 0; ai < 2; ++ai)
#pragma unroll
                        for (int m = 0; m < 4; ++m) *(f32x4*)(pp + (size_t)(ai * HALF + m * 16) * 2048 + bj * HALF + n * 4) = gvv * acc[ai][bj][m][n]; }
            return;
        }
        f32x4 gv[2][2], aw[2][2];
#pragma unroll
        for (int bj = 0; bj < 2; ++bj)
#pragma unroll
            for (int n = 0; n < 2; ++n) { gv[bj][n] = *(const f32x4*)(g + col0 + bj * HALF + n * 4); aw[bj][n] = stat ? *(const f32x4*)(av + (size_t)v * 2048 + col0 + bj * HALF + n * 4) : (f32x4){0.f, 0.f, 0.f, 0.f}; }
        const int lane = fq * 16 + fr;
#pragma unroll
        for (int ai = 0; ai < 2; ++ai)
#pragma unroll
            for (int m = 0; m < 4; ++m) { const float* bp = base + (size_t)(row0 + ai * HALF + m * 16) * 2048 + col0; float* op = out + (size_t)(orow0 + ai * HALF + m * 16) * 2048 + col0;
                bf16_t* xp = XS + (size_t)(row0 + ai * HALF + m * 16) * 2048 + col0; float ss = 0.f;
#pragma unroll
                for (int bj = 0; bj < 2; ++bj) { f32x4 xx[2];
#pragma unroll
                    for (int n = 0; n < 2; ++n) { xx[n] = *(const f32x4*)(bp + bj * HALF + n * 4) + gv[bj][n] * acc[ai][bj][m][n]; *(f32x4*)(op + bj * HALF + n * 4) = xx[n]; }
                    if (stat) { ss += ((xx[0][0] * xx[0][0] + xx[0][1] * xx[0][1]) + (xx[0][2] * xx[0][2] + xx[0][3] * xx[0][3])) + ((xx[1][0] * xx[1][0] + xx[1][1] * xx[1][1]) + (xx[1][2] * xx[1][2] + xx[1][3] * xx[1][3]));
                        const f32x4 y0 = xx[0] * aw[bj][0], y1 = xx[1] * aw[bj][1];
                        u32x4 w; w.x = cvt_pk_bf16(y0[0], y0[1]); w.y = cvt_pk_bf16(y0[2], y0[3]); w.z = cvt_pk_bf16(y1[0], y1[1]); w.w = cvt_pk_bf16(y1[2], y1[3]); *(u32x4*)(xp + bj * HALF) = w;
                        if (XS8) { u32x2 w8; int t_ = 0; t_ = __builtin_amdgcn_cvt_pk_fp8_f32(y0[0], y0[1], t_, false); t_ = __builtin_amdgcn_cvt_pk_fp8_f32(y0[2], y0[3], t_, true); w8.x = (unsigned)t_; t_ = 0; t_ = __builtin_amdgcn_cvt_pk_fp8_f32(y1[0], y1[1], t_, false); t_ = __builtin_amdgcn_cvt_pk_fp8_f32(y1[2], y1[3], t_, true); w8.y = (unsigned)t_;
                            *(u32x2*)(XS8 + (size_t)(row0 + ai * HALF + m * 16) * 2048 + col0 + bj * HALF) = w8; } } }
                if (stat) {
                    ss += __builtin_bit_cast(float, __builtin_amdgcn_ds_bpermute((lane ^ 16) << 2, __builtin_bit_cast(int, ss)));
                    ss += __builtin_bit_cast(float, __builtin_amdgcn_ds_bpermute((lane ^ 32) << 2, __builtin_bit_cast(int, ss)));
                    if (fq == 0) unsafeAtomicAdd(stat + row0 + ai * HALF + m * 16, ss); } }
    }
};
struct PanelOrder : StaticOrder {
    int skip, nkt_full;
    __device__ void init2(int N, int K, int G_, int c_, int skip_) { skip = skip_; nkt_full = K / BK; init(skip_ ? 16384 : 16896, N, G_, c_); }
    __device__ __forceinline__ bool next(int i, Unit& u) const { Unit a; a.pm = 0; a.pn = 0; const bool ok = StaticOrder::next(i, a); u.pm = (skip && a.pm >= 32) ? a.pm + 1 : a.pm; u.pn = a.pn; u.kt0 = 0; u.nkt = nkt_full; return ok; }
};
struct ResOrder : StaticOrder {
    int nsplit, nkt_full;
    __device__ void init2(int K, int G_, int c_, int nsplit_) { nsplit = nsplit_; nkt_full = K / BK; init(16384, 2048, G_, c_); }
    __device__ __forceinline__ bool next(int i, Unit& u) const {
        const int L = i * G + c;
        Unit a; a.pm = 0; a.pn = 0; const bool lat = StaticOrder::next(i, a);
        const int m = L - nwg, cu = m & 15, s = m >> 4, nk = nsplit > 0 ? nkt_full / nsplit : nkt_full;
        const int pm = lat ? (a.pm >= 32 ? a.pm + 1 : a.pm) : ((cu >> 3) ? 65 : 32), pn = lat ? a.pn : (cu & 7);
        u.pm = pm; u.pn = pn; u.kt0 = lat ? 0 : s * nk; u.nkt = lat ? nkt_full : nk;
        return lat || m < 16 * nsplit;
    }
};

template <class Epi, class Sched, bool ALIGN_EPI = false, bool SP2 = false, bool F8 = false>
__device__ __forceinline__ void gemm_phase(PG8_LAS unsigned char* lds, const Gemm g, const Sched& S, const Epi& E, int wave_in) {
    int tid_; asm volatile("v_mbcnt_lo_u32_b32 %0, -1, 0\n\tv_mbcnt_hi_u32_b32 %0, -1, %0" : "=&v"(tid_)); tid_ |= wave_in << 6;
    const int tid = tid_, wid = __builtin_amdgcn_readfirstlane(tid >> 6), lane = tid & 63, wr = wid >> 2, wc = wid & 3, fr = lane & 15, fq = lane >> 4;
    const int K = g.K;
    unsigned voffA[2], voffB[2];
#pragma unroll
    for (int i = 0; i < 2; ++i) { int R, C; stage_rc(tid * 16 + i * 8192, R, C); const int Rb = Epi::PERM ? ((R & ~31) + perm32(R & 31)) : R;
        voffA[i] = (unsigned)(R * K + C) * 2u; voffB[i] = (unsigned)(Rb * K + C) * 2u; }
    const size_t kstep = (size_t)(BK * 2);
    const size_t hstep = (size_t)HALF * K * 2;
    const size_t tstep = 2 * hstep;
    const unsigned ldsw = (unsigned)wid * 1024u;
    const int aoff = lds_byte(wr * 64 + fr, fq * 8), boff = lds_byte(wc * 32 + fr, fq * 8);
#define PG8_SA(b, h) (((b) * 2 + (h)) * HTB)
#define PG8_SB(b, h) ((4 + (b) * 2 + (h)) * HTB)
#define PG8_STAGE(bufoff, gbase, voff) do { _Pragma("unroll") for (int _i = 0; _i < 2; ++_i) \
        __builtin_amdgcn_global_load_lds((const unsigned*)((const char*)(gbase) + (voff)[_i]), (PG8_LAS unsigned*)(lds + (bufoff) + ldsw + _i * 8192), 16, 0, 0); } while (0)
#define PG8_LDA(dst, b, h) do { _Pragma("unroll") for (int m = 0; m < 4; ++m) dst[m].ld(lds + PG8_SA(b, h) + aoff + m * 2048); } while (0)
#define PG8_LDB(dst, b, h) do { _Pragma("unroll") for (int n = 0; n < 2; ++n) dst[n].ld(lds + PG8_SB(b, h) + boff + n * 2048); } while (0)
#define PG8_MMA(ai, bj, At, Bt) do { __builtin_amdgcn_s_setprio(1); _Pragma("unroll") for (int m = 0; m < 4; ++m) _Pragma("unroll") for (int n = 0; n < 2; ++n) { \
        if constexpr (F8) {     \
              \
            asm volatile("v_mfma_scale_f32_16x16x128_f8f6f4 %0, %1, %2, %0, %3, %4 op_sel_hi:[0,0,0]" : "+v"(acc[ai][bj][m][n]) : "v"(Bt[n].w), "v"(At[m].w), "v"(g.sa), "v"(g.sb)); \
        } else { acc[ai][bj][m][n] = __builtin_amdgcn_mfma_f32_16x16x32_bf16(Bt[n].k0(), At[m].k0(), acc[ai][bj][m][n], 0, 0, 0); \
                 acc[ai][bj][m][n] = __builtin_amdgcn_mfma_f32_16x16x32_bf16(Bt[n].k1(), At[m].k1(), acc[ai][bj][m][n], 0, 0, 0); } } \
        __builtin_amdgcn_s_setprio(0); } while (0)
#define PG8_WAIT_V(n) asm volatile("s_waitcnt vmcnt(" #n ")" ::: "memory")
#define PG8_WAIT_L(n) asm volatile("s_waitcnt lgkmcnt(" #n ")" ::: "memory")
#define PG8_BAR __builtin_amdgcn_s_barrier()
#define PG8_SCHED __builtin_amdgcn_sched_barrier(0)
    Unit cur, nxt; int ui = 0;
    if (!S.next(0, cur)) return;
    f32x4 acc[2][2][4][2];
#pragma unroll
    for (int a = 0; a < 2; ++a)
#pragma unroll
        for (int b = 0; b < 2; ++b)
#pragma unroll
            for (int m = 0; m < 4; ++m)
#pragma unroll
                for (int n = 0; n < 2; ++n) acc[a][b][m][n] = (f32x4){0.f, 0.f, 0.f, 0.f};
    Frag2 At[4], B0[2], B1[2];
    const char* cA = (const char*)g.A + (size_t)cur.pm * tstep + (size_t)cur.kt0 * kstep; const char* cB = (const char*)g.Bt + (size_t)cur.pn * tstep + (size_t)cur.kt0 * kstep;
    S.a_ready(cur);
    if constexpr (SP2) {
        PG8_STAGE(PG8_SB(0, 0), cB, voffB); PG8_STAGE(PG8_SB(0, 1), cB + hstep, voffB); PG8_STAGE(PG8_SA(0, 0), cA, voffA); PG8_STAGE(PG8_SA(0, 1), cA + hstep, voffA);
        if (wr == 1) PG8_BAR;
        PG8_WAIT_V(2); PG8_BAR;
        PG8_STAGE(PG8_SB(1, 0), cB + kstep, voffB); PG8_STAGE(PG8_SA(1, 0), cA + kstep, voffA); PG8_STAGE(PG8_SB(1, 1), cB + hstep + kstep, voffB);
        PG8_WAIT_V(6); PG8_BAR;
    } else {
        PG8_STAGE(PG8_SB(0, 0), cB, voffB); PG8_STAGE(PG8_SA(0, 0), cA, voffA); PG8_STAGE(PG8_SB(0, 1), cB + hstep, voffB); PG8_STAGE(PG8_SA(0, 1), cA + hstep, voffA);
        if (wr == 1) PG8_BAR;
        PG8_WAIT_V(4); PG8_BAR;
        PG8_STAGE(PG8_SB(1, 0), cB + kstep, voffB); PG8_STAGE(PG8_SA(1, 0), cA + kstep, voffA); PG8_STAGE(PG8_SB(1, 1), cB + hstep + kstep, voffB);
        PG8_WAIT_V(6); PG8_BAR;
    }
    for (;;) {
        const bool has_next = S.next(ui + 1, nxt);
        const char* nA = has_next ? (const char*)g.A + (size_t)nxt.pm * tstep + (size_t)nxt.kt0 * kstep : cA; const char* nB = has_next ? (const char*)g.Bt + (size_t)nxt.pn * tstep + (size_t)nxt.kt0 * kstep : cB;
        const int nt = cur.nkt;
        for (int t = 0; t < nt; t += 2) {
            const bool last = (t == nt - 2);
            const char* a1 = cA + (size_t)(t + 1) * kstep;
            const char* a2 = last ? nA : cA + (size_t)(t + 2) * kstep; const char* b2 = last ? nB : cB + (size_t)(t + 2) * kstep;
            const char* a3 = a2 + kstep; const char* b3 = b2 + kstep;
            if (last && has_next) S.a_ready(nxt);
            if constexpr (SP2) {
            PG8_LDB(B0, 0, 0); PG8_LDB(B1, 0, 1); PG8_SCHED; PG8_LDA(At, 0, 0); PG8_STAGE(PG8_SA(1, 1), a1 + hstep, voffA);
            PG8_WAIT_V(8); PG8_WAIT_L(0); PG8_BAR; PG8_MMA(0, 0, At, B0); PG8_MMA(0, 1, At, B1); PG8_BAR; PG8_SCHED;
            PG8_LDA(At, 0, 1); PG8_STAGE(PG8_SB(0, 0), b2, voffB); PG8_STAGE(PG8_SB(0, 1), b2 + hstep, voffB); PG8_STAGE(PG8_SA(0, 0), a2, voffA);
            PG8_WAIT_V(8); PG8_WAIT_L(0); PG8_BAR; PG8_MMA(1, 0, At, B0); PG8_MMA(1, 1, At, B1); PG8_BAR; PG8_SCHED;
            PG8_LDB(B0, 1, 0); PG8_LDB(B1, 1, 1); PG8_SCHED; PG8_LDA(At, 1, 0); PG8_STAGE(PG8_SA(0, 1), a2 + hstep, voffA);
            PG8_WAIT_V(8); PG8_WAIT_L(0); PG8_BAR; PG8_MMA(0, 0, At, B0); PG8_MMA(0, 1, At, B1); PG8_BAR; PG8_SCHED;
            PG8_LDA(At, 1, 1); PG8_STAGE(PG8_SB(1, 0), b3, voffB); PG8_STAGE(PG8_SB(1, 1), b3 + hstep, voffB); PG8_STAGE(PG8_SA(1, 0), a3, voffA);
            PG8_WAIT_V(8); PG8_WAIT_L(0); PG8_BAR; PG8_MMA(1, 0, At, B0); PG8_MMA(1, 1, At, B1); PG8_BAR; PG8_SCHED;
            } else {
            PG8_LDB(B0, 0, 0); PG8_SCHED; PG8_LDA(At, 0, 0); PG8_STAGE(PG8_SA(1, 1), a1 + hstep, voffA);
            PG8_WAIT_L(8); PG8_BAR; PG8_WAIT_L(0); PG8_MMA(0, 0, At, B0); PG8_BAR; PG8_SCHED;
            PG8_LDB(B1, 0, 1); PG8_STAGE(PG8_SB(0, 0), b2, voffB);
            PG8_BAR; PG8_WAIT_L(0); PG8_MMA(0, 1, At, B1); PG8_BAR;
            PG8_LDA(At, 0, 1); PG8_STAGE(PG8_SA(0, 0), a2, voffA);
            PG8_BAR; PG8_WAIT_L(0); PG8_MMA(1, 0, At, B0); PG8_BAR; PG8_SCHED;
            PG8_STAGE(PG8_SB(0, 1), b2 + hstep, voffB);
            PG8_WAIT_V(6); PG8_BAR; PG8_MMA(1, 1, At, B1); PG8_BAR;
            PG8_LDB(B0, 1, 0); PG8_SCHED; PG8_LDA(At, 1, 0); PG8_STAGE(PG8_SA(0, 1), a2 + hstep, voffA);
            PG8_WAIT_L(8); PG8_BAR; PG8_WAIT_L(0); PG8_MMA(0, 0, At, B0); PG8_BAR; PG8_SCHED;
            PG8_LDB(B1, 1, 1); PG8_STAGE(PG8_SB(1, 0), b3, voffB);
            PG8_BAR; PG8_WAIT_L(0); PG8_MMA(0, 1, At, B1); PG8_BAR;
            PG8_LDA(At, 1, 1); PG8_STAGE(PG8_SA(1, 0), a3, voffA);
            PG8_BAR; PG8_WAIT_L(0); PG8_MMA(1, 0, At, B0); PG8_BAR; PG8_SCHED;
            PG8_STAGE(PG8_SB(1, 1), b3 + hstep, voffB);
            PG8_WAIT_V(6); PG8_BAR; PG8_MMA(1, 1, At, B1); PG8_BAR;
            }
        }
        if constexpr (ALIGN_EPI) { if (wr == 0) PG8_BAR; }
        if constexpr (F8) asm volatile("s_nop 15\n\ts_nop 15" ::: "memory");
        if constexpr (!Epi::AFTER_DRAIN) { E(acc, cur, wr, wc, fr, fq); S.done(cur); }
        if (!has_next) break;
#pragma unroll
        for (int a = 0; a < 2; ++a)
#pragma unroll
            for (int b = 0; b < 2; ++b)
#pragma unroll
                for (int m = 0; m < 4; ++m)
#pragma unroll
                    for (int n = 0; n < 2; ++n) acc[a][b][m][n] = (f32x4){0.f, 0.f, 0.f, 0.f};
        cur = nxt; cA = nA; cB = nB; ++ui;
        if constexpr (ALIGN_EPI) { if (wr == 1) PG8_BAR; }
    }
    PG8_WAIT_V(0);
    if constexpr (!ALIGN_EPI) { if (wr == 0) PG8_BAR; }
    PG8_BAR;
    if constexpr (Epi::AFTER_DRAIN) { E.fused(acc, cur, wr, wc, fr, fq, lds, wid, lane); S.done(cur); }
#undef PG8_SA
#undef PG8_SB
#undef PG8_STAGE
#undef PG8_LDA
#undef PG8_LDB
#undef PG8_MMA
#undef PG8_WAIT_V
#undef PG8_WAIT_L
#undef PG8_BAR
#undef PG8_SCHED
}
}

#define GAS __attribute__((address_space(1)))
#define LAS __attribute__((address_space(3)))
typedef unsigned short bf16;
typedef unsigned v4u __attribute__((ext_vector_type(4)));
typedef unsigned v2u __attribute__((ext_vector_type(2)));
typedef float f32x4 __attribute__((ext_vector_type(4)));
#define LDS_WAIT() asm volatile("s_waitcnt lgkmcnt(0)" ::: "memory")
#define VM_WAIT() asm volatile("s_waitcnt vmcnt(0)" ::: "memory")

#define XB_TMO      128
#define XB_XCNT(j)  (256  + 64 * (j))
#define XB_XSUB(j)  (1280 + 64 * (j))
#define XB_XGEN(j)  (2304 + 64 * (j))
#define XB_TOP      3328
#define XB_TOPGEN   3392
#define XCD_BAR_WORDS 3456
#define XB_SPIN_CAP (1u << 18)

__device__ __forceinline__ unsigned xb_ld(unsigned* p)              { return __hip_atomic_load(p, __ATOMIC_RELAXED, __HIP_MEMORY_SCOPE_AGENT); }
__device__ __forceinline__ unsigned xb_add(unsigned* p, unsigned v) { return __hip_atomic_fetch_add(p, v, __ATOMIC_RELAXED, __HIP_MEMORY_SCOPE_AGENT); }
__device__ __forceinline__ unsigned xb_xcc_id() { return (unsigned)__builtin_amdgcn_s_getreg((3 << 11) | 20) & 0xFu; }
#define XB_SPIN(cond, bar) do { unsigned _sp = 0; while (cond) { __builtin_amdgcn_s_sleep(1); \
    if ((++_sp & 255u) == 0u) { if (xb_ld(&(bar)[XB_TMO])) break; if (_sp > XB_SPIN_CAP) { atomicAdd(&(bar)[XB_TMO], 1u); break; } } } } while (0)

struct XcdBarrier {
    int tid;
    unsigned* bar; unsigned x;
    volatile LAS unsigned* st;
};

__device__ __forceinline__ XcdBarrier xcd_barrier_post(unsigned* bar, volatile LAS unsigned* st, int tid) {
    XcdBarrier b; b.tid = tid; b.bar = bar; b.x = xb_xcc_id(); b.st = st;
    if (tid == 0) (void)xb_add(&bar[XB_XCNT(b.x)], 1u);
    return b;
}
__device__ __forceinline__ void xcd_barrier_complete(unsigned* bar, unsigned x, unsigned& nloc, unsigned& nx) {
    const unsigned G = gridDim.x * gridDim.y * gridDim.z;
    unsigned sum, cnt, mine, sp = 0u;
    for (;;) {
        sum = 0u; cnt = 0u; mine = 0u;
#pragma unroll
        for (unsigned j = 0; j < 16; ++j) { const unsigned c = xb_ld(&bar[XB_XCNT(j)]); sum += c; cnt += (c > 0u) ? 1u : 0u; mine = (j == x) ? c : mine; }
        if (sum == G) break;
        __builtin_amdgcn_s_sleep(1);
        if ((++sp & 255u) == 0u) { if (xb_ld(&bar[XB_TMO])) break; if (sp > XB_SPIN_CAP) { atomicAdd(&bar[XB_TMO], 1u); break; } }
    }
    nloc = mine > 0u ? mine : 1u; nx = cnt > 0u ? cnt : 1u;
}

__device__ __forceinline__ void xcd_barrier(const XcdBarrier& b) {
    asm volatile("s_waitcnt vmcnt(0)" ::: "memory");
    __syncthreads();
    if (b.tid == 0) {
        unsigned* bar = b.bar;
        __builtin_amdgcn_s_waitcnt(0);
        unsigned nloc = b.st[0], nx = b.st[1];
        if (nloc == 0u) { xcd_barrier_complete(bar, b.x, nloc, nx); b.st[0] = nloc; b.st[1] = nx; }
        const unsigned old = xb_add(&bar[XB_XSUB(b.x)], 1u);
        const unsigned gen = old / nloc;
        if (old + 1u == (gen + 1u) * nloc) {
            __builtin_amdgcn_fence(__ATOMIC_RELEASE, "agent");
            asm volatile("s_waitcnt vmcnt(0)" ::: "memory");
            const unsigned og = xb_add(&bar[XB_TOP], 1u);
            const unsigned tg = og / nx;
            if (og + 1u == (tg + 1u) * nx) xb_add(&bar[XB_TOPGEN], 1u);
            else XB_SPIN(xb_ld(&bar[XB_TOPGEN]) == tg, bar);
            __builtin_amdgcn_fence(__ATOMIC_ACQUIRE, "agent");
            xb_add(&bar[XB_XGEN(b.x)], 1u);
            asm volatile("s_waitcnt vmcnt(0)" ::: "memory");
        } else {
            XB_SPIN(xb_ld(&bar[XB_XGEN(b.x)]) == gen, bar);
            __builtin_amdgcn_fence(__ATOMIC_ACQUIRE, "agent");
            asm volatile("s_waitcnt vmcnt(0)" ::: "memory");
        }
    }
    __syncthreads();
}
namespace att {
using bf16 = unsigned short;
using bf16x8 = __attribute__((ext_vector_type(8))) short;
using s16x4  = __attribute__((ext_vector_type(4))) short;
using f32x16 = __attribute__((ext_vector_type(16))) float;
using f32x4  = __attribute__((ext_vector_type(4))) float;
using u32x4  = __attribute__((ext_vector_type(4))) unsigned;
typedef int v4i_att __attribute__((ext_vector_type(4)));
typedef int v8i_att __attribute__((ext_vector_type(8)));
typedef int v2i_att __attribute__((ext_vector_type(2)));
constexpr int NW = 8, QBLK = 32, KVBLK = 64, DV = 128;
constexpr float THR = 8.f;
#define ATT_SBAR() __builtin_amdgcn_sched_barrier(0)
#define ATT_LAS __attribute__((address_space(3)))
__device__ __forceinline__ int crow(int r, int hi) { return (r & 3) + 8 * (r >> 2) + 4 * hi; }
__device__ __forceinline__ unsigned cvtpk(float lo, float hi) { unsigned r; asm volatile("v_cvt_pk_bf16_f32 %0, %1, %2" : "=v"(r) : "v"(lo), "v"(hi)); return r; }

__device__ __forceinline__ float att_shx(float v, int lane, int o) { return __builtin_bit_cast(float, __builtin_amdgcn_ds_bpermute((lane ^ o) << 2, __builtin_bit_cast(int, v))); }
struct CfgGQA { static constexpr int LDVT = 8448, NS = 2, KROWB = 128, RB = 128, DQK = 128, LDQ = 3072, LDK = 512, LDV = 3072, LDO = 2048, SDEPTH = 0; static constexpr bool MLA = false, MSUM = false; static constexpr float SCALE = 0.088388347648318440f; };
struct CfgMLA { static constexpr int LDVT = 8448, NS = 3, KROWB = 192, RB = 256, DQK = 192, LDQ = 3072, LDK = 3072, LDV = 4096, LDO = 2048, SDEPTH = 0; static constexpr bool MLA = true, MSUM = false;  static constexpr float SCALE = 0.072168783648703220f; };

__device__ __forceinline__ float max3f(float a, float b, float c) { float r; asm("v_max3_f32 %0, %1, %2, %3" : "=v"(r) : "v"(a), "v"(b), "v"(c)); return r; }
__device__ __forceinline__ float max2f(float a, float b) { float r; asm("v_max_f32_e32 %0, %1, %2" : "=v"(r) : "v"(a), "v"(b)); return r; }
__device__ __forceinline__ float max8(const f32x16& p, int base) {
  return max2f(max3f(max3f(max3f(p[base], p[base + 1], p[base + 2]), p[base + 3], p[base + 4]), p[base + 5], p[base + 6]), p[base + 7]);
}
template <bool FIRST>
__device__ __forceinline__ void decideSM(f32x16& p0, f32x16& p1, float pmax, float& m_reg, f32x16& negm, float& alpha) {
  constexpr float THRL = THR * 1.4426950408889634f;
  { auto rr = __builtin_amdgcn_permlane32_swap(__float_as_uint(pmax), __float_as_uint(pmax), false, false);
    pmax = fmaxf(__uint_as_float(rr[0]), __uint_as_float(rr[1])); }
  if (!FIRST && __builtin_expect(__all(pmax <= THRL), 1)) { alpha = 1.f; }
  else { const float d = FIRST ? pmax : fmaxf(pmax, 0.f); alpha = FIRST ? 0.f : __builtin_amdgcn_exp2f(-d); m_reg += d;
#pragma unroll
    for (int r = 0; r < 16; ++r) { p0[r] -= d; p1[r] -= d; negm[r] -= d; } }
}
template <bool SUMV>
__device__ __forceinline__ void finishSM(f32x16& p0, f32x16& p1, float alpha, float& l_reg, bf16x8& pa0, bf16x8& pa1, bf16x8& pa2, bf16x8& pa3) {
#pragma unroll
  for (int r = 0; r < 16; ++r) p0[r] = __builtin_amdgcn_exp2f(p0[r]);
#pragma unroll
  for (int r = 0; r < 16; ++r) p1[r] = __builtin_amdgcn_exp2f(p1[r]);
  if constexpr (SUMV) { float ps = 0;
#pragma unroll
  for (int r = 0; r < 16; ++r) ps += p0[r];
#pragma unroll
  for (int r = 0; r < 16; ++r) ps += p1[r];
  { auto rr = __builtin_amdgcn_permlane32_swap(__float_as_uint(ps), __float_as_uint(ps), false, false);
    ps = __uint_as_float(rr[0]) + __uint_as_float(rr[1]); }
  l_reg = l_reg * alpha + ps; }
#define ATT_PKB(P, B) __builtin_amdgcn_cvt_pk_bf8_f32(P[B + 2], P[B + 3], __builtin_amdgcn_cvt_pk_bf8_f32(P[B], P[B + 1], 0, false), true)
  { const v4i_att w0 = {ATT_PKB(p0, 0), ATT_PKB(p0, 4), ATT_PKB(p0, 8), ATT_PKB(p0, 12)}, w1 = {ATT_PKB(p1, 0), ATT_PKB(p1, 4), ATT_PKB(p1, 8), ATT_PKB(p1, 12)};
    pa0 = __builtin_bit_cast(bf16x8, w0); pa1 = __builtin_bit_cast(bf16x8, w1); pa2 = pa0; pa3 = pa1; }
#undef ATT_PKB
}
__device__ __forceinline__ void finishU8(const f32x16& p0, const f32x16& p1, bf16x8& pa0, bf16x8& pa1) {
  v4i_att w0 = {0, 0, 0, 0}, w1 = {0, 0, 0, 0};
#pragma unroll
  for (int r = 0; r < 16; ++r) { w0[r >> 2] = (int)__builtin_amdgcn_cvt_pk_u8_f32(p0[r], r & 3, (unsigned)w0[r >> 2]); w1[r >> 2] = (int)__builtin_amdgcn_cvt_pk_u8_f32(p1[r], r & 3, (unsigned)w1[r >> 2]); }
  pa0 = __builtin_bit_cast(bf16x8, w0); pa1 = __builtin_bit_cast(bf16x8, w1);
}
__device__ __forceinline__ void rowsum16(f32x4& ls, bf16x8 pa0, bf16x8 pa1, const v8i_att& bones) {
  constexpr int ONE = 0x7f7f7f7f;
  const v4i_att a0 = __builtin_bit_cast(v4i_att, pa0), a1 = __builtin_bit_cast(v4i_att, pa1);
  const v8i_att A = {a0[0], a0[1], a0[2], a0[3], a1[0], a1[1], a1[2], a1[3]};
  asm volatile("s_nop 1\n\tv_mfma_scale_f32_16x16x128_f8f6f4 %0, %1, %2, %0, %3, %3 op_sel_hi:[0,0,0] cbsz:1" : "+v"(ls) : "v"(A), "v"(bones), "v"(ONE));
}
typedef int v8i __attribute__((ext_vector_type(8)));
typedef int v4i __attribute__((ext_vector_type(4)));
template <int RB> __device__ __forceinline__ int kswf(int row) { return RB == 128 ? ((row >> 1) & 7) : (row & 15); }
template <int RB> __device__ __forceinline__ int kswz8(int row, int chunk) { return row * RB + ((chunk ^ kswf<RB>(row)) << 4); }
template <class Cfg, int SA>
__device__ __forceinline__ void qkt(f32x16& p0, f32x16& p1, const char* Ks, const v8i* q8, const f32x16& negm, int r32, int hi) {
  constexpr int ONE = 0x7f7f7f7f;
#pragma unroll
  for (int s = 0; s < Cfg::NS; ++s) { const int c = 4 * s + 2 * hi;
    const v4i a0 = *reinterpret_cast<const v4i*>(Ks + kswz8<Cfg::RB>(r32, c)), a1 = *reinterpret_cast<const v4i*>(Ks + kswz8<Cfg::RB>(r32, c + 1));
    const v4i b0 = *reinterpret_cast<const v4i*>(Ks + kswz8<Cfg::RB>(32 + r32, c)), b1 = *reinterpret_cast<const v4i*>(Ks + kswz8<Cfg::RB>(32 + r32, c + 1));
    const v8i A = {a0[0], a0[1], a0[2], a0[3], a1[0], a1[1], a1[2], a1[3]}, B = {b0[0], b0[1], b0[2], b0[3], b1[0], b1[1], b1[2], b1[3]};
    if (s == 0) { p0 = __builtin_amdgcn_mfma_scale_f32_32x32x64_f8f6f4(A, q8[0], negm, 2, 2, 0, SA, 0, ONE); p1 = __builtin_amdgcn_mfma_scale_f32_32x32x64_f8f6f4(B, q8[0], negm, 2, 2, 0, SA, 0, ONE); }
    else { p0 = __builtin_amdgcn_mfma_scale_f32_32x32x64_f8f6f4(A, q8[s], p0, 2, 2, 0, SA, 0, ONE); p1 = __builtin_amdgcn_mfma_scale_f32_32x32x64_f8f6f4(B, q8[s], p1, 2, 2, 0, SA, 0, ONE); } }
}
__device__ __forceinline__ int pk4_fp8(float a, float b, float c, float d) { int w = 0; w = __builtin_amdgcn_cvt_pk_fp8_f32(a, b, w, false); w = __builtin_amdgcn_cvt_pk_fp8_f32(c, d, w, true); return w; }
template <int D0> __device__ __forceinline__ void pv_one(f32x16& od, const char* vrow, int vd, bf16x8 pa0, bf16x8 pa1, bf16x8, bf16x8) {
  constexpr int ONE = 0x7f7f7f7f;
  const v4i_att b0 = *reinterpret_cast<const v4i_att*>(vrow + D0 * 2048), b1 = *reinterpret_cast<const v4i_att*>(vrow + D0 * 2048 + vd);
  asm volatile("s_waitcnt lgkmcnt(0)" ::: "memory"); ATT_SBAR();
  const v4i_att a0 = __builtin_bit_cast(v4i_att, pa0), a1 = __builtin_bit_cast(v4i_att, pa1);
  const v8i_att A = {a0[0], a0[1], a0[2], a0[3], a1[0], a1[1], a1[2], a1[3]}, B = {b0[0], b0[1], b0[2], b0[3], b1[0], b1[1], b1[2], b1[3]};
  asm volatile("s_nop 1\n\tv_mfma_scale_f32_32x32x64_f8f6f4 %0, %1, %2, %0, %3, %3 op_sel_hi:[0,0,0] cbsz:1" : "+v"(od) : "v"(A), "v"(B), "v"(ONE));
}
__device__ __forceinline__ void pv_rowsum_unused(f32x16& lacc, bf16x8 pa0, bf16x8 pa1, bf16x8 pa2, bf16x8 pa3) {
  const bf16x8 ones = {(short)0x3F80, (short)0x3F80, (short)0x3F80, (short)0x3F80, (short)0x3F80, (short)0x3F80, (short)0x3F80, (short)0x3F80};
  lacc = __builtin_amdgcn_mfma_f32_32x32x16_bf16(pa0, ones, lacc, 0, 0, 0); lacc = __builtin_amdgcn_mfma_f32_32x32x16_bf16(pa1, ones, lacc, 0, 0, 0);
  lacc = __builtin_amdgcn_mfma_f32_32x32x16_bf16(pa2, ones, lacc, 0, 0, 0); lacc = __builtin_amdgcn_mfma_f32_32x32x16_bf16(pa3, ones, lacc, 0, 0, 0);
}
#define ATT_CVT1(W, X, SEL) asm volatile("v_cvt_pk_u8_f32 %0, %1, " #SEL ", %0" : "+v"(W) : "v"(X))
#define ATT_CVT8(P, B, W, I) do { int c0_, c1_; asm volatile("v_cvt_pk_u8_f32 %0, %1, 0, 0" : "=v"(c0_) : "v"(P[B])); asm volatile("v_cvt_pk_u8_f32 %0, %1, 0, 0" : "=v"(c1_) : "v"(P[B + 4])); \
    ATT_CVT1(c0_, P[B + 1], 1); ATT_CVT1(c1_, P[B + 5], 1); ATT_CVT1(c0_, P[B + 2], 2); ATT_CVT1(c1_, P[B + 6], 2); ATT_CVT1(c0_, P[B + 3], 3); ATT_CVT1(c1_, P[B + 7], 3); \
    W[I] = c0_; W[I + 1] = c1_; } while (0)
#define ATT_CVT16(P, W) do { int c0_, c1_, c2_, c3_; asm volatile("v_cvt_pk_u8_f32 %0, %1, 0, 0" : "=v"(c0_) : "v"(P[0])); asm volatile("v_cvt_pk_u8_f32 %0, %1, 0, 0" : "=v"(c1_) : "v"(P[4])); \
    asm volatile("v_cvt_pk_u8_f32 %0, %1, 0, 0" : "=v"(c2_) : "v"(P[8])); asm volatile("v_cvt_pk_u8_f32 %0, %1, 0, 0" : "=v"(c3_) : "v"(P[12])); \
    ATT_CVT1(c0_, P[1], 1); ATT_CVT1(c1_, P[5], 1); ATT_CVT1(c2_, P[9], 1); ATT_CVT1(c3_, P[13], 1); ATT_CVT1(c0_, P[2], 2); ATT_CVT1(c1_, P[6], 2); ATT_CVT1(c2_, P[10], 2); ATT_CVT1(c3_, P[14], 2); \
    ATT_CVT1(c0_, P[3], 3); ATT_CVT1(c1_, P[7], 3); ATT_CVT1(c2_, P[11], 3); ATT_CVT1(c3_, P[15], 3); W[0] = c0_; W[1] = c1_; W[2] = c2_; W[3] = c3_; } while (0)
#define ATT_PVM(OD, B0, B1) do { const v8i_att B_ = {B0[0], B0[1], B0[2], B0[3], B1[0], B1[1], B1[2], B1[3]}; \
    asm volatile("s_nop 1\n\tv_mfma_scale_f32_32x32x64_f8f6f4 %0, %1, %2, %0, %3, %3 op_sel_hi:[0,0,0] cbsz:1" : "+v"(OD) : "v"(A), "v"(B_), "v"(ONE)); } while (0)
template <bool CVT>
__device__ __forceinline__ void pv_cvt(f32x16* o, f32x4& lsum, const char* vb, int vd, const v4i_att& a0, const v4i_att& a1, const f32x16& p0, const f32x16& p1, v4i_att& w0, v4i_att& w1, const v8i_att& bones) {
  constexpr int ONE = 0x7f7f7f7f;
  const v8i_att A = {a0[0], a0[1], a0[2], a0[3], a1[0], a1[1], a1[2], a1[3]};
  const v4i_att b00 = *reinterpret_cast<const v4i_att*>(vb), b01 = *reinterpret_cast<const v4i_att*>(vb + vd); ATT_SBAR();
  const v4i_att b10 = *reinterpret_cast<const v4i_att*>(vb + 2048), b11 = *reinterpret_cast<const v4i_att*>(vb + 2048 + vd);
  asm volatile("s_waitcnt lgkmcnt(2)" ::: "memory"); ATT_SBAR();
  ATT_PVM(o[0], b00, b01); ATT_SBAR();
  if constexpr (CVT) { asm volatile("s_nop 7" ::: "memory"); ATT_CVT8(p0, 0, w0, 0); }
  const v4i_att b20 = *reinterpret_cast<const v4i_att*>(vb + 4096), b21 = *reinterpret_cast<const v4i_att*>(vb + 4096 + vd);
  asm volatile("s_waitcnt lgkmcnt(2)" ::: "memory"); ATT_SBAR();
  ATT_PVM(o[1], b10, b11); ATT_SBAR();
  if constexpr (CVT) ATT_CVT8(p0, 8, w0, 2);
  const v4i_att b30 = *reinterpret_cast<const v4i_att*>(vb + 6144), b31 = *reinterpret_cast<const v4i_att*>(vb + 6144 + vd);
  asm volatile("s_waitcnt lgkmcnt(2)" ::: "memory"); ATT_SBAR();
  ATT_PVM(o[2], b20, b21); ATT_SBAR();
  if constexpr (CVT) ATT_CVT8(p1, 0, w1, 0);
  asm volatile("s_waitcnt lgkmcnt(0)" ::: "memory"); ATT_SBAR();
  ATT_PVM(o[3], b30, b31); ATT_SBAR();
  if constexpr (CVT) ATT_CVT8(p1, 8, w1, 2);
  asm volatile("s_nop 1\n\tv_mfma_scale_f32_16x16x128_f8f6f4 %0, %1, %2, %0, %3, %3 op_sel_hi:[0,0,0] cbsz:1" : "+v"(lsum) : "v"(A), "v"(bones), "v"(ONE));
  ATT_SBAR();
}
#define ATT_DSR(X, ADDR, OFF) asm volatile("ds_read_b128 %0, %1 offset:%2" : "=v"(X) : "v"(ADDR), "n"(OFF))
#define ATT_RK(F, S, ROFF) do { v4i x0_; v2i_att x1_; ATT_DSR(x0_, ka[2 * (S)] + kbo, (ROFF) * Cfg::RB); asm volatile("ds_read_b64 %0, %1 offset:%2" : "=v"(x1_) : "v"(ka[2 * (S) + 1] + kbo), "n"((ROFF) * Cfg::RB)); \
    F = (v8i){x0_[0], x0_[1], x0_[2], x0_[3], x1_[0], x1_[1], 0, 0}; ATT_SBAR(); } while (0)
#define ATT_RV(F, D) do { v4i x0_, x1_; ATT_DSR(x0_, va0 + vbo, (D) * 2048); ATT_DSR(x1_, va1 + vbo, (D) * 2048); \
    F = (v8i){x0_[0], x0_[1], x0_[2], x0_[3], x1_[0], x1_[1], x1_[2], x1_[3]}; ATT_SBAR(); } while (0)
#define ATT_LW(N) do { asm volatile("s_waitcnt lgkmcnt(" #N ")" ::: "memory"); ATT_SBAR(); } while (0)
#define ATT_QKM(PX, F, S) do { if ((S) == 0) PX = __builtin_amdgcn_mfma_scale_f32_32x32x64_f8f6f4(F, q8[S], negm, 2, 2, 0, SA, 0, ONE); else PX = __builtin_amdgcn_mfma_scale_f32_32x32x64_f8f6f4(F, q8[S], PX, 2, 2, 0, SA, 0, ONE); ATT_SBAR(); } while (0)
#define ATT_PVF(OD, F) do { asm volatile("s_nop 1\n\tv_mfma_scale_f32_32x32x64_f8f6f4 %0, %1, %2, %0, %3, %3 op_sel_hi:[0,0,0] cbsz:1" : "+v"(OD) : "v"(A), "v"(F), "v"(ONE)); ATT_SBAR(); } while (0)
#define ATT_PRE(KBN) do { const int kbo = (KBN); ATT_RK(fa, 0, 0); ATT_RK(fb, 0, 32); ATT_RK(fc, 1, 0); } while (0)
#define ATT_STEP_BODY(MID, PRE) do { constexpr int ONE = 0x7f7f7f7f; \
    const v8i A = {a0[0], a0[1], a0[2], a0[3], a1[0], a1[1], a1[2], a1[3]}; \
    ATT_SBAR(); \
    if constexpr (Cfg::NS == 2) { \
      ATT_LW(4); ATT_QKM(p0, fa, 0); ATT_RK(fa, 1, 32); \
      ATT_LW(4); ATT_QKM(p1, fb, 0); ATT_RV(fb, 0); \
      ATT_LW(4); ATT_QKM(p0, fc, 1); ATT_RV(fc, 1); \
      ATT_LW(4); ATT_QKM(p1, fa, 1); MID; ATT_RV(fa, 2); \
      ATT_LW(4); ATT_PVF(o[0], fb); asm volatile("s_nop 7" ::: "memory"); ATT_CVT16(p0, w0); ATT_RV(fb, 3); \
      ATT_LW(4); ATT_PVF(o[1], fc);  \
      ATT_LW(2); ATT_PVF(o[2], fa); ATT_CVT16(p1, w1); \
      ATT_LW(0); ATT_PVF(o[3], fb);  \
    } else { \
      ATT_LW(4); ATT_QKM(p0, fa, 0); ATT_RK(fa, 1, 32); \
      ATT_LW(4); ATT_QKM(p1, fb, 0); ATT_RK(fb, 2, 0); \
      ATT_LW(4); ATT_QKM(p0, fc, 1); ATT_RK(fc, 2, 32); \
      ATT_LW(4); ATT_QKM(p1, fa, 1); ATT_RV(fa, 0); \
      ATT_LW(4); ATT_QKM(p0, fb, 2); ATT_RV(fb, 1); \
      ATT_LW(4); ATT_QKM(p1, fc, 2); MID; ATT_RV(fc, 2); \
      ATT_LW(4); ATT_PVF(o[0], fa); asm volatile("s_nop 7" ::: "memory"); ATT_CVT16(p0, w0); ATT_RV(fa, 3); \
      ATT_LW(4); ATT_PVF(o[1], fb);  \
      ATT_LW(2); ATT_PVF(o[2], fc); ATT_CVT16(p1, w1); \
      ATT_LW(0); ATT_PVF(o[3], fa);  \
    } \
    asm volatile("s_nop 1\n\tv_mfma_scale_f32_16x16x128_f8f6f4 %0, %1, %2, %0, %3, %3 op_sel_hi:[0,0,0] cbsz:1" : "+v"(lsum) : "v"(A), "v"(bones), "v"(ONE)); ATT_SBAR(); PRE; } while (0)
#undef ATT_PVM
__device__ __forceinline__ void pv_d0(f32x16* o, const char* vb, int vd, bf16x8 pa0, bf16x8 pa1, bf16x8 pa2, bf16x8 pa3) {
  pv_one<0>(o[0], vb, vd, pa0, pa1, pa2, pa3); pv_one<1>(o[1], vb, vd, pa0, pa1, pa2, pa3); pv_one<2>(o[2], vb, vd, pa0, pa1, pa2, pa3); pv_one<3>(o[3], vb, vd, pa0, pa1, pa2, pa3);
}
__device__ __forceinline__ float pv_d0_max(f32x16* o, const char* vb, int vd, bf16x8 pa0, bf16x8 pa1, bf16x8 pa2, bf16x8 pa3, const f32x16& x0, const f32x16& x1) {
  pv_one<0>(o[0], vb, vd, pa0, pa1, pa2, pa3); const float m0 = max8(x0, 0);
  pv_one<1>(o[1], vb, vd, pa0, pa1, pa2, pa3); const float m1 = max8(x0, 8);
  pv_one<2>(o[2], vb, vd, pa0, pa1, pa2, pa3); const float m2 = max8(x1, 0);
  pv_one<3>(o[3], vb, vd, pa0, pa1, pa2, pa3); const float m3 = max8(x1, 8);
  return max2f(max3f(m0, m1, m2), m3);
}
__device__ __forceinline__ void unpack8(bf16x8 v, float* f) {
  const u32x4 w = *reinterpret_cast<const u32x4*>(&v);
#pragma unroll
  for (int k = 0; k < 4; ++k) { f[2 * k] = __uint_as_float(w[k] << 16); f[2 * k + 1] = __uint_as_float(w[k] & 0xffff0000u); }
}
__device__ __forceinline__ void rope8(float* a, float* b, const float* cs, const float* sn) {
  const f32x4 c0 = *(const f32x4*)cs, c1 = *(const f32x4*)(cs + 4), s0 = *(const f32x4*)sn, s1 = *(const f32x4*)(sn + 4);
#pragma unroll
  for (int i = 0; i < 8; ++i) { const float c = i < 4 ? c0[i & 3] : c1[i & 3], s = i < 4 ? s0[i & 3] : s1[i & 3]; const float x = a[i], y = b[i]; a[i] = x * c - y * s; b[i] = y * c + x * s; }
}

template <class Cfg, bool STATIC>
__device__ __forceinline__ void attn_unit(const bf16* __restrict__ Qn, const bf16* __restrict__ Qp, const unsigned char* __restrict__ Kh, const unsigned char* __restrict__ Vh,
                                          bf16* __restrict__ Ob, int seq, ATT_LAS unsigned char* ldsL, char* lds, int t0, const float* __restrict__ gq_n, const float* __restrict__ gq_p, const float* __restrict__ rope_tab, float mbound, int wave_in, int var = 0) {
  constexpr int DQK = Cfg::DQK, LDQ = Cfg::LDQ, LDK = Cfg::LDK, LDV = Cfg::LDV, LDO = Cfg::LDO;
  constexpr bool MSUM = Cfg::MSUM;
  constexpr int SHM_V = KVBLK * DV, SHM_K = KVBLK * Cfg::RB, NCH = Cfg::RB / 16, KPT = KVBLK * NCH / 512, NV = KPT + 1, NB = STATIC ? 4 : 3, KOFF = NB * SHM_V, NS = Cfg::NS, LDVT = Cfg::LDVT;
  int tid_; asm volatile("v_mbcnt_lo_u32_b32 %0, -1, 0\n\tv_mbcnt_hi_u32_b32 %0, -1, %0" : "=&v"(tid_)); tid_ |= wave_in << 6;
  const int tid = tid_, wid = __builtin_amdgcn_readfirstlane(tid >> 6), lane = tid & 63, r32 = lane & 31, hi = lane >> 5;
  char* V_lds = lds; char* K_lds = lds + KOFF;
  float* ws = (float*)(lds + KOFF + NB * SHM_K) + wid * 64; float* li_l = ws; float* al_l = ws + 32;
  unsigned kgo[KPT], vgo[2];
#pragma unroll
  for (int k = 0; k < KPT; ++k) { const int s = (k * 8 + wid) * 64 + lane, row = s / NCH, csw = s - row * NCH, c = csw ^ kswf<Cfg::RB>(row); kgo[k] = (unsigned)(row * LDK + (c * 16 < Cfg::KROWB ? c * 16 : 0)); }
  { const int s16 = wid * 64 + lane, d = s16 >> 2, c = (s16 & 3) ^ ((d >> 2) & 3); vgo[0] = (unsigned)(d * LDVT + c * 16); vgo[1] = 0u; }
#define ATT_ISSUE_K(b, k0) do { const char* kt_ = (const char*)Kh + (long)(k0) * LDK; asm volatile("" : "+s"(kt_));     \
    _Pragma("unroll") for (int k_ = 0; k_ < KPT; ++k_) __builtin_amdgcn_global_load_lds((const unsigned*)(kt_ + (size_t)kgo[k_]), (ATT_LAS unsigned*)(ldsL + KOFF + (b) * SHM_K + (k_ * 8 + wid) * 1024), 16, 0, 0); } while (0)
#define ATT_ISSUE_V(b, k0) do { const char* vt_ = (const char*)Vh + (k0); asm volatile("" : "+s"(vt_));        \
    __builtin_amdgcn_global_load_lds((const unsigned*)(vt_ + (size_t)vgo[0]), (ATT_LAS unsigned*)(ldsL + (b) * SHM_V + wid * 1024), 16, 0, 0); } while (0)
#define ATT_ISSUE(b, k0) do { ATT_ISSUE_K(b, k0); ATT_ISSUE_V(b, k0); } while (0)
#define ATT_WAITV_NV() do { if constexpr (NV == 2) asm volatile("s_waitcnt vmcnt(2)" ::: "memory"); else asm volatile("s_waitcnt vmcnt(3)" ::: "memory"); } while (0)
#define ATT_WAITV_2NV() do { if constexpr (NV == 2) asm volatile("s_waitcnt vmcnt(4)" ::: "memory"); else asm volatile("s_waitcnt vmcnt(6)" ::: "memory"); } while (0)
#define ATT_BAR() do { asm volatile("s_waitcnt lgkmcnt(0)" ::: "memory"); __builtin_amdgcn_s_barrier(); asm volatile("" ::: "memory"); } while (0)
  float m_reg = 0.f, l_reg = 0; f32x16 negm = {}; v8i q8[NS];
  if constexpr (STATIC) {
#pragma unroll
    for (int r = 0; r < 16; ++r) negm[r] = 4.f * (15.5f - mbound) + 60.5f; }
  {
    const bf16* qrow = Qn + (long)(wid * QBLK + r32) * LDQ;
    const bf16* prow = Qp + (long)(wid * QBLK + r32) * LDQ;
    const int t = (t0 >= 0 ? t0 : 0) + wid * QBLK + r32, pr = t >> 6, pc = t & 63; const bool do_rope = t0 >= 0;
    constexpr float CQ = Cfg::SCALE * 1.4426950408889634f * 16.f;
    float ssn = 0.f, ssp = 0.f;
#pragma unroll
    for (int s = 0; s < NS; ++s) {
#pragma unroll
      for (int c = 0; c < 4; ++c) {
        const bf16* src;
        if constexpr (Cfg::MLA) src = (s < 2 ? qrow + 64 * s + 32 * hi : prow + 32 * hi) + 8 * c;
        else src = qrow + 64 * s + 16 * hi + (c & 1) * 8 + (c >> 1) * 32;
        float f[8]; unpack8(*reinterpret_cast<const bf16x8*>(src), f); float sq = 0.f;
#pragma unroll
        for (int i = 0; i < 8; ++i) sq += f[i] * f[i];
        if (Cfg::MLA && s == 2) ssp += sq; else ssn += sq; } }
    ssn += att_shx(ssn, lane, 32); ssp += att_shx(ssp, lane, 32);
    const float rn = rsqrtf(ssn * (1.f / 128.f) + 1e-6f) * CQ, rp = rsqrtf(ssp * (1.f / 64.f) + 1e-6f) * CQ;
#define ATT_SCALE8(f, r, gp) do { const f32x4 g0_ = *(const f32x4*)(gp), g1_ = *(const f32x4*)((gp) + 4); \
      _Pragma("unroll") for (int i_ = 0; i_ < 8; ++i_) f[i_] *= (r) * (i_ < 4 ? g0_[i_ & 3] : g1_[i_ & 3]); } while (0)
#pragma unroll
    for (int s = 0; s < NS; ++s) {
      float fa0[8], fa1[8], fb0[8], fb1[8];
      if constexpr (Cfg::MLA) {
        const bf16* src = s < 2 ? qrow + 64 * s + 32 * hi : prow + 32 * hi; const float* gp = s < 2 ? gq_n + 64 * s + 32 * hi : gq_p + 32 * hi; const float r = s < 2 ? rn : rp;
        unpack8(*reinterpret_cast<const bf16x8*>(src), fa0); unpack8(*reinterpret_cast<const bf16x8*>(src + 8), fa1); unpack8(*reinterpret_cast<const bf16x8*>(src + 16), fb0); unpack8(*reinterpret_cast<const bf16x8*>(src + 24), fb1);
        ATT_SCALE8(fa0, r, gp); ATT_SCALE8(fa1, r, gp + 8); ATT_SCALE8(fb0, r, gp + 16); ATT_SCALE8(fb1, r, gp + 24);
        if (s == 2 && do_rope) { const float* cs = rope_tab; const float* sn = rope_tab + 128 * 16; const int p = hi ? pc : pr;
          rope8(fa0, fb0, cs + p * 16, sn + p * 16); rope8(fa1, fb1, cs + p * 16 + 8, sn + p * 16 + 8); }
      } else {
        const bf16* src = qrow + 64 * s + 16 * hi; const float* gp = gq_n + 64 * s + 16 * hi;
        unpack8(*reinterpret_cast<const bf16x8*>(src), fa0); unpack8(*reinterpret_cast<const bf16x8*>(src + 8), fa1); unpack8(*reinterpret_cast<const bf16x8*>(src + 32), fb0); unpack8(*reinterpret_cast<const bf16x8*>(src + 40), fb1);
        ATT_SCALE8(fa0, rn, gp); ATT_SCALE8(fa1, rn, gp + 8); ATT_SCALE8(fb0, rn, gp + 32); ATT_SCALE8(fb1, rn, gp + 40);
        if (do_rope) { const float* cs = rope_tab; const float* sn = rope_tab + 128 * 32; const int p = s ? pc : pr;
          rope8(fa0, fb0, cs + p * 32 + 16 * hi, sn + p * 32 + 16 * hi); rope8(fa1, fb1, cs + p * 32 + 16 * hi + 8, sn + p * 32 + 16 * hi + 8); }
      }
      { typedef float v16f_q __attribute__((ext_vector_type(16))); v16f_q xa, xb;
#pragma unroll
        for (int i = 0; i < 8; ++i) { xa[i] = fa0[i]; xa[8 + i] = fa1[i]; xb[i] = fb0[i]; xb[8 + i] = fb1[i]; }
        const auto r6 = __builtin_amdgcn_cvt_scalef32_2xpk16_fp6_f32(xa, xb, 1.0f);
        q8[s] = (v8i){(int)r6[0], (int)r6[1], (int)r6[2], (int)r6[3], (int)r6[4], (int)r6[5], 0, 0}; }
    }
#undef ATT_SCALE8
  }
  asm volatile("s_waitcnt vmcnt(0)" ::: "memory");
  const int NT = seq / KVBLK;
  ATT_ISSUE(0, 0); ATT_ISSUE(1, KVBLK); ATT_ISSUE(2, 2 * KVBLK);
  f32x16 o[4] = {}; f32x16 lacc = {}; f32x4 lsum = {0.f, 0.f, 0.f, 0.f}; v8i_att bones;
  { int on = (((lane >> 3) & 1) == ((lane >> 4) & 1)) ? 0x38383838 : 0; asm volatile("" : "+v"(on)); bones = (v8i_att){on, on, on, on, on, on, on, on}; }
  constexpr int SA = STATIC ? 0x7c7c7c7c : 0x7a7a7a7a;
  const int cA_ = (2 * hi) ^ ((r32 >> 2) & 3), vd0 = (cA_ & 1) ? -16 : 16;
  const char* vb0 = V_lds + r32 * 64 + (cA_ << 4);
#define ATT_QK_SCHED() do { } while (0)
#define ATT_RESC(a) do { if (__any((a) < 1.f)) { if (hi == 0) al_l[r32] = (a); asm volatile("s_nop 15\n\ts_nop 15\n\ts_waitcnt lgkmcnt(0)" ::: "memory"); \
    _Pragma("unroll") for (int r = 0; r < 16; ++r) { const float a_ = al_l[crow(r, hi)]; _Pragma("unroll") for (int d = 0; d < 4; ++d) o[d][r] *= a_; if constexpr (MSUM) lacc[r] *= a_; } } } while (0)
  if constexpr (STATIC) {
  f32x16 p0, p1; v4i_att wa0, wa1, wb0, wb1;
  unsigned ka[2 * NS];
#pragma unroll
  for (int s_ = 0; s_ < NS; ++s_) { ka[2 * s_] = (unsigned)(size_t)ldsL + KOFF + kswz8<Cfg::RB>(r32, 4 * s_ + 2 * hi); ka[2 * s_ + 1] = (unsigned)(size_t)ldsL + KOFF + kswz8<Cfg::RB>(r32, 4 * s_ + 2 * hi + 1); }
  const unsigned va0 = (unsigned)(size_t)ldsL + r32 * 64 + (cA_ << 4), va1 = va0 + vd0;
  v8i fa, fb, fc;
#define ATT_BARX() do { __builtin_amdgcn_s_barrier(); asm volatile("" ::: "memory"); } while (0)
  ATT_WAITV_NV(); ATT_BAR();
  ATT_ISSUE_K(3, 3 * KVBLK);
  qkt<Cfg, SA>(p0, p1, K_lds, q8, negm, r32, hi);
  asm volatile("s_nop 15\n\ts_nop 15" ::: "memory"); ATT_CVT8(p0, 0, wa0, 0); ATT_CVT8(p0, 8, wa0, 2); ATT_CVT8(p1, 0, wa1, 0); ATT_CVT8(p1, 8, wa1, 2);
  ATT_SBAR(); ATT_PRE(SHM_K);
  ATT_WAITV_NV(); ATT_BARX();
#define ATT_SSTEP(j, WP0, WP1, WC0, WC1) do { \
    if ((j) + 3 < NT) { ATT_ISSUE_K(((j) + 3) & 3, ((j) + 3) * KVBLK); } \
    { const int kbo = ((j) & 3) * SHM_K, vbo = (((j) - 1) & 3) * SHM_V, kbn = (((j) + 1) & 3) * SHM_K; const v4i_att& a0 = WP0; const v4i_att& a1 = WP1; v4i_att& w0 = WC0; v4i_att& w1 = WC1; \
      ATT_STEP_BODY(if ((j) + 2 < NT) { ATT_ISSUE_V(((j) + 2) & 3, ((j) + 2) * KVBLK); }, ATT_PRE(kbn)); } \
    if ((j) + 3 < NT) ATT_WAITV_NV(); else if ((j) + 2 < NT) asm volatile("s_waitcnt vmcnt(1)" ::: "memory"); else asm volatile("s_waitcnt vmcnt(0)" ::: "memory"); \
    ATT_BARX(); } while (0)
  for (int j = 1; j + 1 < NT; j += 2) {
    ATT_SSTEP(j, wa0, wa1, wb0, wb1);
    ATT_SSTEP(j + 1, wb0, wb1, wa0, wa1);
  }
  { const int kbo = ((NT - 1) & 3) * SHM_K, vbo = ((NT - 2) & 3) * SHM_V;
    { const v4i_att& a0 = wa0; const v4i_att& a1 = wa1; v4i_att& w0 = wb0; v4i_att& w1 = wb1;
      ATT_STEP_BODY((void)0, (void)0); }
    pv_cvt<false>(o, lsum, vb0 + ((NT - 1) & 3) * SHM_V, vd0, wb0, wb1, p0, p1, wa0, wa1, bones);
    asm volatile("s_nop 15\n\ts_nop 15" ::: "memory"); }
#undef ATT_BARX
#undef ATT_SSTEP
  } else {
  f32x16 pA0, pA1, pB0, pB1; float alA, alB; bf16x8 pa0, pa1, pa2, pa3;
  ATT_WAITV_2NV(); ATT_BAR();
  qkt<Cfg, SA>(pA0, pA1, K_lds, q8, negm, r32, hi); alA = 1.f; alB = 1.f; if constexpr (!STATIC) decideSM<true>(pA0, pA1, max2f(max3f(max8(pA0, 0), max8(pA0, 8), max8(pA1, 0)), max8(pA1, 8)), m_reg, negm, alA);
  ATT_WAITV_NV(); ATT_BAR();
  int bc = 1;
#define ATT_FIN(Y0, Y1, alY) do { if constexpr (STATIC) finishU8(Y0, Y1, pa0, pa1); else finishSM<true>(Y0, Y1, alY, l_reg, pa0, pa1, pa2, pa3); } while (0)
#define ATT_STEP(j, X0, X1, mnX, alX, Y0, Y1, alY) do { const int bp = bc == 0 ? 2 : bc - 1, bn = bc == 2 ? 0 : bc + 1; \
    ATT_SBAR(); qkt<Cfg, SA>(X0, X1, K_lds + bc * SHM_K, q8, negm, r32, hi); \
    ATT_FIN(Y0, Y1, alY); ATT_QK_SCHED(); ATT_SBAR(); \
    if ((j) >= 2 && (j) + 1 < NT) { ATT_ISSUE_V(bn, ((j) + 1) * KVBLK); }     \
    {  if constexpr (STATIC) { pv_d0(o, vb0 + bp * SHM_V, vd0, pa0, pa1, pa2, pa3); rowsum16(lsum, pa0, pa1, bones); } else { const float pm_ = pv_d0_max(o, vb0 + bp * SHM_V, vd0, pa0, pa1, pa2, pa3, X0, X1); decideSM<false>(X0, X1, pm_, m_reg, negm, alX); } } \
    if ((j) + 2 < NT) asm volatile("s_waitcnt vmcnt(1)" ::: "memory"); else asm volatile("s_waitcnt vmcnt(0)" ::: "memory");     \
    ATT_BAR();                                              \
    if ((j) + 2 < NT) { ATT_ISSUE_K(bp, ((j) + 2) * KVBLK); } \
    if constexpr (!STATIC) { ATT_RESC(alX); } bc = bn; } while (0)
  for (int j = 1; j + 1 < NT; j += 2) {
    ATT_STEP(j, pB0, pB1, mnB, alB, pA0, pA1, alA);
    ATT_STEP(j + 1, pA0, pA1, mnA, alA, pB0, pB1, alB);
  }
  { const int bp = bc == 0 ? 2 : bc - 1;
    ATT_SBAR(); qkt<Cfg, SA>(pB0, pB1, K_lds + bc * SHM_K, q8, negm, r32, hi);
    ATT_FIN(pA0, pA1, alA); ATT_SBAR();
    {  if constexpr (STATIC) { pv_d0(o, vb0 + bp * SHM_V, vd0, pa0, pa1, pa2, pa3); rowsum16(lsum, pa0, pa1, bones); } else { const float pm_ = pv_d0_max(o, vb0 + bp * SHM_V, vd0, pa0, pa1, pa2, pa3, pB0, pB1); decideSM<false>(pB0, pB1, pm_, m_reg, negm, alB); } }
    if constexpr (!STATIC) { ATT_RESC(alB); }
    ATT_FIN(pB0, pB1, alB); ATT_SBAR();
    pv_d0(o, vb0 + bc * SHM_V, vd0, pa0, pa1, pa2, pa3); if constexpr (STATIC) rowsum16(lsum, pa0, pa1, bones); asm volatile("s_nop 15\n\ts_nop 15" ::: "memory"); }
  }
  float rli[16];
  if constexpr (MSUM) {
#pragma unroll
    for (int r = 0; r < 16; ++r) rli[r] = __builtin_amdgcn_rcpf(lacc[r]);
  } else { if constexpr (STATIC) { if ((lane & 7) == 0) { float* dl = li_l + ((lane & 8) ? 16 : 0) + 4 * (lane >> 4); dl[0] = lsum[0]; dl[1] = lsum[1]; dl[2] = lsum[2]; dl[3] = lsum[3]; } }
    else { if (hi == 0) li_l[r32] = l_reg; }
    asm volatile("s_waitcnt lgkmcnt(0)" ::: "memory");
#pragma unroll
    for (int r = 0; r < 16; ++r) rli[r] = __builtin_amdgcn_rcpf(li_l[crow(r, hi)]); }
  bf16* Ow = Ob + (long)(wid * QBLK) * LDO;
  const int odd = lane & 1;
#pragma unroll
  for (int r = 0; r < 16; r += 2) {
#pragma unroll
    for (int d0 = 0; d0 < 4; ++d0) {
      const float v0 = o[d0][r] * rli[r], v1 = o[d0][r + 1] * rli[r + 1];
      const float snd = odd ? v0 : v1, rcv = att_shx(snd, lane, 1);
      const unsigned w = odd ? cvtpk(rcv, v1) : cvtpk(v0, rcv);
      const int orow = crow(odd ? r + 1 : r, hi);
      *reinterpret_cast<unsigned*>(Ow + (long)orow * LDO + d0 * 32 + (r32 & ~1)) = w; } }
  ATT_BAR();
#undef ATT_ISSUE
#undef ATT_WAITV_NV
#undef ATT_WAITV_2NV
#undef ATT_BAR
#undef ATT_RESC
#undef ATT_STEP
#undef ATT_FIN
#undef ATT_CVT8
#undef ATT_CVT16
#undef ATT_RK
#undef ATT_DSR
#undef ATT_LW
#undef ATT_RV
#undef ATT_QKM
#undef ATT_PVF
#undef ATT_STEP_BODY
#undef ATT_PRE
#undef ATT_CVT1
}
}

constexpr int D = 2048, BATCH = 2, SEQ = 8192, CTX = 256, DEPTH = 4, DFF = 5632;
constexpr int SB = SEQ + CTX;
constexpr int R = BATCH * SB;
constexpr int NMOD = 6 * D;
constexpr float EPS = 1e-6f;
constexpr int NWAVES = 8;
constexpr int PH_PER_LAYER = 11, N_PHASES = 1 + DEPTH * PH_PER_LAYER;

constexpr size_t MiB = 1u << 20;
constexpr size_t WS_CTL = 0, CTL_ZERO_BYTES = 1 * MiB;
constexpr size_t WS_MOD = 1 * MiB;
constexpr size_t WS_ROPE = 2 * MiB;
constexpr size_t WS_W = 4 * MiB;
constexpr size_t SZ_W1 = (size_t)1280 * 2048 * 2, SZ_WUQ = (size_t)3072 * 512 * 2, SZ_WUKV = (size_t)4096 * 512 * 2, SZ_WO = (size_t)2048 * 2048 * 2;
constexpr size_t SZ_WQKV = (size_t)3072 * 2048 * 2, SZ_WUP = (size_t)11264 * 2048 * 2, SZ_WDN = (size_t)2048 * 5632 * 2;
constexpr size_t SZ_MLA = SZ_W1 + SZ_WUQ + SZ_WUKV + SZ_WO, SZ_GQA = SZ_WQKV + SZ_WO, SZ_FFN = SZ_WUP + SZ_WDN;
constexpr size_t WS_WMLA = WS_W, WS_WGQA = WS_WMLA + 2 * SZ_MLA, WS_WFFN = WS_WGQA + 2 * SZ_GQA, WS_WEND = WS_WFFN + 4 * SZ_FFN;
static_assert(WS_WEND <= 376 * MiB, "weights");
constexpr size_t WS_X = 376 * MiB;
constexpr size_t WS_H = 508 * MiB;
constexpr size_t WS_BIG = 576 * MiB;
constexpr size_t WS_U = WS_BIG;
constexpr size_t WS_GH = WS_BIG, WS_VH = WS_BIG + 24 * MiB;
constexpr size_t WS_ACT = 940 * MiB;
constexpr size_t WS_RAW1 = WS_BIG;
constexpr size_t WS_CQ = 660 * MiB, WS_CKV = 677 * MiB, WS_KPE = 694 * MiB;
constexpr size_t WS_QRAW = 700 * MiB;
constexpr size_t WS_KVRAW = 800 * MiB;
constexpr size_t WS_KMLA = 932 * MiB;
constexpr size_t WS_QKV = WS_BIG;
constexpr size_t WS_KGQA = 676 * MiB;
constexpr size_t WS_OGQA = 700 * MiB;
constexpr size_t WS_END = 1124 * MiB;
static_assert(WS_X + (size_t)R * D * 4 <= WS_H && WS_H + (size_t)R * D * 2 <= WS_BIG && WS_GH + (size_t)264 * 4 * 5632 * 4 <= WS_VH && WS_VH + (size_t)264 * 2 * 5632 * 4 <= WS_ACT && WS_ACT + (size_t)R * DFF * 2 <= WS_END, "ws map 1");
static_assert(WS_RAW1 + (size_t)R * 1280 * 4 <= WS_CQ && WS_CQ + (size_t)R * 512 * 2 <= WS_CKV && WS_CKV + (size_t)R * 512 * 2 <= WS_KPE && WS_KPE + (size_t)R * 64 * 2 <= WS_QRAW, "ws map 2");
static_assert(WS_QRAW + (size_t)R * 3072 * 2 <= WS_KVRAW && WS_KVRAW + (size_t)R * 4096 * 2 <= WS_KMLA && WS_KMLA + (size_t)R * 3072 * 2 <= WS_END, "ws map 3");
static_assert(WS_QKV + (size_t)R * 3072 * 2 <= WS_KGQA && WS_KGQA + (size_t)R * 512 * 2 <= WS_OGQA && WS_OGQA + (size_t)R * 2048 * 2 <= WS_END, "ws map 4");
constexpr size_t WS_PART = 800 * MiB;
constexpr int NSPLIT_WO = 8, NSPLIT_DN = 11;
constexpr size_t WS_CB = 352 * MiB;
constexpr size_t WS_STAT = 354 * MiB;
constexpr size_t WS_AV = 355 * MiB;
constexpr size_t WS_W8GQA = 360 * MiB, SZ_W8GQA = (size_t)3072 * 2048;
constexpr size_t WS_V8T_MLA = 990 * MiB, WS_V8T_GQA = 780 * MiB;
constexpr size_t WS_XS8 = 720 * MiB;
constexpr int CBN = 11264;
static_assert(WS_KMLA + (size_t)R * 3072 <= WS_V8T_MLA && WS_V8T_MLA + (size_t)2 * 16 * 128 * 8448 <= WS_END && WS_OGQA + (size_t)R * 2048 * 2 <= WS_V8T_GQA && WS_V8T_GQA + (size_t)2 * 4 * 128 * 8448 <= WS_PART, "ws map 7");
static_assert(WS_W8GQA + 2 * SZ_W8GQA <= WS_X && WS_XS8 + (size_t)R * 2048 <= WS_PART, "ws map 6");
static_assert(WS_WEND <= WS_CB && WS_CB + (size_t)8 * 3 * CBN * 4 <= WS_STAT && WS_STAT + (size_t)8 * R * 4 <= WS_AV && WS_AV + (size_t)8 * 3 * D * 4 <= WS_X, "ws map 5");
constexpr int CW_BAR = 4096;

constexpr int RING_OFF = 0, RING_BYTES = 131072;
constexpr int LDSCTL_OFF = RING_BYTES, MISC_OFF = LDSCTL_OFF + 320;
constexpr int LDS_BYTES = 147456;

struct Args {
    const float* in[28]; float* out; unsigned char* ws; int ph_lo, ph_hi, var;
};

struct Frame {
    LAS unsigned char* lds; char* ldsg;
    int tid, lane, wave, G, gw, NGW, bid;
};

__device__ __forceinline__ float shx(float v, int lane, int o) { return __builtin_bit_cast(float, __builtin_amdgcn_ds_bpermute((lane ^ o) << 2, __builtin_bit_cast(int, v))); }
__device__ __forceinline__ float wave_sum(float v, int lane) {
#pragma unroll
    for (int o = 1; o < 64; o <<= 1) v += shx(v, lane, o);
    return v;
}
__device__ __forceinline__ float sum16(float v, int lane) {
#pragma unroll
    for (int o = 1; o < 16; o <<= 1) v += shx(v, lane, o);
    return v;
}
__device__ __forceinline__ unsigned pk2(float lo, float hi) { unsigned r; asm volatile("v_cvt_pk_bf16_f32 %0, %1, %2" : "=v"(r) : "v"(lo), "v"(hi)); return r; }
__device__ __forceinline__ float bf_lo(unsigned w) { return __uint_as_float(w << 16); }
__device__ __forceinline__ float bf_hi(unsigned w) { return __uint_as_float(w & 0xffff0000u); }
__device__ __forceinline__ float silu_f(float x) { return x / (1.f + __expf(-x)); }

__device__ __forceinline__ unsigned pk4f8(float a, float b, float c, float d) { int w = 0; w = __builtin_amdgcn_cvt_pk_fp8_f32(a, b, w, false); w = __builtin_amdgcn_cvt_pk_fp8_f32(c, d, w, true); return (unsigned)w; }
constexpr float W8_SCALE = 64.0f; constexpr int W8_E8M0 = 0x79797979;
__device__ __forceinline__ void transpose_item(const float* W, int K, int N, bf16* WT, int drow0, int k0, int n0, LAS float* scr, int lane, const float* shv, float* cacc, int f8 = 0, unsigned char* WT8 = nullptr) {
#pragma unroll 8
    for (int i = 0; i < 32; ++i) { const int kk = 2 * i + (lane >> 5); scr[kk * 33 + (lane & 31)] = W[(size_t)(k0 + kk) * N + n0 + (lane & 31)]; }
    LDS_WAIT(); asm volatile("" ::: "memory");
    const int c = lane & 7;
#pragma unroll
    for (int j = 0; j < 4; ++j) { const int n = (lane >> 3) + 8 * j; const LAS float* s = scr + (8 * c) * 33 + n;
        v4u o; o.x = pk2(s[0 * 33], s[1 * 33]); o.y = pk2(s[2 * 33], s[3 * 33]); o.z = pk2(s[4 * 33], s[5 * 33]); o.w = pk2(s[6 * 33], s[7 * 33]);
        if (f8) { v2u o8; o8.x = pk4f8(s[0 * 33] * W8_SCALE, s[1 * 33] * W8_SCALE, s[2 * 33] * W8_SCALE, s[3 * 33] * W8_SCALE); o8.y = pk4f8(s[4 * 33] * W8_SCALE, s[5 * 33] * W8_SCALE, s[6 * 33] * W8_SCALE, s[7 * 33] * W8_SCALE);
            *(v2u*)((f8 == 2 ? WT8 : (unsigned char*)WT) + (size_t)(drow0 + n) * K + k0 + 8 * c) = o8; }
        if (f8 != 1) *(v4u*)(WT + (size_t)(drow0 + n) * K + k0 + 8 * c) = o; }
    if (shv) {
        const float s0 = shv[k0 + lane], s1 = shv[NMOD + k0 + lane], s2 = shv[2 * NMOD + k0 + lane];
        const int n = lane & 31; float a0 = 0.f, a1 = 0.f, a2 = 0.f;
#pragma unroll 4
        for (int kk = 0; kk < 64; ++kk) { const float w = scr[kk * 33 + n];
            a0 = fmaf(__builtin_bit_cast(float, __builtin_amdgcn_readlane(__builtin_bit_cast(int, s0), kk)), w, a0);
            a1 = fmaf(__builtin_bit_cast(float, __builtin_amdgcn_readlane(__builtin_bit_cast(int, s1), kk)), w, a1);
            a2 = fmaf(__builtin_bit_cast(float, __builtin_amdgcn_readlane(__builtin_bit_cast(int, s2), kk)), w, a2); }
        if (lane < 32) { float* cp = cacc + drow0 + n; unsafeAtomicAdd(cp, a0); unsafeAtomicAdd(cp + CBN, a1); unsafeAtomicAdd(cp + 2 * CBN, a2); }
    }
    LDS_WAIT(); asm volatile("" ::: "memory");
}
__device__ __forceinline__ int dest_row(int mode, int roff, int n0) {
    if (mode == 1) { const int h = n0 / 192, d = n0 - h * 192; return d < 128 ? h * 128 + d : 2048 + h * 64 + (d - 128); }
    if (mode == 2) { const int h = n0 >> 8, d = n0 & 255; return d < 128 ? h * 128 + d : 2048 + h * 128 + (d - 128); }
    if (mode == 3) { const int f = n0 < 5632 ? n0 : n0 - 5632; return (f >> 7) * 256 + (f & 127) + (n0 < 5632 ? 0 : 128); }
    return roff + n0;
}
__device__ __forceinline__ void transpose_matrix(const Frame& F, const float* W, int K, int N, bf16* WT, int mode, int roff, int rot, const float* shv = nullptr, float* cacc = nullptr, int f8 = 0, unsigned char* WT8 = nullptr) {
    LAS float* scr = (LAS float*)(F.lds + RING_OFF + F.wave * 16384);
    const int nblk = N / 32, items = (K / 64) * nblk;
    int g = F.gw + rot; if (g >= F.NGW) g -= F.NGW;
    for (int it = g; it < items; it += F.NGW) { const int kb = it / nblk, nb = it - kb * nblk; transpose_item(W, K, N, WT, dest_row(mode, roff, nb * 32), kb * 64, nb * 32, scr, F.lane, shv, cacc, f8, WT8); }
}

typedef const __attribute__((address_space(4))) Args* KargPtr0;
__device__ __forceinline__ void p0a_prologue(const Frame& F, KargPtr0 ap) {
    unsigned char* ws = ap->ws;
    __syncthreads();
    {
        LAS float* S = (LAS float*)(F.lds + RING_OFF);
        LAS float* P = (LAS float*)(F.lds + RING_OFF + 24576);
        for (int i = F.tid; i < 3 * D; i += 512) { const int v = i / D, k = i - v * D; const float x = v < 2 ? ap->in[1][v * D + k] : ap->in[3][k]; S[i] = silu_f(x); }
        __syncthreads();
        for (int u = F.bid; u < 256; u += F.G) {
            const int l = u >> 6, n0 = (u & 63) * 192;
            const float* Wl = ap->in[4] + (size_t)l * D * NMOD + n0 + 4 * F.lane;
            f32x4 acc0 = {0.f, 0.f, 0.f, 0.f}, acc1 = acc0, acc2 = acc0;
            if (F.lane < 48) {
                const int kb = F.wave * 256;
#pragma unroll 8
                for (int k = 0; k < 256; ++k) { const f32x4 w = *(const f32x4*)(Wl + (size_t)(kb + k) * NMOD); acc0 += w * S[kb + k]; acc1 += w * S[D + kb + k]; acc2 += w * S[2 * D + kb + k]; }
#pragma unroll
                for (int j = 0; j < 4; ++j) { P[(F.wave * 3 + 0) * 192 + 4 * F.lane + j] = acc0[j]; P[(F.wave * 3 + 1) * 192 + 4 * F.lane + j] = acc1[j]; P[(F.wave * 3 + 2) * 192 + 4 * F.lane + j] = acc2[j]; }
            }
            __syncthreads();
            for (int i = F.tid; i < 576; i += 512) { const int v = i / 192, n = i - v * 192; float s = ap->in[5][(size_t)l * NMOD + n0 + n];
#pragma unroll
                for (int w = 0; w < 8; ++w) s += P[(w * 3 + v) * 192 + n];
                ((float*)(ws + WS_MOD))[(size_t)(l * 3 + v) * NMOD + n0 + n] = s; }
            __syncthreads();
        }
    }
    {
        float* T = (float*)(ws + WS_ROPE);
        for (int i = F.bid * 512 + F.tid; i < 128 * 16 + 128 * 32; i += F.G * 512) {
            int p, j, ad, base; if (i < 128 * 16) { p = i >> 4; j = i & 15; ad = 32; base = 0; } else { const int q = i - 128 * 16; p = q >> 5; j = q & 31; ad = 64; base = 2 * 128 * 16; }
            const float e = -(float)(2 * j) / (float)ad, inv = powf(10000.0f, e), ang = (float)p * inv;
            const int J = ad / 2;
            T[base + p * J + j] = cosf(ang); T[base + 128 * J + p * J + j] = sinf(ang);
        }
    }
    { const int gt = F.bid * 512 + F.tid, NT_ = F.G * 512; const v4u z = {0u, 0u, 0u, 0u};
      for (int i = gt; i < 8 * R / 4; i += NT_) ((v4u*)(ws + WS_STAT))[i] = z;
      for (int i = gt; i < 8 * 3 * CBN / 4; i += NT_) ((v4u*)(ws + WS_CB))[i] = z;
      for (int j = 0; j < 2; ++j) { bf16* w1 = (bf16*)(ws + WS_WMLA + j * SZ_MLA); for (int i = gt; i < 192 * 2048 / 8; i += NT_) *(v4u*)(w1 + (size_t)1088 * 2048 + (size_t)i * 8) = z; } }
}
__device__ __forceinline__ void p0b_prologue(const Frame& F, KargPtr0 ap, bool dummy_cb = false) {
    unsigned char* ws = ap->ws;
    const float* MOD = (const float*)(ws + WS_MOD);
    __syncthreads();
    for (int i = F.bid * 512 + F.tid; i < 8 * 3 * D; i += F.G * 512) { const int sl = i / (3 * D), r = i - sl * 3 * D, v = r / D, k = r - v * D, layer = sl >> 1, sub = sl & 1;
        const float g = (sub ? ap->in[7] : ap->in[6])[layer * D + k], sc = MOD[(size_t)(layer * 3 + v) * NMOD + (sub ? 4 : 1) * D + k];
        ((float*)(ws + WS_AV))[i] = g * (1.f + sc); }
    for (int row = F.gw; row < R; row += F.NGW) {
        const int b = row / SB, t = row - b * SB, v = t >= SEQ ? 2 : b;
        const float* src = t < SEQ ? ap->in[0] + ((size_t)b * SEQ + t) * D : ap->in[2] + ((size_t)b * CTX + (t - SEQ)) * D;
        float* dst = (float*)(ws + WS_X) + (size_t)row * D; bf16* xs = (bf16*)(ws + WS_H) + (size_t)row * D;
        const float* gn = ap->in[6]; const float* sc = MOD + (size_t)v * NMOD + D;
        float ss = 0.f;
#pragma unroll
        for (int j = 0; j < 8; ++j) { const int c = 4 * F.lane + 256 * j; const f32x4 x = *(const f32x4*)(src + c); *(f32x4*)(dst + c) = x;
            ss += (x.x * x.x + x.y * x.y) + (x.z * x.z + x.w * x.w);
            const f32x4 y = x * *(const f32x4*)(gn + c) * (*(const f32x4*)(sc + c) + 1.f);
            v2u o; o.x = pk2(y.x, y.y); o.y = pk2(y.z, y.w); *(v2u*)(xs + c) = o; }
        ss = wave_sum(ss, F.lane);
        if (F.lane == 0) ((float*)(ws + WS_STAT))[row] = ss;
    }
    __syncthreads();
    float* CB = (float*)(ws + (dummy_cb ? WS_ACT : WS_CB));
    int rot = 0;
    for (int j = 0; j < 2; ++j) { const int layer = 2 * j;
        bf16* w1 = (bf16*)(ws + WS_WMLA + j * SZ_MLA); bf16* wuq = (bf16*)((unsigned char*)w1 + SZ_W1); bf16* wukv = (bf16*)((unsigned char*)wuq + SZ_WUQ); bf16* wo = (bf16*)((unsigned char*)wukv + SZ_WUKV);
        const float* shv = MOD + (size_t)layer * 3 * NMOD; float* cacc = CB + (size_t)(2 * layer) * 3 * CBN;
        transpose_matrix(F, ap->in[8] + (size_t)j * 2048 * 512, 2048, 512, w1, 0, 0, rot, shv, cacc); rot = (rot + 512) % F.NGW;
        transpose_matrix(F, ap->in[13] + (size_t)j * 2048 * 576, 2048, 576, w1, 0, 512, rot, shv, cacc); rot = (rot + 576) % F.NGW;
        transpose_matrix(F, ap->in[10] + (size_t)j * 512 * 3072, 512, 3072, wuq, 1, 0, rot, nullptr, nullptr, 1); rot = (rot + 768) % F.NGW;
        transpose_matrix(F, ap->in[16] + (size_t)j * 512 * 4096, 512, 4096, wukv, 2, 0, rot); rot = (rot + 1024) % F.NGW;
        transpose_matrix(F, ap->in[18] + (size_t)j * 2048 * 2048, 2048, 2048, wo, 0, 0, rot);
    }
    for (int j = 0; j < 2; ++j) { const int layer = 2 * j + 1;
        bf16* wqkv = (bf16*)(ws + WS_WGQA + j * SZ_GQA); bf16* wo = (bf16*)((unsigned char*)wqkv + SZ_WQKV);
        const float* shv = MOD + (size_t)layer * 3 * NMOD; float* cacc = CB + (size_t)(2 * layer) * 3 * CBN;
        unsigned char* w8 = ws + WS_W8GQA + j * SZ_W8GQA;
        transpose_matrix(F, ap->in[19] + (size_t)j * 2048 * 2048, 2048, 2048, wqkv, 0, 0, rot, shv, cacc, 2, w8);
        transpose_matrix(F, ap->in[21] + (size_t)j * 2048 * 1024, 2048, 1024, wqkv, 0, 2048, rot, shv, cacc, 2, w8);
        transpose_matrix(F, ap->in[23] + (size_t)j * 2048 * 2048, 2048, 2048, wo, 0, 0, rot);
    }
    for (int l = 0; l < 4; ++l) {
        bf16* wup = (bf16*)(ws + WS_WFFN + l * SZ_FFN); bf16* wdn = (bf16*)((unsigned char*)wup + SZ_WUP);
        transpose_matrix(F, ap->in[24] + (size_t)l * 2048 * 11264, 2048, 11264, wup, 3, 0, rot, MOD + (size_t)l * 3 * NMOD + 3 * D, CB + (size_t)(2 * l + 1) * 3 * CBN);
        transpose_matrix(F, ap->in[27] + (size_t)l * 5632 * 2048, 5632, 2048, wdn, 0, 0, rot);
    }
}

__device__ __forceinline__ void ctx_finalize_phase(const Frame& F, float* X, bf16* XS, float* stat, const float* av, const float* P, int nsplit, unsigned char* XS8) {
    LAS float* red = (LAS float*)(F.lds + RING_OFF);
    for (int pr = F.bid; pr < CTX; pr += F.G) {
        const int q = pr * 2 + (F.wave >> 2), b = q >> 8, row = b * SB + SEQ + (q & 255), c0 = (F.wave & 3) * 512 + 4 * F.lane;
        const float* a = av + 2 * D;
        float* xr = X + (size_t)row * D + c0;
        f32x4 x0 = *(const f32x4*)xr, x1 = *(const f32x4*)(xr + 256);
        for (int s = 0; s < nsplit; ++s) { const float* pp = P + ((size_t)s * 512 + q) * D + c0; x0 += *(const f32x4*)pp; x1 += *(const f32x4*)(pp + 256); }
        *(f32x4*)xr = x0; *(f32x4*)(xr + 256) = x1;
        const float ssw = wave_sum((x0.x * x0.x + x0.y * x0.y) + (x0.z * x0.z + x0.w * x0.w) + (x1.x * x1.x + x1.y * x1.y) + (x1.z * x1.z + x1.w * x1.w), F.lane);
        if (F.lane == 0) red[F.wave] = ssw;
        const f32x4 y0 = x0 * *(const f32x4*)(a + c0), y1 = x1 * *(const f32x4*)(a + c0 + 256);
        bf16* hr = XS + (size_t)row * D + c0;
        v2u o0, o1; o0.x = pk2(y0.x, y0.y); o0.y = pk2(y0.z, y0.w); o1.x = pk2(y1.x, y1.y); o1.y = pk2(y1.z, y1.w);
        *(v2u*)hr = o0; *(v2u*)(hr + 256) = o1;
        if (XS8) { unsigned char* h8 = XS8 + (size_t)row * D + c0; *(unsigned*)h8 = pk4f8(y0.x, y0.y, y0.z, y0.w); *(unsigned*)(h8 + 256) = pk4f8(y1.x, y1.y, y1.z, y1.w); }
        __syncthreads();
        if ((F.wave & 3) == 0 && F.lane == 0) { const int w0 = F.wave; stat[row] = (red[w0] + red[w0 + 1]) + (red[w0 + 2] + red[w0 + 3]); }
        __syncthreads();
    }
}
__device__ __forceinline__ void mla_norm_phase(const Frame& F, const float* RAW, bf16* CQ, bf16* CKV, bf16* KPE, const float* g_dq, const float* g_dkv, const float* g_kpe, const float* ropeM) {
    for (int row = F.gw; row < R; row += F.NGW) {
        const int b = row / SB, t = row - b * SB;
        const float* rr = RAW + (size_t)row * 1280;
#pragma unroll
        for (int part = 0; part < 2; ++part) {
            const float* src = rr + part * 512 + 4 * F.lane; const float* g = (part ? g_dkv : g_dq) + 4 * F.lane; bf16* dst = (part ? CKV : CQ) + (size_t)row * 512 + 4 * F.lane;
            const f32x4 a0 = *(const f32x4*)src, a1 = *(const f32x4*)(src + 256);
            const float ss = wave_sum((a0.x * a0.x + a0.y * a0.y) + (a0.z * a0.z + a0.w * a0.w) + (a1.x * a1.x + a1.y * a1.y) + (a1.z * a1.z + a1.w * a1.w), F.lane);
            const float r = rsqrtf(ss * (1.f / 512.f) + EPS);
            const f32x4 y0 = a0 * r * *(const f32x4*)g, y1 = a1 * r * *(const f32x4*)(g + 256);
            if (part) { v2u o0, o1; o0.x = pk2(y0.x, y0.y); o0.y = pk2(y0.z, y0.w); o1.x = pk2(y1.x, y1.y); o1.y = pk2(y1.z, y1.w); *(v2u*)dst = o0; *(v2u*)(dst + 256) = o1; }
            else { unsigned char* d8 = (unsigned char*)CQ + (size_t)row * 512 + 4 * F.lane;
                *(unsigned*)d8 = pk4f8(y0.x, y0.y, y0.z, y0.w); *(unsigned*)(d8 + 256) = pk4f8(y1.x, y1.y, y1.z, y1.w); }
        }
        const int e = F.lane; const float x = rr[1024 + e];
        const float r = rsqrtf(wave_sum(x * x, F.lane) * (1.f / 64.f) + EPS);
        float y = x * r * g_kpe[e];
        const float yp = shx(y, F.lane, 16);
        if (t < SEQ) { const int j = e & 15, p = e < 32 ? (t >> 6) : (t & 63); const float c = ropeM[p * 16 + j], s = ropeM[128 * 16 + p * 16 + j];
            y = (e & 16) ? (y * c + yp * s) : (y * c - yp * s); }
        KPE[(size_t)row * 64 + e] = (bf16)(pk2(y, y) & 0xffffu);
    }
}
typedef float v16f_t __attribute__((ext_vector_type(16)));
typedef unsigned v6u_t __attribute__((ext_vector_type(6)));
constexpr float K6_SCALE = 2.0f;
__device__ __forceinline__ void st24(unsigned char* dst, const v6u_t& o) { v4u a; a.x = o[0]; a.y = o[1]; a.z = o[2]; a.w = o[3]; v2u b; b.x = o[4]; b.y = o[5]; *(v4u*)dst = a; *(v2u*)(dst + 16) = b; }
__device__ __forceinline__ void unpack16(const bf16* src, v16f_t& f) { const v4u w0 = *(const v4u*)src, w1 = *(const v4u*)(src + 8);
    f[0] = bf_lo(w0.x); f[1] = bf_hi(w0.x); f[2] = bf_lo(w0.y); f[3] = bf_hi(w0.y); f[4] = bf_lo(w0.z); f[5] = bf_hi(w0.z); f[6] = bf_lo(w0.w); f[7] = bf_hi(w0.w);
    f[8] = bf_lo(w1.x); f[9] = bf_hi(w1.x); f[10] = bf_lo(w1.y); f[11] = bf_hi(w1.y); f[12] = bf_lo(w1.z); f[13] = bf_hi(w1.z); f[14] = bf_lo(w1.w); f[15] = bf_hi(w1.w); }
__device__ __forceinline__ void mla_kbuild_phase(const Frame& F, const bf16* KVRAW, const bf16* KPE, unsigned char* K, const float* g_kn) {
    const int h = F.lane >> 2, blk = F.lane & 3;
    v16f_t ga, gb;
#pragma unroll
    for (int i = 0; i < 16; ++i) { ga[i] = g_kn[32 * blk + i]; gb[i] = g_kn[32 * blk + 16 + i]; }
    for (int row = F.gw; row < R; row += F.NGW) {
        v16f_t fa, fb; unpack16(KVRAW + (size_t)row * 4096 + h * 128 + 32 * blk, fa); unpack16(KVRAW + (size_t)row * 4096 + h * 128 + 32 * blk + 16, fb);
        float ss = 0.f;
#pragma unroll
        for (int i = 0; i < 16; ++i) ss += fa[i] * fa[i] + fb[i] * fb[i];
        ss += shx(ss, F.lane, 1); ss += shx(ss, F.lane, 2);
        const float r = rsqrtf(ss * (1.f / 128.f) + EPS) * K6_SCALE;
#pragma unroll
        for (int i = 0; i < 16; ++i) { fa[i] *= r * ga[i]; fb[i] *= r * gb[i]; }
        st24(K + (size_t)row * 3072 + h * 192 + 32 * blk, __builtin_amdgcn_cvt_scalef32_2xpk16_fp6_f32(fa, fb, 1.0f));
        if (F.lane < 32) { const int h2 = F.lane >> 1, b2 = F.lane & 1;
            v16f_t pa, pb; unpack16(KPE + (size_t)row * 64 + 32 * b2, pa); unpack16(KPE + (size_t)row * 64 + 32 * b2 + 16, pb);
#pragma unroll
            for (int i = 0; i < 16; ++i) { pa[i] *= K6_SCALE; pb[i] *= K6_SCALE; }
            st24(K + (size_t)row * 3072 + h2 * 192 + 128 + 32 * b2, __builtin_amdgcn_cvt_scalef32_2xpk16_fp6_f32(pa, pb, 1.0f)); }
    }
}
__device__ __forceinline__ void gqa_knorm_phase(const Frame& F, const bf16* QKV, unsigned char* K, const float* g_k, const float* ropeG) {
    const int blk = F.lane & 3, kh = (F.lane >> 2) & 3, rr = F.lane >> 4, s_ = blk >> 1, hi = blk & 1, da = 64 * s_ + 16 * hi, db = da + 32;
    v16f_t ga, gb;
#pragma unroll
    for (int i = 0; i < 16; ++i) { ga[i] = g_k[da + i]; gb[i] = g_k[db + i]; }
    for (int row0 = F.gw * 4; row0 < R; row0 += F.NGW * 4) {
        const int row = row0 + rr, b = row / SB, t = row - b * SB;
        const bf16* src = QKV + (size_t)row * 3072 + 2048 + kh * 128;
        v16f_t fa, fb; unpack16(src + da, fa); unpack16(src + db, fb);
        float ss = 0.f;
#pragma unroll
        for (int i = 0; i < 16; ++i) ss += fa[i] * fa[i] + fb[i] * fb[i];
        ss += shx(ss, F.lane, 1); ss += shx(ss, F.lane, 2);
        const float r = rsqrtf(ss * (1.f / 128.f) + EPS) * K6_SCALE;
#pragma unroll
        for (int i = 0; i < 16; ++i) { fa[i] *= r * ga[i]; fb[i] *= r * gb[i]; }
        if (t < SEQ) { const int p = s_ == 0 ? (t >> 6) : (t & 63); const float* cs = ropeG + p * 32 + 16 * hi; const float* sn = ropeG + 128 * 32 + p * 32 + 16 * hi;
#pragma unroll
            for (int i = 0; i < 16; ++i) { const float c = cs[i], sv = sn[i], x = fa[i], y = fb[i]; fa[i] = x * c - y * sv; fb[i] = y * c + x * sv; } }
        st24(K + (size_t)row * 512 + kh * 128 + 64 * s_ + 32 * hi, __builtin_amdgcn_cvt_scalef32_2xpk16_fp6_f32(fa, fb, 1.0f));
    }
}
__device__ __forceinline__ void tr4x4(unsigned a0, unsigned a1, unsigned a2, unsigned a3, unsigned* t) {
    const unsigned x0 = __builtin_amdgcn_perm(a1, a0, 0x05010400u), x1 = __builtin_amdgcn_perm(a1, a0, 0x07030602u), y0 = __builtin_amdgcn_perm(a3, a2, 0x05010400u), y1 = __builtin_amdgcn_perm(a3, a2, 0x07030602u);
    t[0] = __builtin_amdgcn_perm(y0, x0, 0x05040100u); t[1] = __builtin_amdgcn_perm(y0, x0, 0x07060302u); t[2] = __builtin_amdgcn_perm(y1, x1, 0x05040100u); t[3] = __builtin_amdgcn_perm(y1, x1, 0x07060302u);
}
__device__ __forceinline__ void v8t_items(const Frame& F, const bf16* Vsrc, int ldv, int vcol0, int nkv, unsigned char* V8T) {
    LAS unsigned char* scr = F.lds + RING_OFF + F.wave * 16384;
    const int l16 = F.lane & 15, kq = F.lane >> 4;
    for (int it = F.gw; it < BATCH * nkv * (SB / 64); it += F.NGW) {
        const int tile = it % (SB / 64), bh = it / (SB / 64), kvh = bh % nkv, b = bh / nkv;
        const bf16* src = Vsrc + (size_t)(b * SB + tile * 64 + 4 * kq) * ldv + vcol0 + kvh * 128 + l16 * 8;
        v4u wl[16];
#pragma unroll
        for (int i = 0; i < 16; ++i) wl[i] = *(const v4u*)(src + (size_t)(16 * (i >> 2) + (i & 3)) * ldv);
        asm volatile("" ::: "memory");
#pragma unroll
        for (int g = 0; g < 4; ++g) { unsigned lo[4], hi[4], t[8];
#pragma unroll
            for (int j = 0; j < 4; ++j) { const v4u w = wl[4 * g + j]; lo[j] = pk4f8(bf_lo(w.x), bf_hi(w.x), bf_lo(w.y), bf_hi(w.y)); hi[j] = pk4f8(bf_lo(w.z), bf_hi(w.z), bf_lo(w.w), bf_hi(w.w)); }
            tr4x4(lo[0], lo[1], lo[2], lo[3], t); tr4x4(hi[0], hi[1], hi[2], hi[3], t + 4);
            const int q = 4 * g + kq, sdw = 8 * (q & 1) + 4 * (q >> 3) + ((q & 7) >> 1);
            LAS unsigned* p = (LAS unsigned*)(scr + (l16 * 8) * 64 + 4 * sdw);
#pragma unroll
            for (int e = 0; e < 8; ++e) p[16 * e] = t[e]; }
        LDS_WAIT(); asm volatile("" ::: "memory");
#pragma unroll
        for (int k = 0; k < 8; ++k) { const int d = 16 * k + (F.lane >> 2), c = F.lane & 3;
            *(v4u*)(V8T + ((size_t)bh * 128 + d) * 8448 + tile * 64 + c * 16) = *(const LAS v4u*)(scr + d * 64 + c * 16); }
        LDS_WAIT(); asm volatile("" ::: "memory");
    }
}
__device__ __forceinline__ void conv_fix_phase(const Frame& F, const float* GH, const float* VH, bf16* ACT, const float* cw, const float* cb, bool skip_ctx) {
    constexpr int NCG = DFF / 512, NST = R / 64;
    for (int it = F.gw; it < NST * 2 * NCG; it += F.NGW) {
        const int cg = it % NCG, se = it / NCG, sid = se >> 1, lastedge = se & 1, f0 = cg * 512 + F.lane * 8;
        const int row = sid * 64 + (lastedge ? 63 : 0), t = row % SB;
        if (skip_ctx && t >= SEQ) continue;
        const bool zp = !lastedge && (t == 0 || t == SEQ), zn = lastedge && (t == SEQ - 1 || t == SB - 1);
        const float* gp = lastedge ? GH + ((size_t)sid * 4 + 2) * DFF : GH + ((size_t)sid * 4 - 1) * DFF;
        const float* gc = GH + ((size_t)sid * 4 + (lastedge ? 3 : 0)) * DFF;
        const float* gn = lastedge ? GH + ((size_t)sid * 4 + 4) * DFF : GH + ((size_t)sid * 4 + 1) * DFF;
        const float* vp = VH + ((size_t)sid * 2 + lastedge) * DFF;
        float o[8];
#pragma unroll
        for (int h = 0; h < 2; ++h) {
            const int f = f0 + 4 * h;
            const f32x4 z = {0.f, 0.f, 0.f, 0.f};
            const f32x4 p = zp ? z : *(const f32x4*)(gp + f), c = *(const f32x4*)(gc + f), n = zn ? z : *(const f32x4*)(gn + f), v = *(const f32x4*)(vp + f);
            const f32x4 w0 = *(const f32x4*)(cw + f), w1 = *(const f32x4*)(cw + DFF + f), w2 = *(const f32x4*)(cw + 2 * DFF + f), b = *(const f32x4*)(cb + f);
#pragma unroll
            for (int i = 0; i < 4; ++i) { const float a = fmaf(w0[i], p[i], fmaf(w1[i], c[i], fmaf(w2[i], n[i], b[i]))); o[4 * h + i] = a * __builtin_amdgcn_rcpf(1.f + __builtin_amdgcn_exp2f(a * -1.4426950408889634f)) * v[i]; }
        }
        v4u ow; ow.x = pk2(o[0], o[1]); ow.y = pk2(o[2], o[3]); ow.z = pk2(o[4], o[5]); ow.w = pk2(o[6], o[7]);
        *(v4u*)(ACT + (size_t)row * DFF + f0) = ow;
    }
}

#ifndef UP_PROBE
#define UP_PROBE 0
#endif
#ifndef PROBE_EXTRA
#define PROBE_EXTRA 0
#endif
#ifndef ATT_STATIC_MAX
#define ATT_STATIC_MAX 29
#endif
#ifndef ATT_FALLBACK
#define ATT_FALLBACK 1
#endif
template <class Cfg>
__device__ __forceinline__ void attention_phase(const Frame& F, const bf16* Q, const unsigned char* K, const unsigned char* V8T, bf16* O, const float* gq_n, const float* gq_p, const float* gk_n, const float* gk_p, const float* rope_tab, bool with_ctx, int var_in) {
    constexpr int QPE = Cfg::MLA ? 2048 : 0, KHD = Cfg::KROWB;
    float mbound;
    { float a = fmaxf(fabsf(gq_n[F.lane]), fabsf(gq_n[64 + F.lane])), b = fmaxf(fabsf(gk_n[F.lane]), fabsf(gk_n[64 + F.lane])), c = 0.f, d = 0.f;
      if constexpr (Cfg::MLA) { c = fabsf(gq_p[F.lane]); d = fabsf(gk_p[F.lane]); }
#pragma unroll
      for (int o = 1; o < 64; o <<= 1) { a = fmaxf(a, shx(a, F.lane, o)); b = fmaxf(b, shx(b, F.lane, o)); if constexpr (Cfg::MLA) { c = fmaxf(c, shx(c, F.lane, o)); d = fmaxf(d, shx(d, F.lane, o)); } }
      const float qn2 = 128.f * a * a + (Cfg::MLA ? 64.f * c * c : 0.f), kn2 = 128.f * b * b + (Cfg::MLA ? 64.f * d * d : 0.f);
      mbound = 1.20f * Cfg::SCALE * 1.4426950408889634f * sqrtf(qn2 * kn2) + 0.5f; }
    const bool use_static = __builtin_amdgcn_readfirstlane((mbound <= ATT_STATIC_MAX) ? 1 : 0) != 0;
    const int var = PROBE_EXTRA ? __builtin_amdgcn_readfirstlane(var_in) : 0;
    const int c = F.bid;
    const int nlat = (F.G == 256) ? 4 : (1024 - c + F.G - 1) / F.G;
    const int ntot = nlat + ((with_ctx && c < 32) ? 1 : 0);
    for (int i = 0; i < ntot; ++i) {
        int bh, qb, seq, t0; size_t row0, krow0;
        if (i < nlat) {
            if (F.G == 256) { bh = i * 8 + (c & 7); qb = c >> 3; }
            else { const int L = i * F.G + c; bh = L >> 5; qb = L & 31; }
            const int b = bh >> 4; row0 = (size_t)b * SB + qb * 256; krow0 = (size_t)b * SB; seq = SB; t0 = qb * 256;
        } else { bh = c; const int b = bh >> 4; row0 = (size_t)b * SB + SEQ; krow0 = row0; seq = CTX; t0 = -1; }
        const int h = bh & 15, kvh = Cfg::MLA ? h : (h >> 2), b_ = bh >> 4;
        if (use_static || !ATT_FALLBACK)
            att::attn_unit<Cfg, true>(Q + row0 * Cfg::LDQ + h * 128, Q + row0 * Cfg::LDQ + QPE + h * 64, K + krow0 * Cfg::LDK + kvh * KHD, V8T + (size_t)((b_ * (Cfg::MLA ? 16 : 4) + kvh) * 128) * Cfg::LDVT + (i < nlat ? 0 : SEQ),
                            O + row0 * Cfg::LDO + h * 128, seq, F.lds + RING_OFF, F.ldsg + RING_OFF, t0, gq_n, gq_p, rope_tab, mbound, F.wave, var);
        else
            att::attn_unit<Cfg, false>(Q + row0 * Cfg::LDQ + h * 128, Q + row0 * Cfg::LDQ + QPE + h * 64, K + krow0 * Cfg::LDK + kvh * KHD, V8T + (size_t)((b_ * (Cfg::MLA ? 16 : 4) + kvh) * 128) * Cfg::LDVT + (i < nlat ? 0 : SEQ),
                            O + row0 * Cfg::LDO + h * 128, seq, F.lds + RING_OFF, F.ldsg + RING_OFF, t0, gq_n, gq_p, rope_tab, mbound, F.wave, var);
    }
}

#ifndef REP_ATT
#define REP_ATT 1
#endif
#ifndef REP_GBF
#define REP_GBF 1
#endif
#ifndef REP_GRES
#define REP_GRES 1
#endif
#ifndef REP_THIN
#define REP_THIN 1
#endif
#ifndef REP_PRO
#define REP_PRO 1
#endif
#ifndef REP_CONV
#define REP_CONV 1
#endif
#ifndef REP_MOD
#define REP_MOD 1
#endif
#ifndef REP_BAR
#define REP_BAR 1
#endif
#ifndef EN_ATT_MLA
#define EN_ATT_MLA 1
#endif
#ifndef EN_ATT_GQA
#define EN_ATT_GQA 1
#endif
#ifndef EN_GEMM
#define EN_GEMM 63
#endif
#ifndef EN_THIN
#define EN_THIN 1
#endif
typedef const __attribute__((address_space(4))) Args* KargPtr;
__device__ __forceinline__ KargPtr kargs() { KargPtr p = (KargPtr)__builtin_amdgcn_kernarg_segment_ptr(); asm volatile("" : "+s"(p)); return p; }

__global__ void __launch_bounds__(NWAVES * 64, 2) fwd_kernel(Args args_unused) {
    extern __shared__ __attribute__((aligned(16))) unsigned char lds[];
#define MKFRAME() Frame F; { int t_; asm volatile("v_mbcnt_lo_u32_b32 %0, -1, 0\n\tv_mbcnt_hi_u32_b32 %0, -1, %0" : "=&v"(t_)); t_ |= wave_s << 6;     F.lds = (LAS unsigned char*)lds; F.ldsg = (char*)lds; F.tid = t_; F.lane = t_ & 63; F.wave = wave_s; \
    F.bid = blockIdx.x; asm volatile("" : "+s"(F.bid)); F.G = gridDim.x; F.gw = F.bid * NWAVES + F.wave; F.NGW = F.G * NWAVES; }
    LAS unsigned char* const ldsl = (LAS unsigned char*)lds;
    const int wave_s = __builtin_amdgcn_readfirstlane(threadIdx.x >> 6);
    for (int u = threadIdx.x; u < (LDS_BYTES - LDSCTL_OFF) / 4; u += NWAVES * 64) ((LAS unsigned*)(ldsl + LDSCTL_OFF))[u] = 0u;
    __syncthreads();
    const int lo = kargs()->ph_lo, hi = kargs()->ph_hi;
    if (hi - lo > 1) { MKFRAME(); (void)xcd_barrier_post((unsigned*)(kargs()->ws + WS_CTL) + CW_BAR, (volatile LAS unsigned*)(ldsl + MISC_OFF) + 8, F.tid); }
#define IN(k) (lo <= (k) && (k) < hi)
#define SEAM(k) do { if (IN(k) && IN((k) + 1)) { MKFRAME(); XcdBarrier bar_; bar_.tid = F.tid; bar_.bar = (unsigned*)(kargs()->ws + WS_CTL) + CW_BAR; bar_.x = xb_xcc_id(); bar_.st = (volatile LAS unsigned*)(ldsl + MISC_OFF) + 8; _Pragma("unroll 1") for (int rb_ = 0; rb_ < REP_BAR; ++rb_) xcd_barrier(bar_); } } while (0)
#define WSP(off) (kargs()->ws + (off))

    if (EN_THIN && IN(0)) { MKFRAME(); p0a_prologue(F, kargs()); } SEAM(0);

    for (int layer = 0; layer < DEPTH; ++layer) {
        const int pb = 1 + layer * PH_PER_LAYER, j = layer >> 1; const bool mla = (layer & 1) == 0, last = layer == DEPTH - 1;
        if (EN_THIN && IN(pb + 0)) { MKFRAME(); KargPtr a = kargs(); unsigned char* ws = a->ws;
            if (layer == 0) { if (REP_PRO > 1) p0b_prologue(F, a, true); p0b_prologue(F, a); }
            else ctx_finalize_phase(F, (float*)(ws + WS_X), (bf16*)(ws + WS_H), (float*)(ws + WS_STAT) + (size_t)(2 * layer) * R, (const float*)(ws + WS_AV) + (size_t)(2 * layer) * 3 * D, (const float*)(ws + WS_PART), NSPLIT_DN, mla ? nullptr : ws + WS_XS8); }
        SEAM(pb + 0);
        if (mla) {
            if ((EN_GEMM & 1) && IN(pb + 1)) {
                MKFRAME(); unsigned char* ws = WSP(0);
                pg8::Gemm g{(const bf16*)(ws + WS_H), (const bf16*)(ws + WS_WMLA + j * SZ_MLA), R, 1280, 2048}; pg8::PanelOrder S; S.init2(1280, 2048, F.G, F.bid, 0);
                pg8::EpiF32 E{(float*)(ws + WS_RAW1), 1280, (const float*)(ws + WS_STAT) + (size_t)(2 * layer) * R, (const float*)(ws + WS_CB) + (size_t)(2 * layer) * 3 * CBN};
                _Pragma("unroll 1") for (int rp_ = 0; rp_ < REP_GBF; ++rp_) pg8::gemm_phase<pg8::EpiF32, pg8::PanelOrder, true, true>(F.lds + RING_OFF, g, S, E, F.wave);
            }
            SEAM(pb + 1);
            if (EN_THIN && IN(pb + 2)) { MKFRAME(); KargPtr a = kargs(); unsigned char* ws = a->ws;
                _Pragma("unroll 1") for (int rp_ = 0; rp_ < REP_THIN; ++rp_) mla_norm_phase(F, (const float*)(ws + WS_RAW1), (bf16*)(ws + WS_CQ), (bf16*)(ws + WS_CKV), (bf16*)(ws + WS_KPE), a->in[9] + j * 512, a->in[14] + j * 512, a->in[15] + j * 64, (const float*)(ws + WS_ROPE)); }
            SEAM(pb + 2);
            if ((EN_GEMM & 2) && IN(pb + 3)) {
                { MKFRAME(); unsigned char* ws = WSP(0);
                  pg8::Gemm g{(const bf16*)(ws + WS_CQ), (const bf16*)(ws + WS_WMLA + j * SZ_MLA + SZ_W1), R, 3072, 256, W8_E8M0, 0x7f7f7f7f}; pg8::PanelOrder S; S.init2(3072, 256, F.G, F.bid, 0);
                  pg8::EpiBf16 E{(bf16*)(ws + WS_QRAW), 3072, nullptr, nullptr};
                  _Pragma("unroll 1") for (int rp_ = 0; rp_ < REP_GBF; ++rp_) pg8::gemm_phase<pg8::EpiBf16, pg8::PanelOrder, true, true, true>(F.lds + RING_OFF, g, S, E, F.wave); }
                { MKFRAME(); unsigned char* ws = WSP(0);
                  pg8::Gemm g{(const bf16*)(ws + WS_CKV), (const bf16*)(ws + WS_WMLA + j * SZ_MLA + SZ_W1 + SZ_WUQ), R, 4096, 512}; pg8::PanelOrder S; S.init2(4096, 512, F.G, F.bid, 0);
                  pg8::EpiBf16 E{(bf16*)(ws + WS_KVRAW), 4096, nullptr, nullptr};
                  _Pragma("unroll 1") for (int rp_ = 0; rp_ < REP_GBF; ++rp_) pg8::gemm_phase<pg8::EpiBf16, pg8::PanelOrder, true, true>(F.lds + RING_OFF, g, S, E, F.wave); }
            }
            SEAM(pb + 3);
            if (EN_THIN && IN(pb + 4)) { MKFRAME(); KargPtr a = kargs(); unsigned char* ws = a->ws; _Pragma("unroll 1") for (int rp_ = 0; rp_ < REP_THIN; ++rp_) { mla_kbuild_phase(F, (const bf16*)(ws + WS_KVRAW), (const bf16*)(ws + WS_KPE), (unsigned char*)(ws + WS_KMLA), a->in[17] + j * 128); v8t_items(F, (const bf16*)(ws + WS_KVRAW), 4096, 2048, 16, ws + WS_V8T_MLA); } }
            SEAM(pb + 4);
            if (EN_ATT_MLA && IN(pb + 5)) { MKFRAME(); KargPtr a = kargs(); unsigned char* ws = a->ws; __syncthreads();
                _Pragma("unroll 1") for (int rp_ = 0; rp_ < REP_ATT; ++rp_)
                attention_phase<att::CfgMLA>(F, (const bf16*)(ws + WS_QRAW), (const unsigned char*)(ws + WS_KMLA), (const unsigned char*)(ws + WS_V8T_MLA), (bf16*)(ws + WS_RAW1), a->in[11] + j * 128, a->in[12] + j * 64, a->in[17] + j * 128, a->in[15] + j * 64, (const float*)(ws + WS_ROPE), !last, PROBE_EXTRA ? a->var : 0); }
            SEAM(pb + 5);
        } else {
            if ((EN_GEMM & 4) && IN(pb + 1)) {
                { MKFRAME(); unsigned char* ws = WSP(0);
                  pg8::Gemm g{(const bf16*)(ws + WS_XS8), (const bf16*)(ws + WS_W8GQA + j * SZ_W8GQA), R, 2560, 1024, W8_E8M0, 0x7f7f7f7f}; pg8::PanelOrder S; S.init2(2560, 1024, F.G, F.bid, 0);
                  pg8::EpiBf16 E{(bf16*)(ws + WS_QKV), 3072, (const float*)(ws + WS_STAT) + (size_t)(2 * layer) * R, (const float*)(ws + WS_CB) + (size_t)(2 * layer) * 3 * CBN};
                  pg8::gemm_phase<pg8::EpiBf16, pg8::PanelOrder, true, true, true>(F.lds + RING_OFF, g, S, E, F.wave); }
                { MKFRAME(); unsigned char* ws = WSP(0);
                  pg8::Gemm g{(const bf16*)(ws + WS_H), (const bf16*)(ws + WS_WGQA + j * SZ_GQA) + (size_t)2560 * 2048, R, 512, 2048}; pg8::PanelOrder S; S.init2(512, 2048, F.G, F.bid, 0);
                  pg8::EpiBf16 E{(bf16*)(ws + WS_QKV) + 2560, 3072, (const float*)(ws + WS_STAT) + (size_t)(2 * layer) * R, (const float*)(ws + WS_CB) + (size_t)(2 * layer) * 3 * CBN + 2560};
                  pg8::gemm_phase<pg8::EpiBf16, pg8::PanelOrder, true, true>(F.lds + RING_OFF, g, S, E, F.wave); }
            }
            SEAM(pb + 1);
            if (EN_THIN && IN(pb + 2)) { MKFRAME(); KargPtr a = kargs(); unsigned char* ws = a->ws; _Pragma("unroll 1") for (int rp_ = 0; rp_ < REP_THIN; ++rp_) { gqa_knorm_phase(F, (const bf16*)(ws + WS_QKV), (unsigned char*)(ws + WS_KGQA), a->in[22] + j * 128, (const float*)(ws + WS_ROPE) + 2 * 128 * 16); v8t_items(F, (const bf16*)(ws + WS_QKV), 3072, 2560, 4, ws + WS_V8T_GQA); } }
            SEAM(pb + 2);
            if (EN_ATT_GQA && IN(pb + 5)) { MKFRAME(); KargPtr a = kargs(); unsigned char* ws = a->ws; __syncthreads();
                _Pragma("unroll 1") for (int rp_ = 0; rp_ < REP_ATT; ++rp_)
                attention_phase<att::CfgGQA>(F, (const bf16*)(ws + WS_QKV), (const unsigned char*)(ws + WS_KGQA), (const unsigned char*)(ws + WS_V8T_GQA), (bf16*)(ws + WS_OGQA), a->in[20] + j * 128, nullptr, a->in[22] + j * 128, nullptr, (const float*)(ws + WS_ROPE) + 2 * 128 * 16, !last, PROBE_EXTRA ? a->var : 0); }
            SEAM(pb + 5);
        }
        if ((EN_GEMM & 8) && IN(pb + 6)) {
            MKFRAME(); unsigned char* ws = WSP(0);
            const bf16* wo = mla ? (const bf16*)(ws + WS_WMLA + j * SZ_MLA + SZ_W1 + SZ_WUQ + SZ_WUKV) : (const bf16*)(ws + WS_WGQA + j * SZ_GQA + SZ_WQKV);
            const bf16* O = mla ? (const bf16*)(ws + WS_RAW1) : (const bf16*)(ws + WS_OGQA);
            pg8::Gemm g{O, wo, R, 2048, 2048}; pg8::ResOrder S; S.init2(2048, F.G, F.bid, last ? 0 : NSPLIT_WO);
            pg8::EpiRes E{(const float*)(ws + WS_X), (float*)(ws + WS_X), (const float*)(ws + WS_MOD) + (size_t)layer * 3 * NMOD + 2 * D, 0, (float*)(ws + WS_PART), 2048 / 64,
                          (bf16*)(ws + WS_H), (const float*)(ws + WS_AV) + (size_t)(2 * layer + 1) * 3 * D, (float*)(ws + WS_STAT) + (size_t)(2 * layer + 1) * R, nullptr};
            pg8::gemm_phase<pg8::EpiRes, pg8::ResOrder, true, true>(F.lds + RING_OFF, g, S, E, F.wave);
        }
        SEAM(pb + 6);
        if (EN_THIN && IN(pb + 7) && !last) { MKFRAME(); KargPtr a = kargs(); unsigned char* ws = a->ws;
            ctx_finalize_phase(F, (float*)(ws + WS_X), (bf16*)(ws + WS_H), (float*)(ws + WS_STAT) + (size_t)(2 * layer + 1) * R, (const float*)(ws + WS_AV) + (size_t)(2 * layer + 1) * 3 * D, (const float*)(ws + WS_PART), NSPLIT_WO, nullptr); }
        if (!last) SEAM(pb + 7);
        if ((EN_GEMM & 16) && IN(pb + 8)) {
            MKFRAME(); KargPtr ka_ = kargs(); unsigned char* ws = ka_->ws;
            pg8::Gemm g{(const bf16*)(ws + WS_H), (const bf16*)(ws + WS_WFFN + layer * SZ_FFN), R, 11264, 2048}; pg8::PanelOrder S; S.init2(11264, 2048, F.G, F.bid, last ? 1 : 0);
            pg8::EpiConv E{(bf16*)(ws + WS_ACT), (float*)(ws + WS_GH), (float*)(ws + WS_VH), ka_->in[25] + (size_t)layer * 3 * DFF, ka_->in[26] + (size_t)layer * DFF,
                           (const float*)(ws + WS_STAT) + (size_t)(2 * layer + 1) * R, (const float*)(ws + WS_CB) + (size_t)(2 * layer + 1) * 3 * CBN};
            if (UP_PROBE == 1) { pg8::EpiConv E2 = E; pg8::gemm_phase<pg8::EpiConv, pg8::PanelOrder, true, true>(F.lds + RING_OFF, g, S, E2, F.wave); }
            if (UP_PROBE == 2) { pg8::EpiBf16 E3{(bf16*)(ws + WS_PART), 11264, nullptr, nullptr}; pg8::gemm_phase<pg8::EpiBf16, pg8::PanelOrder, true, true>(F.lds + RING_OFF, g, S, E3, F.wave); }
            _Pragma("unroll 1") for (int rp_ = 0; rp_ < REP_GBF; ++rp_) pg8::gemm_phase<pg8::EpiConv, pg8::PanelOrder, true, true>(F.lds + RING_OFF, g, S, E, F.wave);
        }
        SEAM(pb + 8);
        if (EN_THIN && IN(pb + 9)) { MKFRAME(); KargPtr a = kargs(); _Pragma("unroll 1") for (int rp_ = 0; rp_ < REP_CONV; ++rp_) conv_fix_phase(F, (const float*)(a->ws + WS_GH), (const float*)(a->ws + WS_VH), (bf16*)(a->ws + WS_ACT), a->in[25] + (size_t)layer * 3 * DFF, a->in[26] + (size_t)layer * DFF, last); }
        SEAM(pb + 9);
        if ((EN_GEMM & 32) && IN(pb + 10)) {
            MKFRAME(); KargPtr a = kargs(); unsigned char* ws = a->ws;
            pg8::Gemm g{(const bf16*)(ws + WS_ACT), (const bf16*)(ws + WS_WFFN + layer * SZ_FFN + SZ_WUP), R, 2048, 5632}; pg8::ResOrder S; S.init2(5632, F.G, F.bid, last ? 0 : NSPLIT_DN);
            pg8::EpiRes E{(const float*)(ws + WS_X), last ? a->out : (float*)(ws + WS_X), (const float*)(ws + WS_MOD) + (size_t)layer * 3 * NMOD + 5 * D, last ? 1 : 0, (float*)(ws + WS_PART), 5632 / 64,
                          (bf16*)(ws + WS_H), (const float*)(ws + WS_AV) + (size_t)(last ? 0 : 2 * layer + 2) * 3 * D, last ? nullptr : (float*)(ws + WS_STAT) + (size_t)(2 * layer + 2) * R, (!last && mla) ? ws + WS_XS8 : nullptr};
            pg8::gemm_phase<pg8::EpiRes, pg8::ResOrder, true, true>(F.lds + RING_OFF, g, S, E, F.wave);
        }
        SEAM(pb + 10);
    }
#undef IN
#undef SEAM
#undef WSP
}

#ifndef PROBE_EXTRA
#define PROBE_EXTRA 0
#endif
#ifndef PROBE_VAR
#define PROBE_VAR 0
#endif
#ifndef MK_PER_PHASE
#define MK_PER_PHASE 0
#endif
extern "C" void kernel_launch(void* const* d_in, const int* in_sizes, int n_in, void* d_out, int out_size, void* d_ws, size_t ws_size, hipStream_t stream) {
    static int grid = 0;
    if (grid == 0) {
        if (n_in != 28 || out_size != BATCH * SEQ * D || ws_size < WS_END) { fprintf(stderr, "kernel_launch: unexpected shapes: n_in %d out %d ws %zu (need %zu)\n", n_in, out_size, ws_size, (size_t)WS_END); grid = -1; return; }
        int dev = 0, cus = 0;
        if (hipGetDevice(&dev) != hipSuccess || hipDeviceGetAttribute(&cus, hipDeviceAttributeMultiprocessorCount, dev) != hipSuccess) { grid = -1; return; }
        if (hipFuncSetAttribute((const void*)fwd_kernel, hipFuncAttributeMaxDynamicSharedMemorySize, LDS_BYTES) != hipSuccess) { fprintf(stderr, "kernel_launch: hipFuncSetAttribute failed\n"); grid = -1; return; }
        int per_cu = 0;
        if (hipOccupancyMaxActiveBlocksPerMultiprocessor(&per_cu, (const void*)fwd_kernel, NWAVES * 64, LDS_BYTES) != hipSuccess || per_cu < 1) { fprintf(stderr, "kernel_launch: occupancy query says %d\n", per_cu); }
        (void)hipGetLastError();
        grid = cus;
    }
    if (grid < 0) return;
    (void)hipMemsetAsync((char*)d_ws + WS_CTL, 0, CTL_ZERO_BYTES, stream);
    Args a{};
    for (int i = 0; i < 28; ++i) a.in[i] = (const float*)d_in[i];
    a.out = (float*)d_out; a.ws = (unsigned char*)d_ws;
#if MK_PER_PHASE
    for (int ph = 0; ph < N_PHASES; ++ph) {
        if (ph >= 1) { const int l = (ph - 1) / PH_PER_LAYER, s = (ph - 1) % PH_PER_LAYER; if ((l & 1) && (s == 3 || s == 4)) continue; }
        a.ph_lo = ph; a.ph_hi = ph + 1;
        hipLaunchKernelGGL(fwd_kernel, dim3(grid), dim3(NWAVES * 64), LDS_BYTES, stream, a);
    }
#else
    a.ph_lo = 0; a.ph_hi = N_PHASES; a.var = 0;
    hipLaunchKernelGGL(fwd_kernel, dim3(grid), dim3(NWAVES * 64), LDS_BYTES, stream, a);
#if PROBE_EXTRA
    for (int l = 0; l < 4; ++l) for (int sl = 0; sl < PH_PER_LAYER; ++sl) if ((PROBE_EXTRA >> sl) & 1) { if ((l & 1) && (sl == 3 || sl == 4)) continue; a.ph_lo = 1 + l * PH_PER_LAYER + sl; a.ph_hi = a.ph_lo + 1; a.var = PROBE_VAR;
        hipLaunchKernelGGL(fwd_kernel, dim3(grid), dim3(NWAVES * 64), LDS_BYTES, stream, a); }
#endif
#endif
    const hipError_t le = hipPeekAtLastError();
    if (le != hipSuccess) fprintf(stderr, "kernel_launch: launch failed: %s\n", hipGetErrorName(le));
}
```

```cpp
#include <hip/hip_runtime.h>
#include <cstdio>
#include <cstdint>
namespace pg8 {
#define PG8_LAS __attribute__((address_space(3)))
typedef unsigned short bf16_t;
typedef short bf16x8 __attribute__((ext_vector_type(8)));
typedef float f32x4 __attribute__((ext_vector_type(4)));
typedef unsigned u32x4 __attribute__((ext_vector_type(4)));
typedef unsigned u32x2 __attribute__((ext_vector_type(2)));
typedef int v8i_t __attribute__((ext_vector_type(8)));
struct Frag2 { v8i_t w;
    __device__ __forceinline__ void ld(PG8_LAS unsigned char* p) { typedef int v4i_t __attribute__((ext_vector_type(4))); const v4i_t a = *(const PG8_LAS v4i_t*)p, b = *(const PG8_LAS v4i_t*)(p + 1024); w = (v8i_t){a[0], a[1], a[2], a[3], b[0], b[1], b[2], b[3]}; }
    __device__ __forceinline__ bf16x8 k0() const { typedef int v4i_t __attribute__((ext_vector_type(4))); const v4i_t a = {w[0], w[1], w[2], w[3]}; return __builtin_bit_cast(bf16x8, a); }
    __device__ __forceinline__ bf16x8 k1() const { typedef int v4i_t __attribute__((ext_vector_type(4))); const v4i_t a = {w[4], w[5], w[6], w[7]}; return __builtin_bit_cast(bf16x8, a); } };
__device__ __forceinline__ v8i_t pg8_cat(bf16x8 lo, bf16x8 hi) { typedef int v4i_t __attribute__((ext_vector_type(4))); const v4i_t a = __builtin_bit_cast(v4i_t, lo), b = __builtin_bit_cast(v4i_t, hi); return (v8i_t){a[0], a[1], a[2], a[3], b[0], b[1], b[2], b[3]}; }
constexpr int BM = 256, BK = 64, HALF = 128, HTB = HALF * BK * 2  , STAGE_BYTES = 8 * HTB, NXCD = 8, WGM = 8;

__host__ __device__ __forceinline__ int lds_byte(int r, int c) { const int st = (r >> 4) * 2 + (c >> 5), rr = r & 15, cc = c & 31, ob = rr * 64 + cc * 2; return st * 1024 + (ob ^ (((ob >> 9) & 1) << 5)); }
__host__ __device__ __forceinline__ void stage_rc(int b, int& R, int& C) { const int st = b / 1024, sb = b % 1024, swz = sb ^ (((sb >> 9) & 1) << 5); R = (st >> 1) * 16 + swz / 64; C = (st & 1) * 32 + (swz % 64) / 2; }
__host__ __device__ __forceinline__ int perm32(int rho) { const int n = rho >> 4, i = rho & 15; return 8 * (i >> 2) + 4 * n + (i & 3); }

struct Unit { int pm, pn, kt0, nkt; };
struct Gemm { const bf16_t* A; const bf16_t* Bt; int M, N, K; int sa, sb; };

struct StaticOrder {
    int nM, nN, nwg, G, c;
    __host__ __device__ void init(int M, int N, int G_, int c_) { nM = M / BM; nN = N / BM; nwg = nM * nN; G = G_; c = c_; }
    __host__ __device__ bool next(int i, Unit& u) const {
        const int L = i * G + c; if (L >= nwg) return false;
        int wgid = L; { const int q = nwg / NXCD, r = nwg % NXCD, xcd = wgid % NXCD, off = wgid / NXCD; wgid = (xcd < r ? xcd * (q + 1) : r * (q + 1) + (xcd - r) * q) + off; }
        const int nig = WGM * nN, gid = wgid / nig, fm = gid * WGM, gsz = (nM - fm) < WGM ? (nM - fm) : WGM;
        u.pm = fm + ((wgid % nig) % gsz); u.pn = (wgid % nig) / gsz; return true;
    }
    __device__ __forceinline__ void a_ready(const Unit&) const {}
    __device__ __forceinline__ void done(const Unit&) const {}
};
__device__ __forceinline__ unsigned cvt_pk_bf16(float lo, float hi) { unsigned r; asm volatile("v_cvt_pk_bf16_f32 %0, %1, %2" : "=v"(r) : "v"(lo), "v"(hi)); return r; }
__device__ __forceinline__ void row_scales(const float* stat, const Unit& u, int wr, int fr, float (&r)[2][4]) {
#pragma unroll
    for (int ai = 0; ai < 2; ++ai)
#pragma unroll
        for (int m = 0; m < 4; ++m) r[ai][m] = stat ? __builtin_amdgcn_rsqf(stat[u.pm * BM + ai * HALF + wr * 64 + m * 16 + fr] * (1.0f / 2048.0f) + 1e-6f) : 1.0f;
}
__device__ __forceinline__ int panel_variant(const Unit& u) { const int b = u.pm / 33; return (u.pm - b * 33) == 32 ? 2 : b; }
constexpr int CBN_ = 11264;
struct EpiF32 {
    static constexpr bool PERM = false, AFTER_DRAIN = false;
    float* C; int ldc; const float* stat; const float* cb;
    __device__ __forceinline__ void operator()(const f32x4 (&acc)[2][2][4][2], const Unit& u, int wr, int wc, int fr, int fq) const {
        const int row0 = u.pm * BM + wr * 64 + fr, col0 = u.pn * BM + wc * 32 + 4 * fq;
        float r[2][4]; row_scales(stat, u, wr, fr, r);
        f32x4 cv[2][2];
#pragma unroll
        for (int bj = 0; bj < 2; ++bj)
#pragma unroll
            for (int n = 0; n < 2; ++n) cv[bj][n] = stat ? *(const f32x4*)(cb + (size_t)panel_variant(u) * CBN_ + col0 + bj * HALF + n * 16) : (f32x4){0.f, 0.f, 0.f, 0.f};
#pragma unroll
        for (int ai = 0; ai < 2; ++ai)
#pragma unroll
            for (int m = 0; m < 4; ++m) { float* rowp = C + (size_t)(row0 + ai * HALF + m * 16) * ldc + col0;
#pragma unroll
                for (int bj = 0; bj < 2; ++bj)
#pragma unroll
                    for (int n = 0; n < 2; ++n) *(f32x4*)(rowp + bj * HALF + n * 16) = acc[ai][bj][m][n] * r[ai][m] + cv[bj][n]; }
    }
};
struct EpiBf16 {
    static constexpr bool PERM = true, AFTER_DRAIN = false;
    bf16_t* O; int ldc; const float* stat; const float* cb;
    __device__ __forceinline__ void operator()(const f32x4 (&acc)[2][2][4][2], const Unit& u, int wr, int wc, int fr, int fq) const {
        const int row0 = u.pm * BM + wr * 64 + fr, col0 = u.pn * BM + wc * 32 + 8 * fq;
        float r[2][4]; row_scales(stat, u, wr, fr, r);
        f32x4 cv[2][2];
#pragma unroll
        for (int bj = 0; bj < 2; ++bj)
#pragma unroll
            for (int n = 0; n < 2; ++n) cv[bj][n] = stat ? *(const f32x4*)(cb + (size_t)panel_variant(u) * CBN_ + col0 + bj * HALF + 4 * n) : (f32x4){0.f, 0.f, 0.f, 0.f};
#pragma unroll
        for (int ai = 0; ai < 2; ++ai)
#pragma unroll
            for (int m = 0; m < 4; ++m) { bf16_t* rowp = O + (size_t)(row0 + ai * HALF + m * 16) * ldc + col0;
#pragma unroll
                for (int bj = 0; bj < 2; ++bj) { const f32x4 v0 = acc[ai][bj][m][0] * r[ai][m] + cv[bj][0], v1 = acc[ai][bj][m][1] * r[ai][m] + cv[bj][1];
                    u32x4 w; w.x = cvt_pk_bf16(v0[0], v0[1]); w.y = cvt_pk_bf16(v0[2], v0[3]); w.z = cvt_pk_bf16(v1[0], v1[1]); w.w = cvt_pk_bf16(v1[2], v1[3]);
                    *(u32x4*)(rowp + bj * HALF) = w; } }
    }
};
__device__ __forceinline__ float dpp_ror1(float v) { return __builtin_bit_cast(float, __builtin_amdgcn_update_dpp(0, __builtin_bit_cast(int, v), 0x121, 0xf, 0xf, false)); }
__device__ __forceinline__ float dpp_rol1(float v) { return __builtin_bit_cast(float, __builtin_amdgcn_update_dpp(0, __builtin_bit_cast(int, v), 0x12f, 0xf, 0xf, false)); }
struct EpiConv {
    static constexpr bool PERM = true, AFTER_DRAIN = false;
    bf16_t* ACT; float* GH; float* VH; const float* cw; const float* cb; const float* stat; const float* cvec;
    __device__ __forceinline__ void operator()(const f32x4 (&acc_)[2][2][4][2], const Unit& u, int wr, int wc, int fr, int fq) const {
        constexpr int FF = 5632;
        const int f0 = u.pn * 128 + wc * 32 + 8 * fq;
        f32x4 acc[2][2][4][2];
        { float r[2][4]; row_scales(stat, u, wr, fr, r); const float* cp = cvec + (size_t)panel_variant(u) * CBN_ + u.pn * BM + wc * 32 + 8 * fq;
#pragma unroll
          for (int bj = 0; bj < 2; ++bj)
#pragma unroll
            for (int n = 0; n < 2; ++n) { const f32x4 cv = *(const f32x4*)(cp + bj * HALF + 4 * n);
#pragma unroll
              for (int ai = 0; ai < 2; ++ai)
#pragma unroll
                for (int m = 0; m < 4; ++m) acc[ai][bj][m][n] = acc_[ai][bj][m][n] * r[ai][m] + cv; } }
        float w0[8], w1[8], w2[8], bb[8];
#pragma unroll
        for (int h = 0; h < 2; ++h) { const f32x4 a = *(const f32x4*)(cw + f0 + 4 * h), b = *(const f32x4*)(cw + FF + f0 + 4 * h), c = *(const f32x4*)(cw + 2 * FF + f0 + 4 * h), d = *(const f32x4*)(cb + f0 + 4 * h);
#pragma unroll
            for (int i = 0; i < 4; ++i) { w0[4 * h + i] = a[i]; w1[4 * h + i] = b[i]; w2[4 * h + i] = c[i]; bb[4 * h + i] = d[i]; } }
#pragma unroll
        for (int ai = 0; ai < 2; ++ai) {
            const int sid = u.pm * 4 + ai * 2 + wr, row0 = u.pm * BM + ai * HALF + wr * 64 + fr;
#pragma unroll
            for (int m = 0; m < 4; ++m) {
                float o[8];
#pragma unroll
                for (int i = 0; i < 8; ++i) {
                    const float g = acc[ai][0][m][i >> 2][i & 3], v = acc[ai][1][m][i >> 2][i & 3];
                    const float pa = dpp_ror1(g), pb = m > 0 ? dpp_ror1(acc[ai][0][m > 0 ? m - 1 : 0][i >> 2][i & 3]) : 0.f;
                    const float na = dpp_rol1(g), nb = m < 3 ? dpp_rol1(acc[ai][0][m < 3 ? m + 1 : 3][i >> 2][i & 3]) : 0.f;
                    const float pv = fr == 0 ? pb : pa, nx = fr == 15 ? nb : na;
                    const float a = fmaf(w0[i], pv, fmaf(w1[i], g, fmaf(w2[i], nx, bb[i])));
                    o[i] = a * __builtin_amdgcn_rcpf(1.f + __builtin_amdgcn_exp2f(a * -1.4426950408889634f)) * v;
                }
                const bool edge = (m == 0 && fr == 0) || (m == 3 && fr == 15);
                if (!edge) { u32x4 w; w.x = cvt_pk_bf16(o[0], o[1]); w.y = cvt_pk_bf16(o[2], o[3]); w.z = cvt_pk_bf16(o[4], o[5]); w.w = cvt_pk_bf16(o[6], o[7]);
                    *(u32x4*)(ACT + (size_t)(row0 + m * 16) * FF + f0) = w; }
                if (m == 0 && fr < 2) { float* p = GH + ((size_t)sid * 4 + fr) * FF + f0; *(f32x4*)p = acc[ai][0][0][0]; *(f32x4*)(p + 4) = acc[ai][0][0][1]; }
                if (m == 3 && fr >= 14) { float* p = GH + ((size_t)sid * 4 + 2 + (fr - 14)) * FF + f0; *(f32x4*)p = acc[ai][0][3][0]; *(f32x4*)(p + 4) = acc[ai][0][3][1]; }
                if (m == 0 && fr == 0) { float* p = VH + ((size_t)sid * 2) * FF + f0; *(f32x4*)p = acc[ai][1][0][0]; *(f32x4*)(p + 4) = acc[ai][1][0][1]; }
                if (m == 3 && fr == 15) { float* p = VH + ((size_t)sid * 2 + 1) * FF + f0; *(f32x4*)p = acc[ai][1][3][0]; *(f32x4*)(p + 4) = acc[ai][1][3][1]; }
            }
        }
    }
};
struct EpiRes {
    static constexpr bool PERM = true, AFTER_DRAIN = false;
    const float* base; float* out; const float* gates; int to_out; float* part; int nkt_full;
    bf16_t* XS; const float* av; float* stat; unsigned char* XS8;
    __device__ __forceinline__ void operator()(const f32x4 (&acc)[2][2][4][2], const Unit& u, int wr, int wc, int fr, int fq) const {
        const int b = u.pm / 33, isctx = (u.pm - b * 33) == 32, v = isctx ? 2 : b;
        const float* g = gates + (size_t)v * 12288;
        const int row0 = u.pm * BM + wr * 64 + fr, col0 = u.pn * BM + wc * 32 + 8 * fq;
        const int orow0 = to_out ? row0 - 256 * b : row0;
        if (u.nkt != nkt_full) {
            float* pp = part + ((size_t)(u.kt0 / u.nkt) * 512 + 256 * b + wr * 64 + fr) * 2048 + u.pn * BM + wc * 32 + 8 * fq;
#pragma unroll
            for (int bj = 0; bj < 2; ++bj)
#pragma unroll
                for (int n = 0; n < 2; ++n) { const f32x4 gvv = *(const f32x4*)(g + col0 + bj * HALF + n * 4);
#pragma unroll
                    for (int ai = 0; ai < 2; ++ai)
#pragma unroll
                        for (int m = 0; m < 4; ++m) *(f32x4*)(pp + (size_t)(ai * HALF + m * 16) * 2048 + bj * HALF + n * 4) = gvv * acc[ai][bj][m][n]; }
            return;
        }
        f32x4 gv[2][2], aw[2][2];
#pragma unroll
        for (int bj = 0; bj < 2; ++bj)
#pragma unroll
            for (int n = 0; n < 2; ++n) { gv[bj][n] = *(const f32x4*)(g + col0 + bj * HALF + n * 4); aw[bj][n] = stat ? *(const f32x4*)(av + (size_t)v * 2048 + col0 + bj * HALF + n * 4) : (f32x4){0.f, 0.f, 0.f, 0.f}; }
        const int lane = fq * 16 + fr;
#pragma unroll
        for (int ai = 0; ai < 2; ++ai)
#pragma unroll
            for (int m = 0; m < 4; ++m) { const float* bp = base + (size_t)(row0 + ai * HALF + m * 16) * 2048 + col0; float* op = out + (size_t)(orow0 + ai * HALF + m * 16) * 2048 + col0;
                bf16_t* xp = XS + (size_t)(row0 + ai * HALF + m * 16) * 2048 + col0; float ss = 0.f;
#pragma unroll
                for (int bj = 0; bj < 2; ++bj) { f32x4 xx[2];
#pragma unroll
                    for (int n = 0; n < 2; ++n) { xx[n] = *(const f32x4*)(bp + bj * HALF + n * 4) + gv[bj][n] * acc[ai][bj][m][n]; *(f32x4*)(op + bj * HALF + n * 4) = xx[n]; }
                    if (stat) { ss += ((xx[0][0] * xx[0][0] + xx[0][1] * xx[0][1]) + (xx[0][2] * xx[0][2] + xx[0][3] * xx[0][3])) + ((xx[1][0] * xx[1][0] + xx[1][1] * xx[1][1]) + (xx[1][2] * xx[1][2] + xx[1][3] * xx[1][3]));
                        const f32x4 y0 = xx[0] * aw[bj][0], y1 = xx[1] * aw[bj][1];
                        u32x4 w; w.x = cvt_pk_bf16(y0[0], y0[1]); w.y = cvt_pk_bf16(y0[2], y0[3]); w.z = cvt_pk_bf16(y1[0], y1[1]); w.w = cvt_pk_bf16(y1[2], y1[3]); *(u32x4*)(xp + bj * HALF) = w;
                        if (XS8) { u32x2 w8; int t_ = 0; t_ = __builtin_amdgcn_cvt_pk_fp8_f32(y0[0], y0[1], t_, false); t_ = __builtin_amdgcn_cvt_pk_fp8_f32(y0[2], y0[3], t_, true); w8.x = (unsigned)t_; t_ = 0; t_ = __builtin_amdgcn_cvt_pk_fp8_f32(y1[0], y1[1], t_, false); t_ = __builtin_amdgcn_cvt_pk_fp8_f32(y1[2], y1[3], t_, true); w8.y = (unsigned)t_;
                            *(u32x2*)(XS8 + (size_t)(row0 + ai * HALF + m * 16) * 2048 + col0 + bj * HALF) = w8; } } }
                if (stat) {
                    ss += __builtin_bit_cast(float, __builtin_amdgcn_ds_bpermute((lane ^ 16) << 2, __builtin_bit_cast(int, ss)));
                    ss += __builtin_bit_cast(float, __builtin_amdgcn_ds_bpermute((lane ^ 32) << 2, __builtin_bit_cast(int, ss)));
                    if (fq == 0) unsafeAtomicAdd(stat + row0 + ai * HALF + m * 16, ss); } }
    }
};
struct PanelOrder : StaticOrder {
    int skip, nkt_full;
    __device__ void init2(int N, int K, int G_, int c_, int skip_) { skip = skip_; nkt_full = K / BK; init(skip_ ? 16384 : 16896, N, G_, c_); }
    __device__ __forceinline__ bool next(int i, Unit& u) const { Unit a; a.pm = 0; a.pn = 0; const bool ok = StaticOrder::next(i, a); u.pm = (skip && a.pm >= 32) ? a.pm + 1 : a.pm; u.pn = a.pn; u.kt0 = 0; u.nkt = nkt_full; return ok; }
};
struct ResOrder : StaticOrder {
    int nsplit, nkt_full;
    __device__ void init2(int K, int G_, int c_, int nsplit_) { nsplit = nsplit_; nkt_full = K / BK; init(16384, 2048, G_, c_); }
    __device__ __forceinline__ bool next(int i, Unit& u) const {
        const int L = i * G + c;
        Unit a; a.pm = 0; a.pn = 0; const bool lat = StaticOrder::next(i, a);
        const int m = L - nwg, cu = m & 15, s = m >> 4, nk = nsplit > 0 ? nkt_full / nsplit : nkt_full;
        const int pm = lat ? (a.pm >= 32 ? a.pm + 1 : a.pm) : ((cu >> 3) ? 65 : 32), pn = lat ? a.pn : (cu & 7);
        u.pm = pm; u.pn = pn; u.kt0 = lat ? 0 : s * nk; u.nkt = lat ? nkt_full : nk;
        return lat || m < 16 * nsplit;
    }
};

template <class Epi, class Sched, bool ALIGN_EPI = false, bool SP2 = false, bool F8 = false>
__device__ __forceinline__ void gemm_phase(PG8_LAS unsigned char* lds, const Gemm g, const Sched& S, const Epi& E, int wave_in) {
    int tid_; asm volatile("v_mbcnt_lo_u32_b32 %0, -1, 0\n\tv_mbcnt_hi_u32_b32 %0, -1, %0" : "=&v"(tid_)); tid_ |= wave_in << 6;
    const int tid = tid_, wid = __builtin_amdgcn_readfirstlane(tid >> 6), lane = tid & 63, wr = wid >> 2, wc = wid & 3, fr = lane & 15, fq = lane >> 4;
    const int K = g.K;
    unsigned voffA[2], voffB[2];
#pragma unroll
    for (int i = 0; i < 2; ++i) { int R, C; stage_rc(tid * 16 + i * 8192, R, C); const int Rb = Epi::PERM ? ((R & ~31) + perm32(R & 31)) : R;
        voffA[i] = (unsigned)(R * K + C) * 2u; voffB[i] = (unsigned)(Rb * K + C) * 2u; }
    const size_t kstep = (size_t)(BK * 2);
    const size_t hstep = (size_t)HALF * K * 2;
    const size_t tstep = 2 * hstep;
    const unsigned ldsw = (unsigned)wid * 1024u;
    const int aoff = lds_byte(wr * 64 + fr, fq * 8), boff = lds_byte(wc * 32 + fr, fq * 8);
#define PG8_SA(b, h) (((b) * 2 + (h)) * HTB)
#define PG8_SB(b, h) ((4 + (b) * 2 + (h)) * HTB)
#define PG8_STAGE(bufoff, gbase, voff) do { _Pragma("unroll") for (int _i = 0; _i < 2; ++_i) \
        __builtin_amdgcn_global_load_lds((const unsigned*)((const char*)(gbase) + (voff)[_i]), (PG8_LAS unsigned*)(lds + (bufoff) + ldsw + _i * 8192), 16, 0, 0); } while (0)
#define PG8_LDA(dst, b, h) do { _Pragma("unroll") for (int m = 0; m < 4; ++m) dst[m].ld(lds + PG8_SA(b, h) + aoff + m * 2048); } while (0)
#define PG8_LDB(dst, b, h) do { _Pragma("unroll") for (int n = 0; n < 2; ++n) dst[n].ld(lds + PG8_SB(b, h) + boff + n * 2048); } while (0)
#define PG8_MMA(ai, bj, At, Bt) do { __builtin_amdgcn_s_setprio(1); _Pragma("unroll") for (int m = 0; m < 4; ++m) _Pragma("unroll") for (int n = 0; n < 2; ++n) { \
        if constexpr (F8) {     \
              \
            asm volatile("v_mfma_scale_f32_16x16x128_f8f6f4 %0, %1, %2, %0, %3, %4 op_sel_hi:[0,0,0]" : "+v"(acc[ai][bj][m][n]) : "v"(Bt[n].w), "v"(At[m].w), "v"(g.sa), "v"(g.sb)); \
        } else { acc[ai][bj][m][n] = __builtin_amdgcn_mfma_f32_16x16x32_bf16(Bt[n].k0(), At[m].k0(), acc[ai][bj][m][n], 0, 0, 0); \
                 acc[ai][bj][m][n] = __builtin_amdgcn_mfma_f32_16x16x32_bf16(Bt[n].k1(), At[m].k1(), acc[ai][bj][m][n], 0, 0, 0); } } \
        __builtin_amdgcn_s_setprio(0); } while (0)
#define PG8_WAIT_V(n) asm volatile("s_waitcnt vmcnt(" #n ")" ::: "memory")
#define PG8_WAIT_L(n) asm volatile("s_waitcnt lgkmcnt(" #n ")" ::: "memory")
#define PG8_BAR __builtin_amdgcn_s_barrier()
#define PG8_SCHED __builtin_amdgcn_sched_barrier(0)
    Unit cur, nxt; int ui = 0;
    if (!S.next(0, cur)) return;
    f32x4 acc[2][2][4][2];
#pragma unroll
    for (int a = 0; a < 2; ++a)
#pragma unroll
        for (int b = 0; b < 2; ++b)
#pragma unroll
            for (int m = 0; m < 4; ++m)
#pragma unroll
                for (int n = 0; n < 2; ++n) acc[a][b][m][n] = (f32x4){0.f, 0.f, 0.f, 0.f};
    Frag2 At[4], B0[2], B1[2];
    const char* cA = (const char*)g.A + (size_t)cur.pm * tstep + (size_t)cur.kt0 * kstep; const char* cB = (const char*)g.Bt + (size_t)cur.pn * tstep + (size_t)cur.kt0 * kstep;
    S.a_ready(cur);
    if constexpr (SP2) {
        PG8_STAGE(PG8_SB(0, 0), cB, voffB); PG8_STAGE(PG8_SB(0, 1), cB + hstep, voffB); PG8_STAGE(PG8_SA(0, 0), cA, voffA); PG8_STAGE(PG8_SA(0, 1), cA + hstep, voffA);
        if (wr == 1) PG8_BAR;
        PG8_WAIT_V(2); PG8_BAR;
        PG8_STAGE(PG8_SB(1, 0), cB + kstep, voffB); PG8_STAGE(PG8_SA(1, 0), cA + kstep, voffA); PG8_STAGE(PG8_SB(1, 1), cB + hstep + kstep, voffB);
        PG8_WAIT_V(6); PG8_BAR;
    } else {
        PG8_STAGE(PG8_SB(0, 0), cB, voffB); PG8_STAGE(PG8_SA(0, 0), cA, voffA); PG8_STAGE(PG8_SB(0, 1), cB + hstep, voffB); PG8_STAGE(PG8_SA(0, 1), cA + hstep, voffA);
        if (wr == 1) PG8_BAR;
        PG8_WAIT_V(4); PG8_BAR;
        PG8_STAGE(PG8_SB(1, 0), cB + kstep, voffB); PG8_STAGE(PG8_SA(1, 0), cA + kstep, voffA); PG8_STAGE(PG8_SB(1, 1), cB + hstep + kstep, voffB);
        PG8_WAIT_V(6); PG8_BAR;
    }
    for (;;) {
        const bool has_next = S.next(ui + 1, nxt);
        const char* nA = has_next ? (const char*)g.A + (size_t)nxt.pm * tstep + (size_t)nxt.kt0 * kstep : cA; const char* nB = has_next ? (const char*)g.Bt + (size_t)nxt.pn * tstep + (size_t)nxt.kt0 * kstep : cB;
        const int nt = cur.nkt;
        for (int t = 0; t < nt; t += 2) {
            const bool last = (t == nt - 2);
            const char* a1 = cA + (size_t)(t + 1) * kstep;
            const char* a2 = last ? nA : cA + (size_t)(t + 2) * kstep; const char* b2 = last ? nB : cB + (size_t)(t + 2) * kstep;
            const char* a3 = a2 + kstep; const char* b3 = b2 + kstep;
            if (last && has_next) S.a_ready(nxt);
            if constexpr (SP2) {
            PG8_LDB(B0, 0, 0); PG8_LDB(B1, 0, 1); PG8_SCHED; PG8_LDA(At, 0, 0); PG8_STAGE(PG8_SA(1, 1), a1 + hstep, voffA);
            PG8_WAIT_V(8); PG8_WAIT_L(0); PG8_BAR; PG8_MMA(0, 0, At, B0); PG8_MMA(0, 1, At, B1); PG8_BAR; PG8_SCHED;
            PG8_LDA(At, 0, 1); PG8_STAGE(PG8_SB(0, 0), b2, voffB); PG8_STAGE(PG8_SB(0, 1), b2 + hstep, voffB); PG8_STAGE(PG8_SA(0, 0), a2, voffA);
            PG8_WAIT_V(8); PG8_WAIT_L(0); PG8_BAR; PG8_MMA(1, 0, At, B0); PG8_MMA(1, 1, At, B1); PG8_BAR; PG8_SCHED;
            PG8_LDB(B0, 1, 0); PG8_LDB(B1, 1, 1); PG8_SCHED; PG8_LDA(At, 1, 0); PG8_STAGE(PG8_SA(0, 1), a2 + hstep, voffA);
            PG8_WAIT_V(8); PG8_WAIT_L(0); PG8_BAR; PG8_MMA(0, 0, At, B0); PG8_MMA(0, 1, At, B1); PG8_BAR; PG8_SCHED;
            PG8_LDA(At, 1, 1); PG8_STAGE(PG8_SB(1, 0), b3, voffB); PG8_STAGE(PG8_SB(1, 1), b3 + hstep, voffB); PG8_STAGE(PG8_SA(1, 0), a3, voffA);
            PG8_WAIT_V(8); PG8_WAIT_L(0); PG8_BAR; PG8_MMA(1, 0, At, B0); PG8_MMA(1, 1, At, B1); PG8_BAR; PG8_SCHED;
            } else {
            PG8_LDB(B0, 0, 0); PG8_SCHED; PG8_LDA(At, 0, 0); PG8_STAGE(PG8_SA(1, 1), a1 + hstep, voffA);
            PG8_WAIT_L(8); PG8_BAR; PG8_WAIT_L(0); PG8_MMA(0, 0, At, B0); PG8_BAR; PG8_SCHED;
            PG8_LDB(B1, 0, 1); PG8_STAGE(PG8_SB(0, 0), b2, voffB);
            PG8_BAR; PG8_WAIT_L(0); PG8_MMA(0, 1, At, B1); PG8_BAR;
            PG8_LDA(At, 0, 1); PG8_STAGE(PG8_SA(0, 0), a2, voffA);
            PG8_BAR; PG8_WAIT_L(0); PG8_MMA(1, 0, At, B0); PG8_BAR; PG8_SCHED;
            PG8_STAGE(PG8_SB(0, 1), b2 + hstep, voffB);
            PG8_WAIT_V(6); PG8_BAR; PG8_MMA(1, 1, At, B1); PG8_BAR;
            PG8_LDB(B0, 1, 0); PG8_SCHED; PG8_LDA(At, 1, 0); PG8_STAGE(PG8_SA(0, 1), a2 + hstep, voffA);
            PG8_WAIT_L(8); PG8_BAR; PG8_WAIT_L(0); PG8_MMA(0, 0, At, B0); PG8_BAR; PG8_SCHED;
            PG8_LDB(B1, 1, 1); PG8_STAGE(PG8_SB(1, 0), b3, voffB);
            PG8_BAR; PG8_WAIT_L(0); PG8_MMA(0, 1, At, B1); PG8_BAR;
            PG8_LDA(At, 1, 1); PG8_STAGE(PG8_SA(1, 0), a3, voffA);
            PG8_BAR; PG8_WAIT_L(0); PG8_MMA(1, 0, At, B0); PG8_BAR; PG8_SCHED;
            PG8_STAGE(PG8_SB(1, 1), b3 + hstep, voffB);
            PG8_WAIT_V(6); PG8_BAR; PG8_MMA(1, 1, At, B1); PG8_BAR;
            }
        }
        if constexpr (ALIGN_EPI) { if (wr == 0) PG8_BAR; }
        if constexpr (F8) asm volatile("s_nop 15\n\ts_nop 15" ::: "memory");
        if constexpr (!Epi::AFTER_DRAIN) { E(acc, cur, wr, wc, fr, fq); S.done(cur); }
        if (!has_next) break;
#pragma unroll
        for (int a = 0; a < 2; ++a)
#pragma unroll
            for (int b = 0; b < 2; ++b)
#pragma unroll
                for (int m = 0; m < 4; ++m)
#pragma unroll
                    for (int n = 0; n < 2; ++n) acc[a][b][m][n] = (f32x4){0.f, 0.f, 0.f, 0.f};
        cur = nxt; cA = nA; cB = nB; ++ui;
        if constexpr (ALIGN_EPI) { if (wr == 1) PG8_BAR; }
    }
    PG8_WAIT_V(0);
    if constexpr (!ALIGN_EPI) { if (wr == 0) PG8_BAR; }
    PG8_BAR;
    if constexpr (Epi::AFTER_DRAIN) { E.fused(acc, cur, wr, wc, fr, fq, lds, wid, lane); S.done(cur); }
#undef PG8_SA
#undef PG8_SB
#undef PG8_STAGE
#undef PG8_LDA
#undef PG8_LDB
#undef PG8_MMA
#undef PG8_WAIT_V
#undef PG8_WAIT_L
#undef PG8_BAR
#undef PG8_SCHED
}
}

#define GAS __attribute__((address_space(1)))
#define LAS __attribute__((address_space(3)))
typedef unsigned short bf16;
typedef unsigned v4u __attribute__((ext_vector_type(4)));
typedef unsigned v2u __attribute__((ext_vector_type(2)));
typedef float f32x4 __attribute__((ext_vector_type(4)));
#define LDS_WAIT() asm volatile("s_waitcnt lgkmcnt(0)" ::: "memory")
#define VM_WAIT() asm volatile("s_waitcnt vmcnt(0)" ::: "memory")

#define XB_TMO      128
#define XB_XCNT(j)  (256  + 64 * (j))
#define XB_XSUB(j)  (1280 + 64 * (j))
#define XB_XGEN(j)  (2304 + 64 * (j))
#define XB_TOP      3328
#define XB_TOPGEN   3392
#define XCD_BAR_WORDS 3456
#define XB_SPIN_CAP (1u << 18)

__device__ __forceinline__ unsigned xb_ld(unsigned* p)              { return __hip_atomic_load(p, __ATOMIC_RELAXED, __HIP_MEMORY_SCOPE_AGENT); }
__device__ __forceinline__ unsigned xb_add(unsigned* p, unsigned v) { return __hip_atomic_fetch_add(p, v, __ATOMIC_RELAXED, __HIP_MEMORY_SCOPE_AGENT); }
__device__ __forceinline__ unsigned xb_xcc_id() { return (unsigned)__builtin_amdgcn_s_getreg((3 << 11) | 20) & 0xFu; }
#define XB_SPIN(cond, bar) do { unsigned _sp = 0; while (cond) { __builtin_amdgcn_s_sleep(1); \
    if ((++_sp & 255u) == 0u) { if (xb_ld(&(bar)[XB_TMO])) break; if (_sp > XB_SPIN_CAP) { atomicAdd(&(bar)[XB_TMO], 1u); break; } } } } while (0)

struct XcdBarrier {
    int tid;
    unsigned* bar; unsigned x;
    volatile LAS unsigned* st;
};

__device__ __forceinline__ XcdBarrier xcd_barrier_post(unsigned* bar, volatile LAS unsigned* st, int tid) {
    XcdBarrier b; b.tid = tid; b.bar = bar; b.x = xb_xcc_id(); b.st = st;
    if (tid == 0) (void)xb_add(&bar[XB_XCNT(b.x)], 1u);
    return b;
}
__device__ __forceinline__ void xcd_barrier_complete(unsigned* bar, unsigned x, unsigned& nloc, unsigned& nx) {
    const unsigned G = gridDim.x * gridDim.y * gridDim.z;
    unsigned sum, cnt, mine, sp = 0u;
    for (;;) {
        sum = 0u; cnt = 0u; mine = 0u;
#pragma unroll
        for (unsigned j = 0; j < 16; ++j) { const unsigned c = xb_ld(&bar[XB_XCNT(j)]); sum += c; cnt += (c > 0u) ? 1u : 0u; mine = (j == x) ? c : mine; }
        if (sum == G) break;
        __builtin_amdgcn_s_sleep(1);
        if ((++sp & 255u) == 0u) { if (xb_ld(&bar[XB_TMO])) break; if (sp > XB_SPIN_CAP) { atomicAdd(&bar[XB_TMO], 1u); break; } }
    }
    nloc = mine > 0u ? mine : 1u; nx = cnt > 0u ? cnt : 1u;
}

__device__ __forceinline__ void xcd_barrier(const XcdBarrier& b) {
    asm volatile("s_waitcnt vmcnt(0)" ::: "memory");
    __syncthreads();
    if (b.tid == 0) {
        unsigned* bar = b.bar;
        __builtin_amdgcn_s_waitcnt(0);
        unsigned nloc = b.st[0], nx = b.st[1];
        if (nloc == 0u) { xcd_barrier_complete(bar, b.x, nloc, nx); b.st[0] = nloc; b.st[1] = nx; }
        const unsigned old = xb_add(&bar[XB_XSUB(b.x)], 1u);
        const unsigned gen = old / nloc;
        if (old + 1u == (gen + 1u) * nloc) {
            __builtin_amdgcn_fence(__ATOMIC_RELEASE, "agent");
            asm volatile("s_waitcnt vmcnt(0)" ::: "memory");
            const unsigned og = xb_add(&bar[XB_TOP], 1u);
            const unsigned tg = og / nx;
            if (og + 1u == (tg + 1u) * nx) xb_add(&bar[XB_TOPGEN], 1u);
            else XB_SPIN(xb_ld(&bar[XB_TOPGEN]) == tg, bar);
            __builtin_amdgcn_fence(__ATOMIC_ACQUIRE, "agent");
            xb_add(&bar[XB_XGEN(b.x)], 1u);
            asm volatile("s_waitcnt vmcnt(0)" ::: "memory");
        } else {
            XB_SPIN(xb_ld(&bar[XB_XGEN(b.x)]) == gen, bar);
            __builtin_amdgcn_fence(__ATOMIC_ACQUIRE, "agent");
            asm volatile("s_waitcnt vmcnt(0)" ::: "memory");
        }
    }
    __syncthreads();
}
namespace att {
using bf16 = unsigned short;
using bf16x8 = __attribute__((ext_vector_type(8))) short;
using s16x4  = __attribute__((ext_vector_type(4))) short;
using f32x16 = __attribute__((ext_vector_type(16))) float;
using f32x4  = __attribute__((ext_vector_type(4))) float;
using u32x4  = __attribute__((ext_vector_type(4))) unsigned;
typedef int v4i_att __attribute__((ext_vector_type(4)));
typedef int v8i_att __attribute__((ext_vector_type(8)));
typedef int v2i_att __attribute__((ext_vector_type(2)));
constexpr int NW = 8, QBLK = 32, KVBLK = 64, DV = 128;
constexpr float THR = 8.f;
#define ATT_SBAR() __builtin_amdgcn_sched_barrier(0)
#define ATT_LAS __attribute__((address_space(3)))
__device__ __forceinline__ int crow(int r, int hi) { return (r & 3) + 8 * (r >> 2) + 4 * hi; }
__device__ __forceinline__ unsigned cvtpk(float lo, float hi) { unsigned r; asm volatile("v_cvt_pk_bf16_f32 %0, %1, %2" : "=v"(r) : "v"(lo), "v"(hi)); return r; }

__device__ __forceinline__ float att_shx(float v, int lane, int o) { return __builtin_bit_cast(float, __builtin_amdgcn_ds_bpermute((lane ^ o) << 2, __builtin_bit_cast(int, v))); }
struct CfgGQA { static constexpr int LDVT = 8448, NS = 2, KROWB = 128, RB = 128, DQK = 128, LDQ = 3072, LDK = 512, LDV = 3072, LDO = 2048, SDEPTH = 0; static constexpr bool MLA = false, MSUM = false; static constexpr float SCALE = 0.088388347648318440f; };
struct CfgMLA { static constexpr int LDVT = 8448, NS = 3, KROWB = 192, RB = 256, DQK = 192, LDQ = 3072, LDK = 3072, LDV = 4096, LDO = 2048, SDEPTH = 0; static constexpr bool MLA = true, MSUM = false;  static constexpr float SCALE = 0.072168783648703220f; };

__device__ __forceinline__ float max3f(float a, float b, float c) { float r; asm("v_max3_f32 %0, %1, %2, %3" : "=v"(r) : "v"(a), "v"(b), "v"(c)); return r; }
__device__ __forceinline__ float max2f(float a, float b) { float r; asm("v_max_f32_e32 %0, %1, %2" : "=v"(r) : "v"(a), "v"(b)); return r; }
__device__ __forceinline__ float max8(const f32x16& p, int base) {
  return max2f(max3f(max3f(max3f(p[base], p[base + 1], p[base + 2]), p[base + 3], p[base + 4]), p[base + 5], p[base + 6]), p[base + 7]);
}
template <bool FIRST>
__device__ __forceinline__ void decideSM(f32x16& p0, f32x16& p1, float pmax, float& m_reg, f32x16& negm, float& alpha) {
  constexpr float THRL = THR * 1.4426950408889634f;
  { auto rr = __builtin_amdgcn_permlane32_swap(__float_as_uint(pmax), __float_as_uint(pmax), false, false);
    pmax = fmaxf(__uint_as_float(rr[0]), __uint_as_float(rr[1])); }
  if (!FIRST && __builtin_expect(__all(pmax <= THRL), 1)) { alpha = 1.f; }
  else { const float d = FIRST ? pmax : fmaxf(pmax, 0.f); alpha = FIRST ? 0.f : __builtin_amdgcn_exp2f(-d); m_reg += d;
#pragma unroll
    for (int r = 0; r < 16; ++r) { p0[r] -= d; p1[r] -= d; negm[r] -= d; } }
}
template <bool SUMV>
__device__ __forceinline__ void finishSM(f32x16& p0, f32x16& p1, float alpha, float& l_reg, bf16x8& pa0, bf16x8& pa1, bf16x8& pa2, bf16x8& pa3) {
#pragma unroll
  for (int r = 0; r < 16; ++r) p0[r] = __builtin_amdgcn_exp2f(p0[r]);
#pragma unroll
  for (int r = 0; r < 16; ++r) p1[r] = __builtin_amdgcn_exp2f(p1[r]);
  if constexpr (SUMV) { float ps = 0;
#pragma unroll
  for (int r = 0; r < 16; ++r) ps += p0[r];
#pragma unroll
  for (int r = 0; r < 16; ++r) ps += p1[r];
  { auto rr = __builtin_amdgcn_permlane32_swap(__float_as_uint(ps), __float_as_uint(ps), false, false);
    ps = __uint_as_float(rr[0]) + __uint_as_float(rr[1]); }
  l_reg = l_reg * alpha + ps; }
#define ATT_PKB(P, B) __builtin_amdgcn_cvt_pk_bf8_f32(P[B + 2], P[B + 3], __builtin_amdgcn_cvt_pk_bf8_f32(P[B], P[B + 1], 0, false), true)
  { const v4i_att w0 = {ATT_PKB(p0, 0), ATT_PKB(p0, 4), ATT_PKB(p0, 8), ATT_PKB(p0, 12)}, w1 = {ATT_PKB(p1, 0), ATT_PKB(p1, 4), ATT_PKB(p1, 8), ATT_PKB(p1, 12)};
    pa0 = __builtin_bit_cast(bf16x8, w0); pa1 = __builtin_bit_cast(bf16x8, w1); pa2 = pa0; pa3 = pa1; }
#undef ATT_PKB
}
__device__ __forceinline__ void finishU8(const f32x16& p0, const f32x16& p1, bf16x8& pa0, bf16x8& pa1) {
  v4i_att w0 = {0, 0, 0, 0}, w1 = {0, 0, 0, 0};
#pragma unroll
  for (int r = 0; r < 16; ++r) { w0[r >> 2] = (int)__builtin_amdgcn_cvt_pk_u8_f32(p0[r], r & 3, (unsigned)w0[r >> 2]); w1[r >> 2] = (int)__builtin_amdgcn_cvt_pk_u8_f32(p1[r], r & 3, (unsigned)w1[r >> 2]); }
  pa0 = __builtin_bit_cast(bf16x8, w0); pa1 = __builtin_bit_cast(bf16x8, w1);
}
__device__ __forceinline__ void rowsum16(f32x4& ls, bf16x8 pa0, bf16x8 pa1, const v8i_att& bones) {
  constexpr int ONE = 0x7f7f7f7f;
  const v4i_att a0 = __builtin_bit_cast(v4i_att, pa0), a1 = __builtin_bit_cast(v4i_att, pa1);
  const v8i_att A = {a0[0], a0[1], a0[2], a0[3], a1[0], a1[1], a1[2], a1[3]};
  asm volatile("s_nop 1\n\tv_mfma_scale_f32_16x16x128_f8f6f4 %0, %1, %2, %0, %3, %3 op_sel_hi:[0,0,0] cbsz:1" : "+v"(ls) : "v"(A), "v"(bones), "v"(ONE));
}
typedef int v8i __attribute__((ext_vector_type(8)));
typedef int v4i __attribute__((ext_vector_type(4)));
template <int RB> __device__ __forceinline__ int kswf(int row) { return RB == 128 ? ((row >> 1) & 7) : (row & 15); }
template <int RB> __device__ __forceinline__ int kswz8(int row, int chunk) { return row * RB + ((chunk ^ kswf<RB>(row)) << 4); }
template <class Cfg, int SA>
__device__ __forceinline__ void qkt(f32x16& p0, f32x16& p1, const char* Ks, const v8i* q8, const f32x16& negm, int r32, int hi) {
  constexpr int ONE = 0x7f7f7f7f;
#pragma unroll
  for (int s = 0; s < Cfg::NS; ++s) { const int c = 4 * s + 2 * hi;
    const v4i a0 = *reinterpret_cast<const v4i*>(Ks + kswz8<Cfg::RB>(r32, c)), a1 = *reinterpret_cast<const v4i*>(Ks + kswz8<Cfg::RB>(r32, c + 1));
    const v4i b0 = *reinterpret_cast<const v4i*>(Ks + kswz8<Cfg::RB>(32 + r32, c)), b1 = *reinterpret_cast<const v4i*>(Ks + kswz8<Cfg::RB>(32 + r32, c + 1));
    const v8i A = {a0[0], a0[1], a0[2], a0[3], a1[0], a1[1], a1[2], a1[3]}, B = {b0[0], b0[1], b0[2], b0[3], b1[0], b1[1], b1[2], b1[3]};
    if (s == 0) { p0 = __builtin_amdgcn_mfma_scale_f32_32x32x64_f8f6f4(A, q8[0], negm, 2, 2, 0, SA, 0, ONE); p1 = __builtin_amdgcn_mfma_scale_f32_32x32x64_f8f6f4(B, q8[0], negm, 2, 2, 0, SA, 0, ONE); }
    else { p0 = __builtin_amdgcn_mfma_scale_f32_32x32x64_f8f6f4(A, q8[s], p0, 2, 2, 0, SA, 0, ONE); p1 = __builtin_amdgcn_mfma_scale_f32_32x32x64_f8f6f4(B, q8[s], p1, 2, 2, 0, SA, 0, ONE); } }
}
__device__ __forceinline__ int pk4_fp8(float a, float b, float c, float d) { int w = 0; w = __builtin_amdgcn_cvt_pk_fp8_f32(a, b, w, false); w = __builtin_amdgcn_cvt_pk_fp8_f32(c, d, w, true); return w; }
template <int D0> __device__ __forceinline__ void pv_one(f32x16& od, const char* vrow, int vd, bf16x8 pa0, bf16x8 pa1, bf16x8, bf16x8) {
  constexpr int ONE = 0x7f7f7f7f;
  const v4i_att b0 = *reinterpret_cast<const v4i_att*>(vrow + D0 * 2048), b1 = *reinterpret_cast<const v4i_att*>(vrow + D0 * 2048 + vd);
  asm volatile("s_waitcnt lgkmcnt(0)" ::: "memory"); ATT_SBAR();
  const v4i_att a0 = __builtin_bit_cast(v4i_att, pa0), a1 = __builtin_bit_cast(v4i_att, pa1);
  const v8i_att A = {a0[0], a0[1], a0[2], a0[3], a1[0], a1[1], a1[2], a1[3]}, B = {b0[0], b0[1], b0[2], b0[3], b1[0], b1[1], b1[2], b1[3]};
  asm volatile("s_nop 1\n\tv_mfma_scale_f32_32x32x64_f8f6f4 %0, %1, %2, %0, %3, %3 op_sel_hi:[0,0,0] cbsz:1" : "+v"(od) : "v"(A), "v"(B), "v"(ONE));
}
__device__ __forceinline__ void pv_rowsum_unused(f32x16& lacc, bf16x8 pa0, bf16x8 pa1, bf16x8 pa2, bf16x8 pa3) {
  const bf16x8 ones = {(short)0x3F80, (short)0x3F80, (short)0x3F80, (short)0x3F80, (short)0x3F80, (short)0x3F80, (short)0x3F80, (short)0x3F80};
  lacc = __builtin_amdgcn_mfma_f32_32x32x16_bf16(pa0, ones, lacc, 0, 0, 0); lacc = __builtin_amdgcn_mfma_f32_32x32x16_bf16(pa1, ones, lacc, 0, 0, 0);
  lacc = __builtin_amdgcn_mfma_f32_32x32x16_bf16(pa2, ones, lacc, 0, 0, 0); lacc = __builtin_amdgcn_mfma_f32_32x32x16_bf16(pa3, ones, lacc, 0, 0, 0);
}
#define ATT_CVT1(W, X, SEL) asm volatile("v_cvt_pk_u8_f32 %0, %1, " #SEL ", %0" : "+v"(W) : "v"(X))
#define ATT_CVT8(P, B, W, I) do { int c0_, c1_; asm volatile("v_cvt_pk_u8_f32 %0, %1, 0, 0" : "=v"(c0_) : "v"(P[B])); asm volatile("v_cvt_pk_u8_f32 %0, %1, 0, 0" : "=v"(c1_) : "v"(P[B + 4])); \
    ATT_CVT1(c0_, P[B + 1], 1); ATT_CVT1(c1_, P[B + 5], 1); ATT_CVT1(c0_, P[B + 2], 2); ATT_CVT1(c1_, P[B + 6], 2); ATT_CVT1(c0_, P[B + 3], 3); ATT_CVT1(c1_, P[B + 7], 3); \
    W[I] = c0_; W[I + 1] = c1_; } while (0)
#define ATT_CVT16(P, W) do { int c0_, c1_, c2_, c3_; asm volatile("v_cvt_pk_u8_f32 %0, %1, 0, 0" : "=v"(c0_) : "v"(P[0])); asm volatile("v_cvt_pk_u8_f32 %0, %1, 0, 0" : "=v"(c1_) : "v"(P[4])); \
    asm volatile("v_cvt_pk_u8_f32 %0, %1, 0, 0" : "=v"(c2_) : "v"(P[8])); asm volatile("v_cvt_pk_u8_f32 %0, %1, 0, 0" : "=v"(c3_) : "v"(P[12])); \
    ATT_CVT1(c0_, P[1], 1); ATT_CVT1(c1_, P[5], 1); ATT_CVT1(c2_, P[9], 1); ATT_CVT1(c3_, P[13], 1); ATT_CVT1(c0_, P[2], 2); ATT_CVT1(c1_, P[6], 2); ATT_CVT1(c2_, P[10], 2); ATT_CVT1(c3_, P[14], 2); \
    ATT_CVT1(c0_, P[3], 3); ATT_CVT1(c1_, P[7], 3); ATT_CVT1(c2_, P[11], 3); ATT_CVT1(c3_, P[15], 3); W[0] = c0_; W[1] = c1_; W[2] = c2_; W[3] = c3_; } while (0)
#define ATT_PVM(OD, B0, B1) do { const v8i_att B_ = {B0[0], B0[1], B0[2], B0[3], B1[0], B1[1], B1[2], B1[3]}; \
    asm volatile("s_nop 1\n\tv_mfma_scale_f32_32x32x64_f8f6f4 %0, %1, %2, %0, %3, %3 op_sel_hi:[0,0,0] cbsz:1" : "+v"(OD) : "v"(A), "v"(B_), "v"(ONE)); } while (0)
template <bool CVT>
__device__ __forceinline__ void pv_cvt(f32x16* o, f32x4& lsum, const char* vb, int vd, const v4i_att& a0, const v4i_att& a1, const f32x16& p0, const f32x16& p1, v4i_att& w0, v4i_att& w1, const v8i_att& bones) {
  constexpr int ONE = 0x7f7f7f7f;
  const v8i_att A = {a0[0], a0[1], a0[2], a0[3], a1[0], a1[1], a1[2], a1[3]};
  const v4i_att b00 = *reinterpret_cast<const v4i_att*>(vb), b01 = *reinterpret_cast<const v4i_att*>(vb + vd); ATT_SBAR();
  const v4i_att b10 = *reinterpret_cast<const v4i_att*>(vb + 2048), b11 = *reinterpret_cast<const v4i_att*>(vb + 2048 + vd);
  asm volatile("s_waitcnt lgkmcnt(2)" ::: "memory"); ATT_SBAR();
  ATT_PVM(o[0], b00, b01); ATT_SBAR();
  if constexpr (CVT) { asm volatile("s_nop 7" ::: "memory"); ATT_CVT8(p0, 0, w0, 0); }
  const v4i_att b20 = *reinterpret_cast<const v4i_att*>(vb + 4096), b21 = *reinterpret_cast<const v4i_att*>(vb + 4096 + vd);
  asm volatile("s_waitcnt lgkmcnt(2)" ::: "memory"); ATT_SBAR();
  ATT_PVM(o[1], b10, b11); ATT_SBAR();
  if constexpr (CVT) ATT_CVT8(p0, 8, w0, 2);
  const v4i_att b30 = *reinterpret_cast<const v4i_att*>(vb + 6144), b31 = *reinterpret_cast<const v4i_att*>(vb + 6144 + vd);
  asm volatile("s_waitcnt lgkmcnt(2)" ::: "memory"); ATT_SBAR();
  ATT_PVM(o[2], b20, b21); ATT_SBAR();
  if constexpr (CVT) ATT_CVT8(p1, 0, w1, 0);
  asm volatile("s_waitcnt lgkmcnt(0)" ::: "memory"); ATT_SBAR();
  ATT_PVM(o[3], b30, b31); ATT_SBAR();
  if constexpr (CVT) ATT_CVT8(p1, 8, w1, 2);
  asm volatile("s_nop 1\n\tv_mfma_scale_f32_16x16x128_f8f6f4 %0, %1, %2, %0, %3, %3 op_sel_hi:[0,0,0] cbsz:1" : "+v"(lsum) : "v"(A), "v"(bones), "v"(ONE));
  ATT_SBAR();
}
#define ATT_DSR(X, ADDR, OFF) asm volatile("ds_read_b128 %0, %1 offset:%2" : "=v"(X) : "v"(ADDR), "n"(OFF))
#define ATT_RK(F, S, ROFF) do { v4i x0_; v2i_att x1_; ATT_DSR(x0_, ka[2 * (S)] + kbo, (ROFF) * Cfg::RB); asm volatile("ds_read_b64 %0, %1 offset:%2" : "=v"(x1_) : "v"(ka[2 * (S) + 1] + kbo), "n"((ROFF) * Cfg::RB)); \
    F = (v8i){x0_[0], x0_[1], x0_[2], x0_[3], x1_[0], x1_[1], 0, 0}; ATT_SBAR(); } while (0)
#define ATT_RV(F, D) do { v4i x0_, x1_; ATT_DSR(x0_, va0 + vbo, (D) * 2048); ATT_DSR(x1_, va1 + vbo, (D) * 2048); \
    F = (v8i){x0_[0], x0_[1], x0_[2], x0_[3], x1_[0], x1_[1], x1_[2], x1_[3]}; ATT_SBAR(); } while (0)
#define ATT_LW(N) do { asm volatile("s_waitcnt lgkmcnt(" #N ")" ::: "memory"); ATT_SBAR(); } while (0)
#define ATT_QKM(PX, F, S) do { if ((S) == 0) PX = __builtin_amdgcn_mfma_scale_f32_32x32x64_f8f6f4(F, q8[S], negm, 2, 2, 0, SA, 0, ONE); else PX = __builtin_amdgcn_mfma_scale_f32_32x32x64_f8f6f4(F, q8[S], PX, 2, 2, 0, SA, 0, ONE); ATT_SBAR(); } while (0)
#define ATT_PVF(OD, F) do { asm volatile("s_nop 1\n\tv_mfma_scale_f32_32x32x64_f8f6f4 %0, %1, %2, %0, %3, %3 op_sel_hi:[0,0,0] cbsz:1" : "+v"(OD) : "v"(A), "v"(F), "v"(ONE)); ATT_SBAR(); } while (0)
#define ATT_PRE(KBN) do { const int kbo = (KBN); ATT_RK(fa, 0, 0); ATT_RK(fb, 0, 32); ATT_RK(fc, 1, 0); } while (0)
#define ATT_STEP_BODY(MID, PRE) do { constexpr int ONE = 0x7f7f7f7f; \
    const v8i A = {a0[0], a0[1], a0[2], a0[3], a1[0], a1[1], a1[2], a1[3]}; \
    ATT_SBAR(); \
    if constexpr (Cfg::NS == 2) { \
      ATT_LW(4); ATT_QKM(p0, fa, 0); ATT_RK(fa, 1, 32); \
      ATT_LW(4); ATT_QKM(p1, fb, 0); ATT_RV(fb, 0); \
      ATT_LW(4); ATT_QKM(p0, fc, 1); ATT_RV(fc, 1); \
      ATT_LW(4); ATT_QKM(p1, fa, 1); MID; ATT_RV(fa, 2); \
      ATT_LW(4); ATT_PVF(o[0], fb); asm volatile("s_nop 7" ::: "memory"); ATT_CVT16(p0, w0); ATT_RV(fb, 3); \
      ATT_LW(4); ATT_PVF(o[1], fc);  \
      ATT_LW(2); ATT_PVF(o[2], fa); ATT_CVT16(p1, w1); \
      ATT_LW(0); ATT_PVF(o[3], fb);  \
    } else { \
      ATT_LW(4); ATT_QKM(p0, fa, 0); ATT_RK(fa, 1, 32); \
      ATT_LW(4); ATT_QKM(p1, fb, 0); ATT_RK(fb, 2, 0); \
      ATT_LW(4); ATT_QKM(p0, fc, 1); ATT_RK(fc, 2, 32); \
      ATT_LW(4); ATT_QKM(p1, fa, 1); ATT_RV(fa, 0); \
      ATT_LW(4); ATT_QKM(p0, fb, 2); ATT_RV(fb, 1); \
      ATT_LW(4); ATT_QKM(p1, fc, 2); MID; ATT_RV(fc, 2); \
      ATT_LW(4); ATT_PVF(o[0], fa); asm volatile("s_nop 7" ::: "memory"); ATT_CVT16(p0, w0); ATT_RV(fa, 3); \
      ATT_LW(4); ATT_PVF(o[1], fb);  \
      ATT_LW(2); ATT_PVF(o[2], fc); ATT_CVT16(p1, w1); \
      ATT_LW(0); ATT_PVF(o[3], fa);  \
    } \
    asm volatile("s_nop 1\n\tv_mfma_scale_f32_16x16x128_f8f6f4 %0, %1, %2, %0, %3, %3 op_sel_hi:[0,0,0] cbsz:1" : "+v"(lsum) : "v"(A), "v"(bones), "v"(ONE)); ATT_SBAR(); PRE; } while (0)
#undef ATT_PVM
__device__ __forceinline__ void pv_d0(f32x16* o, const char* vb, int vd, bf16x8 pa0, bf16x8 pa1, bf16x8 pa2, bf16x8 pa3) {
  pv_one<0>(o[0], vb, vd, pa0, pa1, pa2, pa3); pv_one<1>(o[1], vb, vd, pa0, pa1, pa2, pa3); pv_one<2>(o[2], vb, vd, pa0, pa1, pa2, pa3); pv_one<3>(o[3], vb, vd, pa0, pa1, pa2, pa3);
}
__device__ __forceinline__ float pv_d0_max(f32x16* o, const char* vb, int vd, bf16x8 pa0, bf16x8 pa1, bf16x8 pa2, bf16x8 pa3, const f32x16& x0, const f32x16& x1) {
  pv_one<0>(o[0], vb, vd, pa0, pa1, pa2, pa3); const float m0 = max8(x0, 0);
  pv_one<1>(o[1], vb, vd, pa0, pa1, pa2, pa3); const float m1 = max8(x0, 8);
  pv_one<2>(o[2], vb, vd, pa0, pa1, pa2, pa3); const float m2 = max8(x1, 0);
  pv_one<3>(o[3], vb, vd, pa0, pa1, pa2, pa3); const float m3 = max8(x1, 8);
  return max2f(max3f(m0, m1, m2), m3);
}
__device__ __forceinline__ void unpack8(bf16x8 v, float* f) {
  const u32x4 w = *reinterpret_cast<const u32x4*>(&v);
#pragma unroll
  for (int k = 0; k < 4; ++k) { f[2 * k] = __uint_as_float(w[k] << 16); f[2 * k + 1] = __uint_as_float(w[k] & 0xffff0000u); }
}
__device__ __forceinline__ void rope8(float* a, float* b, const float* cs, const float* sn) {
  const f32x4 c0 = *(const f32x4*)cs, c1 = *(const f32x4*)(cs + 4), s0 = *(const f32x4*)sn, s1 = *(const f32x4*)(sn + 4);
#pragma unroll
  for (int i = 0; i < 8; ++i) { const float c = i < 4 ? c0[i & 3] : c1[i & 3], s = i < 4 ? s0[i & 3] : s1[i & 3]; const float x = a[i], y = b[i]; a[i] = x * c - y * s; b[i] = y * c + x * s; }
}

template <class Cfg, bool STATIC>
__device__ __forceinline__ void attn_unit(const bf16* __restrict__ Qn, const bf16* __restrict__ Qp, const unsigned char* __restrict__ Kh, const unsigned char* __restrict__ Vh,
                                          bf16* __restrict__ Ob, int seq, ATT_LAS unsigned char* ldsL, char* lds, int t0, const float* __restrict__ gq_n, const float* __restrict__ gq_p, const float* __restrict__ rope_tab, float mbound, int wave_in, int var = 0) {
  constexpr int DQK = Cfg::DQK, LDQ = Cfg::LDQ, LDK = Cfg::LDK, LDV = Cfg::LDV, LDO = Cfg::LDO;
  constexpr bool MSUM = Cfg::MSUM;
  constexpr int SHM_V = KVBLK * DV, SHM_K = KVBLK * Cfg::RB, NCH = Cfg::RB / 16, KPT = KVBLK * NCH / 512, NV = KPT + 1, NB = STATIC ? 4 : 3, KOFF = NB * SHM_V, NS = Cfg::NS, LDVT = Cfg::LDVT;
  int tid_; asm volatile("v_mbcnt_lo_u32_b32 %0, -1, 0\n\tv_mbcnt_hi_u32_b32 %0, -1, %0" : "=&v"(tid_)); tid_ |= wave_in << 6;
  const int tid = tid_, wid = __builtin_amdgcn_readfirstlane(tid >> 6), lane = tid & 63, r32 = lane & 31, hi = lane >> 5;
  char* V_lds = lds; char* K_lds = lds + KOFF;
  float* ws = (float*)(lds + KOFF + NB * SHM_K) + wid * 64; float* li_l = ws; float* al_l = ws + 32;
  unsigned kgo[KPT], vgo[2];
#pragma unroll
  for (int k = 0; k < KPT; ++k) { const int s = (k * 8 + wid) * 64 + lane, row = s / NCH, csw = s - row * NCH, c = csw ^ kswf<Cfg::RB>(row); kgo[k] = (unsigned)(row * LDK + (c * 16 < Cfg::KROWB ? c * 16 : 0)); }
  { const int s16 = wid * 64 + lane, d = s16 >> 2, c = (s16 & 3) ^ ((d >> 2) & 3); vgo[0] = (unsigned)(d * LDVT + c * 16); vgo[1] = 0u; }
#define ATT_ISSUE_K(b, k0) do { const char* kt_ = (const char*)Kh + (long)(k0) * LDK; asm volatile("" : "+s"(kt_));     \
    _Pragma("unroll") for (int k_ = 0; k_ < KPT; ++k_) __builtin_amdgcn_global_load_lds((const unsigned*)(kt_ + (size_t)kgo[k_]), (ATT_LAS unsigned*)(ldsL + KOFF + (b) * SHM_K + (k_ * 8 + wid) * 1024), 16, 0, 0); } while (0)
#define ATT_ISSUE_V(b, k0) do { const char* vt_ = (const char*)Vh + (k0); asm volatile("" : "+s"(vt_));        \
    __builtin_amdgcn_global_load_lds((const unsigned*)(vt_ + (size_t)vgo[0]), (ATT_LAS unsigned*)(ldsL + (b) * SHM_V + wid * 1024), 16, 0, 0); } while (0)
#define ATT_ISSUE(b, k0) do { ATT_ISSUE_K(b, k0); ATT_ISSUE_V(b, k0); } while (0)
#define ATT_WAITV_NV() do { if constexpr (NV == 2) asm volatile("s_waitcnt vmcnt(2)" ::: "memory"); else asm volatile("s_waitcnt vmcnt(3)" ::: "memory"); } while (0)
#define ATT_WAITV_2NV() do { if constexpr (NV == 2) asm volatile("s_waitcnt vmcnt(4)" ::: "memory"); else asm volatile("s_waitcnt vmcnt(6)" ::: "memory"); } while (0)
#define ATT_BAR() do { asm volatile("s_waitcnt lgkmcnt(0)" ::: "memory"); __builtin_amdgcn_s_barrier(); asm volatile("" ::: "memory"); } while (0)
  float m_reg = 0.f, l_reg = 0; f32x16 negm = {}; v8i q8[NS];
  if constexpr (STATIC) {
#pragma unroll
    for (int r = 0; r < 16; ++r) negm[r] = 4.f * (15.5f - mbound) + 60.5f; }
  {
    const bf16* qrow = Qn + (long)(wid * QBLK + r32) * LDQ;
    const bf16* prow = Qp + (long)(wid * QBLK + r32) * LDQ;
    const int t = (t0 >= 0 ? t0 : 0) + wid * QBLK + r32, pr = t >> 6, pc = t & 63; const bool do_rope = t0 >= 0;
    constexpr float CQ = Cfg::SCALE * 1.4426950408889634f * 16.f;
    float ssn = 0.f, ssp = 0.f;
#pragma unroll
    for (int s = 0; s < NS; ++s) {
#pragma unroll
      for (int c = 0; c < 4; ++c) {
        const bf16* src;
        if constexpr (Cfg::MLA) src = (s < 2 ? qrow + 64 * s + 32 * hi : prow + 32 * hi) + 8 * c;
        else src = qrow + 64 * s + 16 * hi + (c & 1) * 8 + (c >> 1) * 32;
        float f[8]; unpack8(*reinterpret_cast<const bf16x8*>(src), f); float sq = 0.f;
#pragma unroll
        for (int i = 0; i < 8; ++i) sq += f[i] * f[i];
        if (Cfg::MLA && s == 2) ssp += sq; else ssn += sq; } }
    ssn += att_shx(ssn, lane, 32); ssp += att_shx(ssp, lane, 32);
    const float rn = rsqrtf(ssn * (1.f / 128.f) + 1e-6f) * CQ, rp = rsqrtf(ssp * (1.f / 64.f) + 1e-6f) * CQ;
#define ATT_SCALE8(f, r, gp) do { const f32x4 g0_ = *(const f32x4*)(gp), g1_ = *(const f32x4*)((gp) + 4); \
      _Pragma("unroll") for (int i_ = 0; i_ < 8; ++i_) f[i_] *= (r) * (i_ < 4 ? g0_[i_ & 3] : g1_[i_ & 3]); } while (0)
#pragma unroll
    for (int s = 0; s < NS; ++s) {
      float fa0[8], fa1[8], fb0[8], fb1[8];
      if constexpr (Cfg::MLA) {
        const bf16* src = s < 2 ? qrow + 64 * s + 32 * hi : prow + 32 * hi; const float* gp = s < 2 ? gq_n + 64 * s + 32 * hi : gq_p + 32 * hi; const float r = s < 2 ? rn : rp;
        unpack8(*reinterpret_cast<const bf16x8*>(src), fa0); unpack8(*reinterpret_cast<const bf16x8*>(src + 8), fa1); unpack8(*reinterpret_cast<const bf16x8*>(src + 16), fb0); unpack8(*reinterpret_cast<const bf16x8*>(src + 24), fb1);
        ATT_SCALE8(fa0, r, gp); ATT_SCALE8(fa1, r, gp + 8); ATT_SCALE8(fb0, r, gp + 16); ATT_SCALE8(fb1, r, gp + 24);
        if (s == 2 && do_rope) { const float* cs = rope_tab; const float* sn = rope_tab + 128 * 16; const int p = hi ? pc : pr;
          rope8(fa0, fb0, cs + p * 16, sn + p * 16); rope8(fa1, fb1, cs + p * 16 + 8, sn + p * 16 + 8); }
      } else {
        const bf16* src = qrow + 64 * s + 16 * hi; const float* gp = gq_n + 64 * s + 16 * hi;
        unpack8(*reinterpret_cast<const bf16x8*>(src), fa0); unpack8(*reinterpret_cast<const bf16x8*>(src + 8), fa1); unpack8(*reinterpret_cast<const bf16x8*>(src + 32), fb0); unpack8(*reinterpret_cast<const bf16x8*>(src + 40), fb1);
        ATT_SCALE8(fa0, rn, gp); ATT_SCALE8(fa1, rn, gp + 8); ATT_SCALE8(fb0, rn, gp + 32); ATT_SCALE8(fb1, rn, gp + 40);
        if (do_rope) { const float* cs = rope_tab; const float* sn = rope_tab + 128 * 32; const int p = s ? pc : pr;
          rope8(fa0, fb0, cs + p * 32 + 16 * hi, sn + p * 32 + 16 * hi); rope8(fa1, fb1, cs + p * 32 + 16 * hi + 8, sn + p * 32 + 16 * hi + 8); }
      }
      { typedef float v16f_q __attribute__((ext_vector_type(16))); v16f_q xa, xb;
#pragma unroll
        for (int i = 0; i < 8; ++i) { xa[i] = fa0[i]; xa[8 + i] = fa1[i]; xb[i] = fb0[i]; xb[8 + i] = fb1[i]; }
        const auto r6 = __builtin_amdgcn_cvt_scalef32_2xpk16_fp6_f32(xa, xb, 1.0f);
        q8[s] = (v8i){(int)r6[0], (int)r6[1], (int)r6[2], (int)r6[3], (int)r6[4], (int)r6[5], 0, 0}; }
    }
#undef ATT_SCALE8
  }
  asm volatile("s_waitcnt vmcnt(0)" ::: "memory");
  const int NT = seq / KVBLK;
  ATT_ISSUE(0, 0); ATT_ISSUE(1, KVBLK); ATT_ISSUE(2, 2 * KVBLK);
  f32x16 o[4] = {}; f32x16 lacc = {}; f32x4 lsum = {0.f, 0.f, 0.f, 0.f}; v8i_att bones;
  { int on = (((lane >> 3) & 1) == ((lane >> 4) & 1)) ? 0x38383838 : 0; asm volatile("" : "+v"(on)); bones = (v8i_att){on, on, on, on, on, on, on, on}; }
  constexpr int SA = STATIC ? 0x7c7c7c7c : 0x7a7a7a7a;
  const int cA_ = (2 * hi) ^ ((r32 >> 2) & 3), vd0 = (cA_ & 1) ? -16 : 16;
  const char* vb0 = V_lds + r32 * 64 + (cA_ << 4);
#define ATT_QK_SCHED() do { } while (0)
#define ATT_RESC(a) do { if (__any((a) < 1.f)) { if (hi == 0) al_l[r32] = (a); asm volatile("s_nop 15\n\ts_nop 15\n\ts_waitcnt lgkmcnt(0)" ::: "memory"); \
    _Pragma("unroll") for (int r = 0; r < 16; ++r) { const float a_ = al_l[crow(r, hi)]; _Pragma("unroll") for (int d = 0; d < 4; ++d) o[d][r] *= a_; if constexpr (MSUM) lacc[r] *= a_; } } } while (0)
  if constexpr (STATIC) {
  f32x16 p0, p1; v4i_att wa0, wa1, wb0, wb1;
  unsigned ka[2 * NS];
#pragma unroll
  for (int s_ = 0; s_ < NS; ++s_) { ka[2 * s_] = (unsigned)(size_t)ldsL + KOFF + kswz8<Cfg::RB>(r32, 4 * s_ + 2 * hi); ka[2 * s_ + 1] = (unsigned)(size_t)ldsL + KOFF + kswz8<Cfg::RB>(r32, 4 * s_ + 2 * hi + 1); }
  const unsigned va0 = (unsigned)(size_t)ldsL + r32 * 64 + (cA_ << 4), va1 = va0 + vd0;
  v8i fa, fb, fc;
#define ATT_BARX() do { __builtin_amdgcn_s_barrier(); asm volatile("" ::: "memory"); } while (0)
  ATT_WAITV_NV(); ATT_BAR();
  ATT_ISSUE_K(3, 3 * KVBLK);
  qkt<Cfg, SA>(p0, p1, K_lds, q8, negm, r32, hi);
  asm volatile("s_nop 15\n\ts_nop 15" ::: "memory"); ATT_CVT8(p0, 0, wa0, 0); ATT_CVT8(p0, 8, wa0, 2); ATT_CVT8(p1, 0, wa1, 0); ATT_CVT8(p1, 8, wa1, 2);
  ATT_SBAR(); ATT_PRE(SHM_K);
  ATT_WAITV_NV(); ATT_BARX();
#define ATT_SSTEP(j, WP0, WP1, WC0, WC1) do { \
    if ((j) + 3 < NT) { ATT_ISSUE_K(((j) + 3) & 3, ((j) + 3) * KVBLK); } \
    { const int kbo = ((j) & 3) * SHM_K, vbo = (((j) - 1) & 3) * SHM_V, kbn = (((j) + 1) & 3) * SHM_K; const v4i_att& a0 = WP0; const v4i_att& a1 = WP1; v4i_att& w0 = WC0; v4i_att& w1 = WC1; \
      ATT_STEP_BODY(if ((j) + 2 < NT) { ATT_ISSUE_V(((j) + 2) & 3, ((j) + 2) * KVBLK); }, ATT_PRE(kbn)); } \
    if ((j) + 3 < NT) ATT_WAITV_NV(); else if ((j) + 2 < NT) asm volatile("s_waitcnt vmcnt(1)" ::: "memory"); else asm volatile("s_waitcnt vmcnt(0)" ::: "memory"); \
    ATT_BARX(); } while (0)
  for (int j = 1; j + 1 < NT; j += 2) {
    ATT_SSTEP(j, wa0, wa1, wb0, wb1);
    ATT_SSTEP(j + 1, wb0, wb1, wa0, wa1);
  }
  { const int kbo = ((NT - 1) & 3) * SHM_K, vbo = ((NT - 2) & 3) * SHM_V;
    { const v4i_att& a0 = wa0; const v4i_att& a1 = wa1; v4i_att& w0 = wb0; v4i_att& w1 = wb1;
      ATT_STEP_BODY((void)0, (void)0); }
    pv_cvt<false>(o, lsum, vb0 + ((NT - 1) & 3) * SHM_V, vd0, wb0, wb1, p0, p1, wa0, wa1, bones);
    asm volatile("s_nop 15\n\ts_nop 15" ::: "memory"); }
#undef ATT_BARX
#undef ATT_SSTEP
  } else {
  f32x16 pA0, pA1, pB0, pB1; float alA, alB; bf16x8 pa0, pa1, pa2, pa3;
  ATT_WAITV_2NV(); ATT_BAR();
  qkt<Cfg, SA>(pA0, pA1, K_lds, q8, negm, r32, hi); alA = 1.f; alB = 1.f; if constexpr (!STATIC) decideSM<true>(pA0, pA1, max2f(max3f(max8(pA0, 0), max8(pA0, 8), max8(pA1, 0)), max8(pA1, 8)), m_reg, negm, alA);
  ATT_WAITV_NV(); ATT_BAR();
  int bc = 1;
#define ATT_FIN(Y0, Y1, alY) do { if constexpr (STATIC) finishU8(Y0, Y1, pa0, pa1); else finishSM<true>(Y0, Y1, alY, l_reg, pa0, pa1, pa2, pa3); } while (0)
#define ATT_STEP(j, X0, X1, mnX, alX, Y0, Y1, alY) do { const int bp = bc == 0 ? 2 : bc - 1, bn = bc == 2 ? 0 : bc + 1; \
    ATT_SBAR(); qkt<Cfg, SA>(X0, X1, K_lds + bc * SHM_K, q8, negm, r32, hi); \
    ATT_FIN(Y0, Y1, alY); ATT_QK_SCHED(); ATT_SBAR(); \
    if ((j) >= 2 && (j) + 1 < NT) { ATT_ISSUE_V(bn, ((j) + 1) * KVBLK); }     \
    {  if constexpr (STATIC) { pv_d0(o, vb0 + bp * SHM_V, vd0, pa0, pa1, pa2, pa3); rowsum16(lsum, pa0, pa1, bones); } else { const float pm_ = pv_d0_max(o, vb0 + bp * SHM_V, vd0, pa0, pa1, pa2, pa3, X0, X1); decideSM<false>(X0, X1, pm_, m_reg, negm, alX); } } \
    if ((j) + 2 < NT) asm volatile("s_waitcnt vmcnt(1)" ::: "memory"); else asm volatile("s_waitcnt vmcnt(0)" ::: "memory");     \
    ATT_BAR();                                              \
    if ((j) + 2 < NT) { ATT_ISSUE_K(bp, ((j) + 2) * KVBLK); } \
    if constexpr (!STATIC) { ATT_RESC(alX); } bc = bn; } while (0)
  for (int j = 1; j + 1 < NT; j += 2) {
    ATT_STEP(j, pB0, pB1, mnB, alB, pA0, pA1, alA);
    ATT_STEP(j + 1, pA0, pA1, mnA, alA, pB0, pB1, alB);
  }
  { const int bp = bc == 0 ? 2 : bc - 1;
    ATT_SBAR(); qkt<Cfg, SA>(pB0, pB1, K_lds + bc * SHM_K, q8, negm, r32, hi);
    ATT_FIN(pA0, pA1, alA); ATT_SBAR();
    {  if constexpr (STATIC) { pv_d0(o, vb0 + bp * SHM_V, vd0, pa0, pa1, pa2, pa3); rowsum16(lsum, pa0, pa1, bones); } else { const float pm_ = pv_d0_max(o, vb0 + bp * SHM_V, vd0, pa0, pa1, pa2, pa3, pB0, pB1); decideSM<false>(pB0, pB1, pm_, m_reg, negm, alB); } }
    if constexpr (!STATIC) { ATT_RESC(alB); }
    ATT_FIN(pB0, pB1, alB); ATT_SBAR();
    pv_d0(o, vb0 + bc * SHM_V, vd0, pa0, pa1, pa2, pa3); if constexpr (STATIC) rowsum16(lsum, pa0, pa1, bones); asm volatile("s_nop 15\n\ts_nop 15" ::: "memory"); }
  }
  float rli[16];
  if constexpr (MSUM) {
#pragma unroll
    for (int r = 0; r < 16; ++r) rli[r] = __builtin_amdgcn_rcpf(lacc[r]);
  } else { if constexpr (STATIC) { if ((lane & 7) == 0) { float* dl = li_l + ((lane & 8) ? 16 : 0) + 4 * (lane >> 4); dl[0] = lsum[0]; dl[1] = lsum[1]; dl[2] = lsum[2]; dl[3] = lsum[3]; } }
    else { if (hi == 0) li_l[r32] = l_reg; }
    asm volatile("s_waitcnt lgkmcnt(0)" ::: "memory");
#pragma unroll
    for (int r = 0; r < 16; ++r) rli[r] = __builtin_amdgcn_rcpf(li_l[crow(r, hi)]); }
  bf16* Ow = Ob + (long)(wid * QBLK) * LDO;
  const int odd = lane & 1;
#pragma unroll
  for (int r = 0; r < 16; r += 2) {
#pragma unroll
    for (int d0 = 0; d0 < 4; ++d0) {
      const float v0 = o[d0][r] * rli[r], v1 = o[d0][r + 1] * rli[r + 1];
      const float snd = odd ? v0 : v1, rcv = att_shx(snd, lane, 1);
      const unsigned w = odd ? cvtpk(rcv, v1) : cvtpk(v0, rcv);
      const int orow = crow(odd ? r + 1 : r, hi);
      *reinterpret_cast<unsigned*>(Ow + (long)orow * LDO + d0 * 32 + (r32 & ~1)) = w; } }
  ATT_BAR();
#undef ATT_ISSUE
#undef ATT_WAITV_NV
#undef ATT_WAITV_2NV
#undef ATT_BAR
#undef ATT_RESC
#undef ATT_STEP
#undef ATT_FIN
#undef ATT_CVT8
#undef ATT_CVT16
#undef ATT_RK
#undef ATT_DSR
#undef ATT_LW
#undef ATT_RV
#undef ATT_QKM
#undef ATT_PVF
#undef ATT_STEP_BODY
#undef ATT_PRE
#undef ATT_CVT1
}
}

constexpr int D = 2048, BATCH = 2, SEQ = 8192, CTX = 256, DEPTH = 4, DFF = 5632;
constexpr int SB = SEQ + CTX;
constexpr int R = BATCH * SB;
constexpr int NMOD = 6 * D;
constexpr float EPS = 1e-6f;
constexpr int NWAVES = 8;
constexpr int PH_PER_LAYER = 11, N_PHASES = 1 + DEPTH * PH_PER_LAYER;

constexpr size_t MiB = 1u << 20;
constexpr size_t WS_CTL = 0, CTL_ZERO_BYTES = 1 * MiB;
constexpr size_t WS_MOD = 1 * MiB;
constexpr size_t WS_ROPE = 2 * MiB;
constexpr size_t WS_W = 4 * MiB;
constexpr size_t SZ_W1 = (size_t)1280 * 2048 * 2, SZ_WUQ = (size_t)3072 * 512 * 2, SZ_WUKV = (size_t)4096 * 512 * 2, SZ_WO = (size_t)2048 * 2048 * 2;
constexpr size_t SZ_WQKV = (size_t)3072 * 2048 * 2, SZ_WUP = (size_t)11264 * 2048 * 2, SZ_WDN = (size_t)2048 * 5632 * 2;
constexpr size_t SZ_MLA = SZ_W1 + SZ_WUQ + SZ_WUKV + SZ_WO, SZ_GQA = SZ_WQKV + SZ_WO, SZ_FFN = SZ_WUP + SZ_WDN;
constexpr size_t WS_WMLA = WS_W, WS_WGQA = WS_WMLA + 2 * SZ_MLA, WS_WFFN = WS_WGQA + 2 * SZ_GQA, WS_WEND = WS_WFFN + 4 * SZ_FFN;
static_assert(WS_WEND <= 376 * MiB, "weights");
constexpr size_t WS_X = 376 * MiB;
constexpr size_t WS_H = 508 * MiB;
constexpr size_t WS_BIG = 576 * MiB;
constexpr size_t WS_U = WS_BIG;
constexpr size_t WS_GH = WS_BIG, WS_VH = WS_BIG + 24 * MiB;
constexpr size_t WS_ACT = 940 * MiB;
constexpr size_t WS_RAW1 = WS_BIG;
constexpr size_t WS_CQ = 660 * MiB, WS_CKV = 677 * MiB, WS_KPE = 694 * MiB;
constexpr size_t WS_QRAW = 700 * MiB;
constexpr size_t WS_KVRAW = 800 * MiB;
constexpr size_t WS_KMLA = 932 * MiB;
constexpr size_t WS_QKV = WS_BIG;
constexpr size_t WS_KGQA = 676 * MiB;
constexpr size_t WS_OGQA = 700 * MiB;
constexpr size_t WS_END = 1124 * MiB;
static_assert(WS_X + (size_t)R * D * 4 <= WS_H && WS_H + (size_t)R * D * 2 <= WS_BIG && WS_GH + (size_t)264 * 4 * 5632 * 4 <= WS_VH && WS_VH + (size_t)264 * 2 * 5632 * 4 <= WS_ACT && WS_ACT + (size_t)R * DFF * 2 <= WS_END, "ws map 1");
static_assert(WS_RAW1 + (size_t)R * 1280 * 4 <= WS_CQ && WS_CQ + (size_t)R * 512 * 2 <= WS_CKV && WS_CKV + (size_t)R * 512 * 2 <= WS_KPE && WS_KPE + (size_t)R * 64 * 2 <= WS_QRAW, "ws map 2");
static_assert(WS_QRAW + (size_t)R * 3072 * 2 <= WS_KVRAW && WS_KVRAW + (size_t)R * 4096 * 2 <= WS_KMLA && WS_KMLA + (size_t)R * 3072 * 2 <= WS_END, "ws map 3");
static_assert(WS_QKV + (size_t)R * 3072 * 2 <= WS_KGQA && WS_KGQA + (size_t)R * 512 * 2 <= WS_OGQA && WS_OGQA + (size_t)R * 2048 * 2 <= WS_END, "ws map 4");
constexpr size_t WS_PART = 800 * MiB;
constexpr int NSPLIT_WO = 8, NSPLIT_DN = 11;
constexpr size_t WS_CB = 352 * MiB;
constexpr size_t WS_STAT = 354 * MiB;
constexpr size_t WS_AV = 355 * MiB;
constexpr size_t WS_W8GQA = 360 * MiB, SZ_W8GQA = (size_t)3072 * 2048;
constexpr size_t WS_V8T_MLA = 990 * MiB, WS_V8T_GQA = 780 * MiB;
constexpr size_t WS_XS8 = 720 * MiB;
constexpr int CBN = 11264;
static_assert(WS_KMLA + (size_t)R * 3072 <= WS_V8T_MLA && WS_V8T_MLA + (size_t)2 * 16 * 128 * 8448 <= WS_END && WS_OGQA + (size_t)R * 2048 * 2 <= WS_V8T_GQA && WS_V8T_GQA + (size_t)2 * 4 * 128 * 8448 <= WS_PART, "ws map 7");
static_assert(WS_W8GQA + 2 * SZ_W8GQA <= WS_X && WS_XS8 + (size_t)R * 2048 <= WS_PART, "ws map 6");
static_assert(WS_WEND <= WS_CB && WS_CB + (size_t)8 * 3 * CBN * 4 <= WS_STAT && WS_STAT + (size_t)8 * R * 4 <= WS_AV && WS_AV + (size_t)8 * 3 * D * 4 <= WS_X, "ws map 5");
constexpr int CW_BAR = 4096;

constexpr int RING_OFF = 0, RING_BYTES = 131072;
constexpr int LDSCTL_OFF = RING_BYTES, MISC_OFF = LDSCTL_OFF + 320;
constexpr int LDS_BYTES = 147456;

struct Args {
    const float* in[28]; float* out; unsigned char* ws; int ph_lo, ph_hi, var;
};

struct Frame {
    LAS unsigned char* lds; char* ldsg;
    int tid, lane, wave, G, gw, NGW, bid;
};

__device__ __forceinline__ float shx(float v, int lane, int o) { return __builtin_bit_cast(float, __builtin_amdgcn_ds_bpermute((lane ^ o) << 2, __builtin_bit_cast(int, v))); }
__device__ __forceinline__ float wave_sum(float v, int lane) {
#pragma unroll
    for (int o = 1; o < 64; o <<= 1) v += shx(v, lane, o);
    return v;
}
__device__ __forceinline__ float sum16(float v, int lane) {
#pragma unroll
    for (int o = 1; o < 16; o <<= 1) v += shx(v, lane, o);
    return v;
}
__device__ __forceinline__ unsigned pk2(float lo, float hi) { unsigned r; asm volatile("v_cvt_pk_bf16_f32 %0, %1, %2" : "=v"(r) : "v"(lo), "v"(hi)); return r; }
__device__ __forceinline__ float bf_lo(unsigned w) { return __uint_as_float(w << 16); }
__device__ __forceinline__ float bf_hi(unsigned w) { return __uint_as_float(w & 0xffff0000u); }
__device__ __forceinline__ float silu_f(float x) { return x / (1.f + __expf(-x)); }

__device__ __forceinline__ unsigned pk4f8(float a, float b, float c, float d) { int w = 0; w = __builtin_amdgcn_cvt_pk_fp8_f32(a, b, w, false); w = __builtin_amdgcn_cvt_pk_fp8_f32(c, d, w, true); return (unsigned)w; }
constexpr float W8_SCALE = 64.0f; constexpr int W8_E8M0 = 0x79797979;
__device__ __forceinline__ void transpose_item(const float* W, int K, int N, bf16* WT, int drow0, int k0, int n0, LAS float* scr, int lane, const float* shv, float* cacc, int f8 = 0, unsigned char* WT8 = nullptr) {
    { f32x4 r[8]; const int kr = lane >> 3, n4 = (lane & 7) * 4;
#pragma unroll
      for (int i = 0; i < 8; ++i) r[i] = *(const f32x4*)(W + (size_t)(k0 + 8 * i + kr) * N + n0 + n4);
      asm volatile("" ::: "memory");
#pragma unroll
      for (int i = 0; i < 8; ++i) { LAS float* d = scr + (8 * i + kr) * 33 + n4; d[0] = r[i].x; d[1] = r[i].y; d[2] = r[i].z; d[3] = r[i].w; } }
    LDS_WAIT(); asm volatile("" ::: "memory");
    const int c = lane & 7;
#pragma unroll
    for (int j = 0; j < 4; ++j) { const int n = (lane >> 3) + 8 * j; const LAS float* s = scr + (8 * c) * 33 + n;
        v4u o; o.x = pk2(s[0 * 33], s[1 * 33]); o.y = pk2(s[2 * 33], s[3 * 33]); o.z = pk2(s[4 * 33], s[5 * 33]); o.w = pk2(s[6 * 33], s[7 * 33]);
        if (f8) { v2u o8; o8.x = pk4f8(s[0 * 33] * W8_SCALE, s[1 * 33] * W8_SCALE, s[2 * 33] * W8_SCALE, s[3 * 33] * W8_SCALE); o8.y = pk4f8(s[4 * 33] * W8_SCALE, s[5 * 33] * W8_SCALE, s[6 * 33] * W8_SCALE, s[7 * 33] * W8_SCALE);
            *(v2u*)((f8 == 2 ? WT8 : (unsigned char*)WT) + (size_t)(drow0 + n) * K + k0 + 8 * c) = o8; }
        if (f8 != 1) *(v4u*)(WT + (size_t)(drow0 + n) * K + k0 + 8 * c) = o; }
    if (shv) {
        const float s0 = shv[k0 + lane], s1 = shv[NMOD + k0 + lane], s2 = shv[2 * NMOD + k0 + lane];
        const int n = lane & 31; float a0 = 0.f, a1 = 0.f, a2 = 0.f;
#pragma unroll 4
        for (int kk = 0; kk < 64; ++kk) { const float w = scr[kk * 33 + n];
            a0 = fmaf(__builtin_bit_cast(float, __builtin_amdgcn_readlane(__builtin_bit_cast(int, s0), kk)), w, a0);
            a1 = fmaf(__builtin_bit_cast(float, __builtin_amdgcn_readlane(__builtin_bit_cast(int, s1), kk)), w, a1);
            a2 = fmaf(__builtin_bit_cast(float, __builtin_amdgcn_readlane(__builtin_bit_cast(int, s2), kk)), w, a2); }
        if (lane < 32) { float* cp = cacc + drow0 + n; unsafeAtomicAdd(cp, a0); unsafeAtomicAdd(cp + CBN, a1); unsafeAtomicAdd(cp + 2 * CBN, a2); }
    }
    LDS_WAIT(); asm volatile("" ::: "memory");
}
__device__ __forceinline__ int dest_row(int mode, int roff, int n0) {
    if (mode == 1) { const int h = n0 / 192, d = n0 - h * 192; return d < 128 ? h * 128 + d : 2048 + h * 64 + (d - 128); }
    if (mode == 2) { const int h = n0 >> 8, d = n0 & 255; return d < 128 ? h * 128 + d : 2048 + h * 128 + (d - 128); }
    if (mode == 3) { const int f = n0 < 5632 ? n0 : n0 - 5632; return (f >> 7) * 256 + (f & 127) + (n0 < 5632 ? 0 : 128); }
    return roff + n0;
}
__device__ __forceinline__ void transpose_matrix(const Frame& F, const float* W, int K, int N, bf16* WT, int mode, int roff, int rot, const float* shv = nullptr, float* cacc = nullptr, int f8 = 0, unsigned char* WT8 = nullptr) {
    LAS float* scr = (LAS float*)(F.lds + RING_OFF + F.wave * 16384);
    const int nblk = N / 32, items = (K / 64) * nblk;
    int g = F.gw + rot; if (g >= F.NGW) g -= F.NGW;
    for (int it = g; it < items; it += F.NGW) { const int kb = it / nblk, nb = it - kb * nblk; transpose_item(W, K, N, WT, dest_row(mode, roff, nb * 32), kb * 64, nb * 32, scr, F.lane, shv, cacc, f8, WT8); }
}

typedef const __attribute__((address_space(4))) Args* KargPtr0;
__device__ __forceinline__ void p0a_prologue(const Frame& F, KargPtr0 ap) {
    unsigned char* ws = ap->ws;
    __syncthreads();
    {
        LAS float* S = (LAS float*)(F.lds + RING_OFF);
        LAS float* P = (LAS float*)(F.lds + RING_OFF + 24576);
        for (int i = F.tid; i < 3 * D; i += 512) { const int v = i / D, k = i - v * D; const float x = v < 2 ? ap->in[1][v * D + k] : ap->in[3][k]; S[i] = silu_f(x); }
        __syncthreads();
        for (int u = F.bid; u < 256; u += F.G) {
            const int l = u >> 6, n0 = (u & 63) * 192;
            const float* Wl = ap->in[4] + (size_t)l * D * NMOD + n0 + 4 * F.lane;
            f32x4 acc0 = {0.f, 0.f, 0.f, 0.f}, acc1 = acc0, acc2 = acc0;
            if (F.lane < 48) {
                const int kb = F.wave * 256;
#pragma unroll 8
                for (int k = 0; k < 256; ++k) { const f32x4 w = *(const f32x4*)(Wl + (size_t)(kb + k) * NMOD); acc0 += w * S[kb + k]; acc1 += w * S[D + kb + k]; acc2 += w * S[2 * D + kb + k]; }
#pragma unroll
                for (int j = 0; j < 4; ++j) { P[(F.wave * 3 + 0) * 192 + 4 * F.lane + j] = acc0[j]; P[(F.wave * 3 + 1) * 192 + 4 * F.lane + j] = acc1[j]; P[(F.wave * 3 + 2) * 192 + 4 * F.lane + j] = acc2[j]; }
            }
            __syncthreads();
            for (int i = F.tid; i < 576; i += 512) { const int v = i / 192, n = i - v * 192; float s = ap->in[5][(size_t)l * NMOD + n0 + n];
#pragma unroll
                for (int w = 0; w < 8; ++w) s += P[(w * 3 + v) * 192 + n];
                ((float*)(ws + WS_MOD))[(size_t)(l * 3 + v) * NMOD + n0 + n] = s; }
            __syncthreads();
        }
    }
    {
        float* T = (float*)(ws + WS_ROPE);
        for (int i = F.bid * 512 + F.tid; i < 128 * 16 + 128 * 32; i += F.G * 512) {
            int p, j, ad, base; if (i < 128 * 16) { p = i >> 4; j = i & 15; ad = 32; base = 0; } else { const int q = i - 128 * 16; p = q >> 5; j = q & 31; ad = 64; base = 2 * 128 * 16; }
            const float e = -(float)(2 * j) / (float)ad, inv = powf(10000.0f, e), ang = (float)p * inv;
            const int J = ad / 2;
            T[base + p * J + j] = cosf(ang); T[base + 128 * J + p * J + j] = sinf(ang);
        }
    }
    { const int gt = F.bid * 512 + F.tid, NT_ = F.G * 512; const v4u z = {0u, 0u, 0u, 0u};
      for (int i = gt; i < 8 * R / 4; i += NT_) ((v4u*)(ws + WS_STAT))[i] = z;
      for (int i = gt; i < 8 * 3 * CBN / 4; i += NT_) ((v4u*)(ws + WS_CB))[i] = z;
      for (int j = 0; j < 2; ++j) { bf16* w1 = (bf16*)(ws + WS_WMLA + j * SZ_MLA); for (int i = gt; i < 192 * 2048 / 8; i += NT_) *(v4u*)(w1 + (size_t)1088 * 2048 + (size_t)i * 8) = z; } }
}
__device__ __forceinline__ void p0b_prologue(const Frame& F, KargPtr0 ap, bool dummy_cb = false) {
    unsigned char* ws = ap->ws;
    const float* MOD = (const float*)(ws + WS_MOD);
    __syncthreads();
    for (int i = F.bid * 512 + F.tid; i < 8 * 3 * D; i += F.G * 512) { const int sl = i / (3 * D), r = i - sl * 3 * D, v = r / D, k = r - v * D, layer = sl >> 1, sub = sl & 1;
        const float g = (sub ? ap->in[7] : ap->in[6])[layer * D + k], sc = MOD[(size_t)(layer * 3 + v) * NMOD + (sub ? 4 : 1) * D + k];
        ((float*)(ws + WS_AV))[i] = g * (1.f + sc); }
    for (int row = F.gw; row < R; row += F.NGW) {
        const int b = row / SB, t = row - b * SB, v = t >= SEQ ? 2 : b;
        const float* src = t < SEQ ? ap->in[0] + ((size_t)b * SEQ + t) * D : ap->in[2] + ((size_t)b * CTX + (t - SEQ)) * D;
        float* dst = (float*)(ws + WS_X) + (size_t)row * D; bf16* xs = (bf16*)(ws + WS_H) + (size_t)row * D;
        const float* gn = ap->in[6]; const float* sc = MOD + (size_t)v * NMOD + D;
        float ss = 0.f;
#pragma unroll
        for (int j = 0; j < 8; ++j) { const int c = 4 * F.lane + 256 * j; const f32x4 x = *(const f32x4*)(src + c); *(f32x4*)(dst + c) = x;
            ss += (x.x * x.x + x.y * x.y) + (x.z * x.z + x.w * x.w);
            const f32x4 y = x * *(const f32x4*)(gn + c) * (*(const f32x4*)(sc + c) + 1.f);
            v2u o; o.x = pk2(y.x, y.y); o.y = pk2(y.z, y.w); *(v2u*)(xs + c) = o; }
        ss = wave_sum(ss, F.lane);
        if (F.lane == 0) ((float*)(ws + WS_STAT))[row] = ss;
    }
    __syncthreads();
    float* CB = (float*)(ws + (dummy_cb ? WS_ACT : WS_CB));
    int rot = 0;
    for (int j = 0; j < 2; ++j) { const int layer = 2 * j;
        bf16* w1 = (bf16*)(ws + WS_WMLA + j * SZ_MLA); bf16* wuq = (bf16*)((unsigned char*)w1 + SZ_W1); bf16* wukv = (bf16*)((unsigned char*)wuq + SZ_WUQ); bf16* wo = (bf16*)((unsigned char*)wukv + SZ_WUKV);
        const float* shv = MOD + (size_t)layer * 3 * NMOD; float* cacc = CB + (size_t)(2 * layer) * 3 * CBN;
        transpose_matrix(F, ap->in[8] + (size_t)j * 2048 * 512, 2048, 512, w1, 0, 0, rot, shv, cacc); rot = (rot + 512) % F.NGW;
        transpose_matrix(F, ap->in[13] + (size_t)j * 2048 * 576, 2048, 576, w1, 0, 512, rot, shv, cacc); rot = (rot + 576) % F.NGW;
        transpose_matrix(F, ap->in[10] + (size_t)j * 512 * 3072, 512, 3072, wuq, 1, 0, rot, nullptr, nullptr, 1); rot = (rot + 768) % F.NGW;
        transpose_matrix(F, ap->in[16] + (size_t)j * 512 * 4096, 512, 4096, wukv, 2, 0, rot); rot = (rot + 1024) % F.NGW;
        transpose_matrix(F, ap->in[18] + (size_t)j * 2048 * 2048, 2048, 2048, wo, 0, 0, rot);
    }
    for (int j = 0; j < 2; ++j) { const int layer = 2 * j + 1;
        bf16* wqkv = (bf16*)(ws + WS_WGQA + j * SZ_GQA); bf16* wo = (bf16*)((unsigned char*)wqkv + SZ_WQKV);
        const float* shv = MOD + (size_t)layer * 3 * NMOD; float* cacc = CB + (size_t)(2 * layer) * 3 * CBN;
        unsigned char* w8 = ws + WS_W8GQA + j * SZ_W8GQA;
        transpose_matrix(F, ap->in[19] + (size_t)j * 2048 * 2048, 2048, 2048, wqkv, 0, 0, rot, shv, cacc, 2, w8);
        transpose_matrix(F, ap->in[21] + (size_t)j * 2048 * 1024, 2048, 1024, wqkv, 0, 2048, rot, shv, cacc, 2, w8);
        transpose_matrix(F, ap->in[23] + (size_t)j * 2048 * 2048, 2048, 2048, wo, 0, 0, rot);
    }
    for (int l = 0; l < 4; ++l) {
        bf16* wup = (bf16*)(ws + WS_WFFN + l * SZ_FFN); bf16* wdn = (bf16*)((unsigned char*)wup + SZ_WUP);
        transpose_matrix(F, ap->in[24] + (size_t)l * 2048 * 11264, 2048, 11264, wup, 3, 0, rot, MOD + (size_t)l * 3 * NMOD + 3 * D, CB + (size_t)(2 * l + 1) * 3 * CBN);
        transpose_matrix(F, ap->in[27] + (size_t)l * 5632 * 2048, 5632, 2048, wdn, 0, 0, rot);
    }
}

__device__ __forceinline__ void ctx_finalize_phase(const Frame& F, float* X, bf16* XS, float* stat, const float* av, const float* P, int nsplit, unsigned char* XS8) {
    LAS float* red = (LAS float*)(F.lds + RING_OFF);
    for (int pr = F.bid; pr < CTX; pr += F.G) {
        const int q = pr * 2 + (F.wave >> 2), b = q >> 8, row = b * SB + SEQ + (q & 255), c0 = (F.wave & 3) * 512 + 4 * F.lane;
        const float* a = av + 2 * D;
        float* xr = X + (size_t)row * D + c0;
        f32x4 x0 = *(const f32x4*)xr, x1 = *(const f32x4*)(xr + 256);
        for (int s = 0; s < nsplit; ++s) { const float* pp = P + ((size_t)s * 512 + q) * D + c0; x0 += *(const f32x4*)pp; x1 += *(const f32x4*)(pp + 256); }
        *(f32x4*)xr = x0; *(f32x4*)(xr + 256) = x1;
        const float ssw = wave_sum((x0.x * x0.x + x0.y * x0.y) + (x0.z * x0.z + x0.w * x0.w) + (x1.x * x1.x + x1.y * x1.y) + (x1.z * x1.z + x1.w * x1.w), F.lane);
        if (F.lane == 0) red[F.wave] = ssw;
        const f32x4 y0 = x0 * *(const f32x4*)(a + c0), y1 = x1 * *(const f32x4*)(a + c0 + 256);
        bf16* hr = XS + (size_t)row * D + c0;
        v2u o0, o1; o0.x = pk2(y0.x, y0.y); o0.y = pk2(y0.z, y0.w); o1.x = pk2(y1.x, y1.y); o1.y = pk2(y1.z, y1.w);
        *(v2u*)hr = o0; *(v2u*)(hr + 256) = o1;
        if (XS8) { unsigned char* h8 = XS8 + (size_t)row * D + c0; *(unsigned*)h8 = pk4f8(y0.x, y0.y, y0.z, y0.w); *(unsigned*)(h8 + 256) = pk4f8(y1.x, y1.y, y1.z, y1.w); }
        __syncthreads();
        if ((F.wave & 3) == 0 && F.lane == 0) { const int w0 = F.wave; stat[row] = (red[w0] + red[w0 + 1]) + (red[w0 + 2] + red[w0 + 3]); }
        __syncthreads();
    }
}
__device__ __forceinline__ void mla_norm_phase(const Frame& F, const float* RAW, bf16* CQ, bf16* CKV, bf16* KPE, const float* g_dq, const float* g_dkv, const float* g_kpe, const float* ropeM) {
    for (int row = F.gw; row < R; row += F.NGW) {
        const int b = row / SB, t = row - b * SB;
        const float* rr = RAW + (size_t)row * 1280;
#pragma unroll
        for (int part = 0; part < 2; ++part) {
            const float* src = rr + part * 512 + 4 * F.lane; const float* g = (part ? g_dkv : g_dq) + 4 * F.lane; bf16* dst = (part ? CKV : CQ) + (size_t)row * 512 + 4 * F.lane;
            const f32x4 a0 = *(const f32x4*)src, a1 = *(const f32x4*)(src + 256);
            const float ss = wave_sum((a0.x * a0.x + a0.y * a0.y) + (a0.z * a0.z + a0.w * a0.w) + (a1.x * a1.x + a1.y * a1.y) + (a1.z * a1.z + a1.w * a1.w), F.lane);
            const float r = rsqrtf(ss * (1.f / 512.f) + EPS);
            const f32x4 y0 = a0 * r * *(const f32x4*)g, y1 = a1 * r * *(const f32x4*)(g + 256);
            if (part) { v2u o0, o1; o0.x = pk2(y0.x, y0.y); o0.y = pk2(y0.z, y0.w); o1.x = pk2(y1.x, y1.y); o1.y = pk2(y1.z, y1.w); *(v2u*)dst = o0; *(v2u*)(dst + 256) = o1; }
            else { unsigned char* d8 = (unsigned char*)CQ + (size_t)row * 512 + 4 * F.lane;
                *(unsigned*)d8 = pk4f8(y0.x, y0.y, y0.z, y0.w); *(unsigned*)(d8 + 256) = pk4f8(y1.x, y1.y, y1.z, y1.w); }
        }
        const int e = F.lane; const float x = rr[1024 + e];
        const float r = rsqrtf(wave_sum(x * x, F.lane) * (1.f / 64.f) + EPS);
        float y = x * r * g_kpe[e];
        const float yp = shx(y, F.lane, 16);
        if (t < SEQ) { const int j = e & 15, p = e < 32 ? (t >> 6) : (t & 63); const float c = ropeM[p * 16 + j], s = ropeM[128 * 16 + p * 16 + j];
            y = (e & 16) ? (y * c + yp * s) : (y * c - yp * s); }
        KPE[(size_t)row * 64 + e] = (bf16)(pk2(y, y) & 0xffffu);
    }
}
typedef float v16f_t __attribute__((ext_vector_type(16)));
typedef unsigned v6u_t __attribute__((ext_vector_type(6)));
constexpr float K6_SCALE = 2.0f;
__device__ __forceinline__ void st24(unsigned char* dst, const v6u_t& o) { v4u a; a.x = o[0]; a.y = o[1]; a.z = o[2]; a.w = o[3]; v2u b; b.x = o[4]; b.y = o[5]; *(v4u*)dst = a; *(v2u*)(dst + 16) = b; }
__device__ __forceinline__ void unpack16(const bf16* src, v16f_t& f) { const v4u w0 = *(const v4u*)src, w1 = *(const v4u*)(src + 8);
    f[0] = bf_lo(w0.x); f[1] = bf_hi(w0.x); f[2] = bf_lo(w0.y); f[3] = bf_hi(w0.y); f[4] = bf_lo(w0.z); f[5] = bf_hi(w0.z); f[6] = bf_lo(w0.w); f[7] = bf_hi(w0.w);
    f[8] = bf_lo(w1.x); f[9] = bf_hi(w1.x); f[10] = bf_lo(w1.y); f[11] = bf_hi(w1.y); f[12] = bf_lo(w1.z); f[13] = bf_hi(w1.z); f[14] = bf_lo(w1.w); f[15] = bf_hi(w1.w); }
__device__ __forceinline__ void mla_kbuild_phase(const Frame& F, const bf16* KVRAW, const bf16* KPE, unsigned char* K, const float* g_kn) {
    const int h = F.lane >> 2, blk = F.lane & 3;
    v16f_t ga, gb;
#pragma unroll
    for (int i = 0; i < 16; ++i) { ga[i] = g_kn[32 * blk + i]; gb[i] = g_kn[32 * blk + 16 + i]; }
    for (int row = F.gw; row < R; row += F.NGW) {
        v16f_t fa, fb; unpack16(KVRAW + (size_t)row * 4096 + h * 128 + 32 * blk, fa); unpack16(KVRAW + (size_t)row * 4096 + h * 128 + 32 * blk + 16, fb);
        float ss = 0.f;
#pragma unroll
        for (int i = 0; i < 16; ++i) ss += fa[i] * fa[i] + fb[i] * fb[i];
        ss += shx(ss, F.lane, 1); ss += shx(ss, F.lane, 2);
        const float r = rsqrtf(ss * (1.f / 128.f) + EPS) * K6_SCALE;
#pragma unroll
        for (int i = 0; i < 16; ++i) { fa[i] *= r * ga[i]; fb[i] *= r * gb[i]; }
        st24(K + (size_t)row * 3072 + h * 192 + 32 * blk, __builtin_amdgcn_cvt_scalef32_2xpk16_fp6_f32(fa, fb, 1.0f));
        if (F.lane < 32) { const int h2 = F.lane >> 1, b2 = F.lane & 1;
            v16f_t pa, pb; unpack16(KPE + (size_t)row * 64 + 32 * b2, pa); unpack16(KPE + (size_t)row * 64 + 32 * b2 + 16, pb);
#pragma unroll
            for (int i = 0; i < 16; ++i) { pa[i] *= K6_SCALE; pb[i] *= K6_SCALE; }
            st24(K + (size_t)row * 3072 + h2 * 192 + 128 + 32 * b2, __builtin_amdgcn_cvt_scalef32_2xpk16_fp6_f32(pa, pb, 1.0f)); }
    }
}
__device__ __forceinline__ void gqa_knorm_phase(const Frame& F, const bf16* QKV, unsigned char* K, const float* g_k, const float* ropeG) {
    const int blk = F.lane & 3, kh = (F.lane >> 2) & 3, rr = F.lane >> 4, s_ = blk >> 1, hi = blk & 1, da = 64 * s_ + 16 * hi, db = da + 32;
    v16f_t ga, gb;
#pragma unroll
    for (int i = 0; i < 16; ++i) { ga[i] = g_k[da + i]; gb[i] = g_k[db + i]; }
    for (int row0 = F.gw * 4; row0 < R; row0 += F.NGW * 4) {
        const int row = row0 + rr, b = row / SB, t = row - b * SB;
        const bf16* src = QKV + (size_t)row * 3072 + 2048 + kh * 128;
        v16f_t fa, fb; unpack16(src + da, fa); unpack16(src + db, fb);
        float ss = 0.f;
#pragma unroll
        for (int i = 0; i < 16; ++i) ss += fa[i] * fa[i] + fb[i] * fb[i];
        ss += shx(ss, F.lane, 1); ss += shx(ss, F.lane, 2);
        const float r = rsqrtf(ss * (1.f / 128.f) + EPS) * K6_SCALE;
#pragma unroll
        for (int i = 0; i < 16; ++i) { fa[i] *= r * ga[i]; fb[i] *= r * gb[i]; }
        if (t < SEQ) { const int p = s_ == 0 ? (t >> 6) : (t & 63); const float* cs = ropeG + p * 32 + 16 * hi; const float* sn = ropeG + 128 * 32 + p * 32 + 16 * hi;
#pragma unroll
            for (int i = 0; i < 16; ++i) { const float c = cs[i], sv = sn[i], x = fa[i], y = fb[i]; fa[i] = x * c - y * sv; fb[i] = y * c + x * sv; } }
        st24(K + (size_t)row * 512 + kh * 128 + 64 * s_ + 32 * hi, __builtin_amdgcn_cvt_scalef32_2xpk16_fp6_f32(fa, fb, 1.0f));
    }
}
__device__ __forceinline__ void tr4x4(unsigned a0, unsigned a1, unsigned a2, unsigned a3, unsigned* t) {
    const unsigned x0 = __builtin_amdgcn_perm(a1, a0, 0x05010400u), x1 = __builtin_amdgcn_perm(a1, a0, 0x07030602u), y0 = __builtin_amdgcn_perm(a3, a2, 0x05010400u), y1 = __builtin_amdgcn_perm(a3, a2, 0x07030602u);
    t[0] = __builtin_amdgcn_perm(y0, x0, 0x05040100u); t[1] = __builtin_amdgcn_perm(y0, x0, 0x07060302u); t[2] = __builtin_amdgcn_perm(y1, x1, 0x05040100u); t[3] = __builtin_amdgcn_perm(y1, x1, 0x07060302u);
}
__device__ __forceinline__ void v8t_items(const Frame& F, const bf16* Vsrc, int ldv, int vcol0, int nkv, unsigned char* V8T) {
    LAS unsigned char* scr = F.lds + RING_OFF + F.wave * 16384;
    const int l16 = F.lane & 15, kq = F.lane >> 4;
    for (int it = F.gw; it < BATCH * nkv * (SB / 64); it += F.NGW) {
        const int tile = it % (SB / 64), bh = it / (SB / 64), kvh = bh % nkv, b = bh / nkv;
        const bf16* src = Vsrc + (size_t)(b * SB + tile * 64 + 4 * kq) * ldv + vcol0 + kvh * 128 + l16 * 8;
        v4u wl[16];
#pragma unroll
        for (int i = 0; i < 16; ++i) wl[i] = *(const v4u*)(src + (size_t)(16 * (i >> 2) + (i & 3)) * ldv);
        asm volatile("" ::: "memory");
#pragma unroll
        for (int g = 0; g < 4; ++g) { unsigned lo[4], hi[4], t[8];
#pragma unroll
            for (int j = 0; j < 4; ++j) { const v4u w = wl[4 * g + j]; lo[j] = pk4f8(bf_lo(w.x), bf_hi(w.x), bf_lo(w.y), bf_hi(w.y)); hi[j] = pk4f8(bf_lo(w.z), bf_hi(w.z), bf_lo(w.w), bf_hi(w.w)); }
            tr4x4(lo[0], lo[1], lo[2], lo[3], t); tr4x4(hi[0], hi[1], hi[2], hi[3], t + 4);
            const int q = 4 * g + kq, sdw = 8 * (q & 1) + 4 * (q >> 3) + ((q & 7) >> 1);
            LAS unsigned* p = (LAS unsigned*)(scr + (l16 * 8) * 64 + 4 * sdw);
#pragma unroll
            for (int e = 0; e < 8; ++e) p[16 * e] = t[e]; }
        LDS_WAIT(); asm volatile("" ::: "memory");
#pragma unroll
        for (int k = 0; k < 8; ++k) { const int d = 16 * k + (F.lane >> 2), c = F.lane & 3;
            *(v4u*)(V8T + ((size_t)bh * 128 + d) * 8448 + tile * 64 + c * 16) = *(const LAS v4u*)(scr + d * 64 + c * 16); }
        LDS_WAIT(); asm volatile("" ::: "memory");
    }
}
__device__ __forceinline__ void conv_fix_phase(const Frame& F, const float* GH, const float* VH, bf16* ACT, const float* cw, const float* cb, bool skip_ctx) {
    constexpr int NCG = DFF / 512, NST = R / 64;
    for (int it = F.gw; it < NST * 2 * NCG; it += F.NGW) {
        const int cg = it % NCG, se = it / NCG, sid = se >> 1, lastedge = se & 1, f0 = cg * 512 + F.lane * 8;
        const int row = sid * 64 + (lastedge ? 63 : 0), t = row % SB;
        if (skip_ctx && t >= SEQ) continue;
        const bool zp = !lastedge && (t == 0 || t == SEQ), zn = lastedge && (t == SEQ - 1 || t == SB - 1);
        const float* gp = lastedge ? GH + ((size_t)sid * 4 + 2) * DFF : GH + ((size_t)sid * 4 - 1) * DFF;
        const float* gc = GH + ((size_t)sid * 4 + (lastedge ? 3 : 0)) * DFF;
        const float* gn = lastedge ? GH + ((size_t)sid * 4 + 4) * DFF : GH + ((size_t)sid * 4 + 1) * DFF;
        const float* vp = VH + ((size_t)sid * 2 + lastedge) * DFF;
        float o[8];
#pragma unroll
        for (int h = 0; h < 2; ++h) {
            const int f = f0 + 4 * h;
            const f32x4 z = {0.f, 0.f, 0.f, 0.f};
            const f32x4 p = zp ? z : *(const f32x4*)(gp + f), c = *(const f32x4*)(gc + f), n = zn ? z : *(const f32x4*)(gn + f), v = *(const f32x4*)(vp + f);
            const f32x4 w0 = *(const f32x4*)(cw + f), w1 = *(const f32x4*)(cw + DFF + f), w2 = *(const f32x4*)(cw + 2 * DFF + f), b = *(const f32x4*)(cb + f);
#pragma unroll
            for (int i = 0; i < 4; ++i) { const float a = fmaf(w0[i], p[i], fmaf(w1[i], c[i], fmaf(w2[i], n[i], b[i]))); o[4 * h + i] = a * __builtin_amdgcn_rcpf(1.f + __builtin_amdgcn_exp2f(a * -1.4426950408889634f)) * v[i]; }
        }
        v4u ow; ow.x = pk2(o[0], o[1]); ow.y = pk2(o[2], o[3]); ow.z = pk2(o[4], o[5]); ow.w = pk2(o[6], o[7]);
        *(v4u*)(ACT + (size_t)row * DFF + f0) = ow;
    }
}

#ifndef UP_PROBE
#define UP_PROBE 0
#endif
#ifndef PROBE_EXTRA
#define PROBE_EXTRA 0
#endif
#ifndef ATT_STATIC_MAX
#define ATT_STATIC_MAX 29
#endif
#ifndef ATT_FALLBACK
#define ATT_FALLBACK 1
#endif
template <class Cfg>
__device__ __forceinline__ void attention_phase(const Frame& F, const bf16* Q, const unsigned char* K, const unsigned char* V8T, bf16* O, const float* gq_n, const float* gq_p, const float* gk_n, const float* gk_p, const float* rope_tab, bool with_ctx, int var_in) {
    constexpr int QPE = Cfg::MLA ? 2048 : 0, KHD = Cfg::KROWB;
    float mbound;
    { float a = fmaxf(fabsf(gq_n[F.lane]), fabsf(gq_n[64 + F.lane])), b = fmaxf(fabsf(gk_n[F.lane]), fabsf(gk_n[64 + F.lane])), c = 0.f, d = 0.f;
      if constexpr (Cfg::MLA) { c = fabsf(gq_p[F.lane]); d = fabsf(gk_p[F.lane]); }
#pragma unroll
      for (int o = 1; o < 64; o <<= 1) { a = fmaxf(a, shx(a, F.lane, o)); b = fmaxf(b, shx(b, F.lane, o)); if constexpr (Cfg::MLA) { c = fmaxf(c, shx(c, F.lane, o)); d = fmaxf(d, shx(d, F.lane, o)); } }
      const float qn2 = 128.f * a * a + (Cfg::MLA ? 64.f * c * c : 0.f), kn2 = 128.f * b * b + (Cfg::MLA ? 64.f * d * d : 0.f);
      mbound = 1.20f * Cfg::SCALE * 1.4426950408889634f * sqrtf(qn2 * kn2) + 0.5f; }
    const bool use_static = __builtin_amdgcn_readfirstlane((mbound <= ATT_STATIC_MAX) ? 1 : 0) != 0;
    const int var = PROBE_EXTRA ? __builtin_amdgcn_readfirstlane(var_in) : 0;
    const int c = F.bid;
    const int nlat = (F.G == 256) ? 4 : (1024 - c + F.G - 1) / F.G;
    const int ntot = nlat + ((with_ctx && c < 32) ? 1 : 0);
    for (int i = 0; i < ntot; ++i) {
        int bh, qb, seq, t0; size_t row0, krow0;
        if (i < nlat) {
            if (F.G == 256) { bh = i * 8 + (c & 7); qb = c >> 3; }
            else { const int L = i * F.G + c; bh = L >> 5; qb = L & 31; }
            const int b = bh >> 4; row0 = (size_t)b * SB + qb * 256; krow0 = (size_t)b * SB; seq = SB; t0 = qb * 256;
        } else { bh = c; const int b = bh >> 4; row0 = (size_t)b * SB + SEQ; krow0 = row0; seq = CTX; t0 = -1; }
        const int h = bh & 15, kvh = Cfg::MLA ? h : (h >> 2), b_ = bh >> 4;
        if (use_static || !ATT_FALLBACK)
            att::attn_unit<Cfg, true>(Q + row0 * Cfg::LDQ + h * 128, Q + row0 * Cfg::LDQ + QPE + h * 64, K + krow0 * Cfg::LDK + kvh * KHD, V8T + (size_t)((b_ * (Cfg::MLA ? 16 : 4) + kvh) * 128) * Cfg::LDVT + (i < nlat ? 0 : SEQ),
                            O + row0 * Cfg::LDO + h * 128, seq, F.lds + RING_OFF, F.ldsg + RING_OFF, t0, gq_n, gq_p, rope_tab, mbound, F.wave, var);
        else
            att::attn_unit<Cfg, false>(Q + row0 * Cfg::LDQ + h * 128, Q + row0 * Cfg::LDQ + QPE + h * 64, K + krow0 * Cfg::LDK + kvh * KHD, V8T + (size_t)((b_ * (Cfg::MLA ? 16 : 4) + kvh) * 128) * Cfg::LDVT + (i < nlat ? 0 : SEQ),
                            O + row0 * Cfg::LDO + h * 128, seq, F.lds + RING_OFF, F.ldsg + RING_OFF, t0, gq_n, gq_p, rope_tab, mbound, F.wave, var);
    }
}

#ifndef REP_ATT
#define REP_ATT 1
#endif
#ifndef REP_GBF
#define REP_GBF 1
#endif
#ifndef REP_GRES
#define REP_GRES 1
#endif
#ifndef REP_THIN
#define REP_THIN 1
#endif
#ifndef REP_PRO
#define REP_PRO 1
#endif
#ifndef REP_CONV
#define REP_CONV 1
#endif
#ifndef REP_MOD
#define REP_MOD 1
#endif
#ifndef REP_BAR
#define REP_BAR 1
#endif
#ifndef EN_ATT_MLA
#define EN_ATT_MLA 1
#endif
#ifndef EN_ATT_GQA
#define EN_ATT_GQA 1
#endif
#ifndef EN_GEMM
#define EN_GEMM 63
#endif
#ifndef EN_THIN
#define EN_THIN 1
#endif
typedef const __attribute__((address_space(4))) Args* KargPtr;
__device__ __forceinline__ KargPtr kargs() { KargPtr p = (KargPtr)__builtin_amdgcn_kernarg_segment_ptr(); asm volatile("" : "+s"(p)); return p; }

__global__ void __launch_bounds__(NWAVES * 64, 2) fwd_kernel(Args args_unused) {
    extern __shared__ __attribute__((aligned(16))) unsigned char lds[];
#define MKFRAME() Frame F; { int t_; asm volatile("v_mbcnt_lo_u32_b32 %0, -1, 0\n\tv_mbcnt_hi_u32_b32 %0, -1, %0" : "=&v"(t_)); t_ |= wave_s << 6;     F.lds = (LAS unsigned char*)lds; F.ldsg = (char*)lds; F.tid = t_; F.lane = t_ & 63; F.wave = wave_s; \
    F.bid = blockIdx.x; asm volatile("" : "+s"(F.bid)); F.G = gridDim.x; F.gw = F.bid * NWAVES + F.wave; F.NGW = F.G * NWAVES; }
    LAS unsigned char* const ldsl = (LAS unsigned char*)lds;
    const int wave_s = __builtin_amdgcn_readfirstlane(threadIdx.x >> 6);
    for (int u = threadIdx.x; u < (LDS_BYTES - LDSCTL_OFF) / 4; u += NWAVES * 64) ((LAS unsigned*)(ldsl + LDSCTL_OFF))[u] = 0u;
    __syncthreads();
    const int lo = kargs()->ph_lo, hi = kargs()->ph_hi;
    if (hi - lo > 1) { MKFRAME(); (void)xcd_barrier_post((unsigned*)(kargs()->ws + WS_CTL) + CW_BAR, (volatile LAS unsigned*)(ldsl + MISC_OFF) + 8, F.tid); }
#define IN(k) (lo <= (k) && (k) < hi)
#define SEAM(k) do { if (IN(k) && IN((k) + 1)) { MKFRAME(); XcdBarrier bar_; bar_.tid = F.tid; bar_.bar = (unsigned*)(kargs()->ws + WS_CTL) + CW_BAR; bar_.x = xb_xcc_id(); bar_.st = (volatile LAS unsigned*)(ldsl + MISC_OFF) + 8; _Pragma("unroll 1") for (int rb_ = 0; rb_ < REP_BAR; ++rb_) xcd_barrier(bar_); } } while (0)
#define WSP(off) (kargs()->ws + (off))

    if (EN_THIN && IN(0)) { MKFRAME(); p0a_prologue(F, kargs()); } SEAM(0);

    for (int layer = 0; layer < DEPTH; ++layer) {
        const int pb = 1 + layer * PH_PER_LAYER, j = layer >> 1; const bool mla = (layer & 1) == 0, last = layer == DEPTH - 1;
        if (EN_THIN && IN(pb + 0)) { MKFRAME(); KargPtr a = kargs(); unsigned char* ws = a->ws;
            if (layer == 0) { if (REP_PRO > 1) p0b_prologue(F, a, true); p0b_prologue(F, a); }
            else ctx_finalize_phase(F, (float*)(ws + WS_X), (bf16*)(ws + WS_H), (float*)(ws + WS_STAT) + (size_t)(2 * layer) * R, (const float*)(ws + WS_AV) + (size_t)(2 * layer) * 3 * D, (const float*)(ws + WS_PART), NSPLIT_DN, mla ? nullptr : ws + WS_XS8); }
        SEAM(pb + 0);
        if (mla) {
            if ((EN_GEMM & 1) && IN(pb + 1)) {
                MKFRAME(); unsigned char* ws = WSP(0);
                pg8::Gemm g{(const bf16*)(ws + WS_H), (const bf16*)(ws + WS_WMLA + j * SZ_MLA), R, 1280, 2048}; pg8::PanelOrder S; S.init2(1280, 2048, F.G, F.bid, 0);
                pg8::EpiF32 E{(float*)(ws + WS_RAW1), 1280, (const float*)(ws + WS_STAT) + (size_t)(2 * layer) * R, (const float*)(ws + WS_CB) + (size_t)(2 * layer) * 3 * CBN};
                _Pragma("unroll 1") for (int rp_ = 0; rp_ < REP_GBF; ++rp_) pg8::gemm_phase<pg8::EpiF32, pg8::PanelOrder, true, true>(F.lds + RING_OFF, g, S, E, F.wave);
            }
            SEAM(pb + 1);
            if (EN_THIN && IN(pb + 2)) { MKFRAME(); KargPtr a = kargs(); unsigned char* ws = a->ws;
                _Pragma("unroll 1") for (int rp_ = 0; rp_ < REP_THIN; ++rp_) mla_norm_phase(F, (const float*)(ws + WS_RAW1), (bf16*)(ws + WS_CQ), (bf16*)(ws + WS_CKV), (bf16*)(ws + WS_KPE), a->in[9] + j * 512, a->in[14] + j * 512, a->in[15] + j * 64, (const float*)(ws + WS_ROPE)); }
            SEAM(pb + 2);
            if ((EN_GEMM & 2) && IN(pb + 3)) {
                { MKFRAME(); unsigned char* ws = WSP(0);
                  pg8::Gemm g{(const bf16*)(ws + WS_CQ), (const bf16*)(ws + WS_WMLA + j * SZ_MLA + SZ_W1), R, 3072, 256, W8_E8M0, 0x7f7f7f7f}; pg8::PanelOrder S; S.init2(3072, 256, F.G, F.bid, 0);
                  pg8::EpiBf16 E{(bf16*)(ws + WS_QRAW), 3072, nullptr, nullptr};
                  _Pragma("unroll 1") for (int rp_ = 0; rp_ < REP_GBF; ++rp_) pg8::gemm_phase<pg8::EpiBf16, pg8::PanelOrder, true, true, true>(F.lds + RING_OFF, g, S, E, F.wave); }
                { MKFRAME(); unsigned char* ws = WSP(0);
                  pg8::Gemm g{(const bf16*)(ws + WS_CKV), (const bf16*)(ws + WS_WMLA + j * SZ_MLA + SZ_W1 + SZ_WUQ), R, 4096, 512}; pg8::PanelOrder S; S.init2(4096, 512, F.G, F.bid, 0);
                  pg8::EpiBf16 E{(bf16*)(ws + WS_KVRAW), 4096, nullptr, nullptr};
                  _Pragma("unroll 1") for (int rp_ = 0; rp_ < REP_GBF; ++rp_) pg8::gemm_phase<pg8::EpiBf16, pg8::PanelOrder, true, true>(F.lds + RING_OFF, g, S, E, F.wave); }
            }
            SEAM(pb + 3);
            if (EN_THIN && IN(pb + 4)) { MKFRAME(); KargPtr a = kargs(); unsigned char* ws = a->ws; _Pragma("unroll 1") for (int rp_ = 0; rp_ < REP_THIN; ++rp_) { mla_kbuild_phase(F, (const bf16*)(ws + WS_KVRAW), (const bf16*)(ws + WS_KPE), (unsigned char*)(ws + WS_KMLA), a->in[17] + j * 128); v8t_items(F, (const bf16*)(ws + WS_KVRAW), 4096, 2048, 16, ws + WS_V8T_MLA); } }
            SEAM(pb + 4);
            if (EN_ATT_MLA && IN(pb + 5)) { MKFRAME(); KargPtr a = kargs(); unsigned char* ws = a->ws; __syncthreads();
                _Pragma("unroll 1") for (int rp_ = 0; rp_ < REP_ATT; ++rp_)
                attention_phase<att::CfgMLA>(F, (const bf16*)(ws + WS_QRAW), (const unsigned char*)(ws + WS_KMLA), (const unsigned char*)(ws + WS_V8T_MLA), (bf16*)(ws + WS_RAW1), a->in[11] + j * 128, a->in[12] + j * 64, a->in[17] + j * 128, a->in[15] + j * 64, (const float*)(ws + WS_ROPE), !last, PROBE_EXTRA ? a->var : 0); }
            SEAM(pb + 5);
        } else {
            if ((EN_GEMM & 4) && IN(pb + 1)) {
                { MKFRAME(); unsigned char* ws = WSP(0);
                  pg8::Gemm g{(const bf16*)(ws + WS_XS8), (const bf16*)(ws + WS_W8GQA + j * SZ_W8GQA), R, 2560, 1024, W8_E8M0, 0x7f7f7f7f}; pg8::PanelOrder S; S.init2(2560, 1024, F.G, F.bid, 0);
                  pg8::EpiBf16 E{(bf16*)(ws + WS_QKV), 3072, (const float*)(ws + WS_STAT) + (size_t)(2 * layer) * R, (const float*)(ws + WS_CB) + (size_t)(2 * layer) * 3 * CBN};
                  pg8::gemm_phase<pg8::EpiBf16, pg8::PanelOrder, true, true, true>(F.lds + RING_OFF, g, S, E, F.wave); }
                { MKFRAME(); unsigned char* ws = WSP(0);
                  pg8::Gemm g{(const bf16*)(ws + WS_H), (const bf16*)(ws + WS_WGQA + j * SZ_GQA) + (size_t)2560 * 2048, R, 512, 2048}; pg8::PanelOrder S; S.init2(512, 2048, F.G, F.bid, 0);
                  pg8::EpiBf16 E{(bf16*)(ws + WS_QKV) + 2560, 3072, (const float*)(ws + WS_STAT) + (size_t)(2 * layer) * R, (const float*)(ws + WS_CB) + (size_t)(2 * layer) * 3 * CBN + 2560};
                  pg8::gemm_phase<pg8::EpiBf16, pg8::PanelOrder, true, true>(F.lds + RING_OFF, g, S, E, F.wave); }
            }
            SEAM(pb + 1);
            if (EN_THIN && IN(pb + 2)) { MKFRAME(); KargPtr a = kargs(); unsigned char* ws = a->ws; _Pragma("unroll 1") for (int rp_ = 0; rp_ < REP_THIN; ++rp_) { gqa_knorm_phase(F, (const bf16*)(ws + WS_QKV), (unsigned char*)(ws + WS_KGQA), a->in[22] + j * 128, (const float*)(ws + WS_ROPE) + 2 * 128 * 16); v8t_items(F, (const bf16*)(ws + WS_QKV), 3072, 2560, 4, ws + WS_V8T_GQA); } }
            SEAM(pb + 2);
            if (EN_ATT_GQA && IN(pb + 5)) { MKFRAME(); KargPtr a = kargs(); unsigned char* ws = a->ws; __syncthreads();
                _Pragma("unroll 1") for (int rp_ = 0; rp_ < REP_ATT; ++rp_)
                attention_phase<att::CfgGQA>(F, (const bf16*)(ws + WS_QKV), (const unsigned char*)(ws + WS_KGQA), (const unsigned char*)(ws + WS_V8T_GQA), (bf16*)(ws + WS_OGQA), a->in[20] + j * 128, nullptr, a->in[22] + j * 128, nullptr, (const float*)(ws + WS_ROPE) + 2 * 128 * 16, !last, PROBE_EXTRA ? a->var : 0); }
            SEAM(pb + 5);
        }
        if ((EN_GEMM & 8) && IN(pb + 6)) {
            MKFRAME(); unsigned char* ws = WSP(0);
            const bf16* wo = mla ? (const bf16*)(ws + WS_WMLA + j * SZ_MLA + SZ_W1 + SZ_WUQ + SZ_WUKV) : (const bf16*)(ws + WS_WGQA + j * SZ_GQA + SZ_WQKV);
            const bf16* O = mla ? (const bf16*)(ws + WS_RAW1) : (const bf16*)(ws + WS_OGQA);
            pg8::Gemm g{O, wo, R, 2048, 2048}; pg8::ResOrder S; S.init2(2048, F.G, F.bid, last ? 0 : NSPLIT_WO);
            pg8::EpiRes E{(const float*)(ws + WS_X), (float*)(ws + WS_X), (const float*)(ws + WS_MOD) + (size_t)layer * 3 * NMOD + 2 * D, 0, (float*)(ws + WS_PART), 2048 / 64,
                          (bf16*)(ws + WS_H), (const float*)(ws + WS_AV) + (size_t)(2 * layer + 1) * 3 * D, (float*)(ws + WS_STAT) + (size_t)(2 * layer + 1) * R, nullptr};
            pg8::gemm_phase<pg8::EpiRes, pg8::ResOrder, true, true>(F.lds + RING_OFF, g, S, E, F.wave);
        }
        SEAM(pb + 6);
        if (EN_THIN && IN(pb + 7) && !last) { MKFRAME(); KargPtr a = kargs(); unsigned char* ws = a->ws;
            ctx_finalize_phase(F, (float*)(ws + WS_X), (bf16*)(ws + WS_H), (float*)(ws + WS_STAT) + (size_t)(2 * layer + 1) * R, (const float*)(ws + WS_AV) + (size_t)(2 * layer + 1) * 3 * D, (const float*)(ws + WS_PART), NSPLIT_WO, nullptr); }
        if (!last) SEAM(pb + 7);
        if ((EN_GEMM & 16) && IN(pb + 8)) {
            MKFRAME(); KargPtr ka_ = kargs(); unsigned char* ws = ka_->ws;
            pg8::Gemm g{(const bf16*)(ws + WS_H), (const bf16*)(ws + WS_WFFN + layer * SZ_FFN), R, 11264, 2048}; pg8::PanelOrder S; S.init2(11264, 2048, F.G, F.bid, last ? 1 : 0);
            pg8::EpiConv E{(bf16*)(ws + WS_ACT), (float*)(ws + WS_GH), (float*)(ws + WS_VH), ka_->in[25] + (size_t)layer * 3 * DFF, ka_->in[26] + (size_t)layer * DFF,
                           (const float*)(ws + WS_STAT) + (size_t)(2 * layer + 1) * R, (const float*)(ws + WS_CB) + (size_t)(2 * layer + 1) * 3 * CBN};
            if (UP_PROBE == 1) { pg8::EpiConv E2 = E; pg8::gemm_phase<pg8::EpiConv, pg8::PanelOrder, true, true>(F.lds + RING_OFF, g, S, E2, F.wave); }
            if (UP_PROBE == 2) { pg8::EpiBf16 E3{(bf16*)(ws + WS_PART), 11264, nullptr, nullptr}; pg8::gemm_phase<pg8::EpiBf16, pg8::PanelOrder, true, true>(F.lds + RING_OFF, g, S, E3, F.wave); }
            _Pragma("unroll 1") for (int rp_ = 0; rp_ < REP_GBF; ++rp_) pg8::gemm_phase<pg8::EpiConv, pg8::PanelOrder, true, true>(F.lds + RING_OFF, g, S, E, F.wave);
        }
        SEAM(pb + 8);
        if (EN_THIN && IN(pb + 9)) { MKFRAME(); KargPtr a = kargs(); _Pragma("unroll 1") for (int rp_ = 0; rp_ < REP_CONV; ++rp_) conv_fix_phase(F, (const float*)(a->ws + WS_GH), (const float*)(a->ws + WS_VH), (bf16*)(a->ws + WS_ACT), a->in[25] + (size_t)layer * 3 * DFF, a->in[26] + (size_t)layer * DFF, last); }
        SEAM(pb + 9);
        if ((EN_GEMM & 32) && IN(pb + 10)) {
            MKFRAME(); KargPtr a = kargs(); unsigned char* ws = a->ws;
            pg8::Gemm g{(const bf16*)(ws + WS_ACT), (const bf16*)(ws + WS_WFFN + layer * SZ_FFN + SZ_WUP), R, 2048, 5632}; pg8::ResOrder S; S.init2(5632, F.G, F.bid, last ? 0 : NSPLIT_DN);
            pg8::EpiRes E{(const float*)(ws + WS_X), last ? a->out : (float*)(ws + WS_X), (const float*)(ws + WS_MOD) + (size_t)layer * 3 * NMOD + 5 * D, last ? 1 : 0, (float*)(ws + WS_PART), 5632 / 64,
                          (bf16*)(ws + WS_H), (const float*)(ws + WS_AV) + (size_t)(last ? 0 : 2 * layer + 2) * 3 * D, last ? nullptr : (float*)(ws + WS_STAT) + (size_t)(2 * layer + 2) * R, (!last && mla) ? ws + WS_XS8 : nullptr};
            pg8::gemm_phase<pg8::EpiRes, pg8::ResOrder, true, true>(F.lds + RING_OFF, g, S, E, F.wave);
        }
        SEAM(pb + 10);
    }
#undef IN
#undef SEAM
#undef WSP
}

#ifndef PROBE_EXTRA
#define PROBE_EXTRA 0
#endif
#ifndef PROBE_VAR
#define PROBE_VAR 0
#endif
#ifndef MK_PER_PHASE
#define MK_PER_PHASE 0
#endif
extern "C" void kernel_launch(void* const* d_in, const int* in_sizes, int n_in, void* d_out, int out_size, void* d_ws, size_t ws_size, hipStream_t stream) {
    static int grid = 0;
    if (grid == 0) {
        if (n_in != 28 || out_size != BATCH * SEQ * D || ws_size < WS_END) { fprintf(stderr, "kernel_launch: unexpected shapes: n_in %d out %d ws %zu (need %zu)\n", n_in, out_size, ws_size, (size_t)WS_END); grid = -1; return; }
        int dev = 0, cus = 0;
        if (hipGetDevice(&dev) != hipSuccess || hipDeviceGetAttribute(&cus, hipDeviceAttributeMultiprocessorCount, dev) != hipSuccess) { grid = -1; return; }
        if (hipFuncSetAttribute((const void*)fwd_kernel, hipFuncAttributeMaxDynamicSharedMemorySize, LDS_BYTES) != hipSuccess) { fprintf(stderr, "kernel_launch: hipFuncSetAttribute failed\n"); grid = -1; return; }
        int per_cu = 0;
        if (hipOccupancyMaxActiveBlocksPerMultiprocessor(&per_cu, (const void*)fwd_kernel, NWAVES * 64, LDS_BYTES) != hipSuccess || per_cu < 1) { fprintf(stderr, "kernel_launch: occupancy query says %d\n", per_cu); }
        (void)hipGetLastError();
        grid = cus;
    }
    if (grid < 0) return;
    (void)hipMemsetAsync((char*)d_ws + WS_CTL, 0, CTL_ZERO_BYTES, stream);
    Args a{};
    for (int i = 0; i < 28; ++i) a.in[i] = (const float*)d_in[i];
    a.out = (float*)d_out; a.ws = (unsigned char*)d_ws;
#if MK_PER_PHASE
    for (int ph = 0; ph < N_PHASES; ++ph) {
        if (ph >= 1) { const int l = (ph - 1) / PH_PER_LAYER, s = (ph - 1) % PH_PER_LAYER; if ((l & 1) && (s == 3 || s == 4)) continue; }
        a.ph_lo = ph; a.ph_hi = ph + 1;
        hipLaunchKernelGGL(fwd_kernel, dim3(grid), dim3(NWAVES * 64), LDS_BYTES, stream, a);
    }
#else
    a.ph_lo = 0; a.ph_hi = N_PHASES; a.var = 0;
    hipLaunchKernelGGL(fwd_kernel, dim3(grid), dim3(NWAVES * 64), LDS_BYTES, stream, a);
#if PROBE_EXTRA
    for (int l = 0; l < 4; ++l) for (int sl = 0; sl < PH_PER_LAYER; ++sl) if ((PROBE_EXTRA >> sl) & 1) { if ((l & 1) && (sl == 3 || sl == 4)) continue; a.ph_lo = 1 + l * PH_PER_LAYER + sl; a.ph_hi = a.ph_lo + 1; a.var = PROBE_VAR;
        hipLaunchKernelGGL(fwd_kernel, dim3(grid), dim3(NWAVES * 64), LDS_BYTES, stream, a); }
#endif
#endif
    const hipError_t le = hipPeekAtLastError();
    if (le != hipSuccess) fprintf(stderr, "kernel_launch: launch failed: %s\n", hipGetErrorName(le));
}
```

```cpp
#include <hip/hip_runtime.h>
#include <cstdio>
#include <cstdint>
namespace pg8 {
#define PG8_LAS __attribute__((address_space(3)))
typedef unsigned short bf16_t;
typedef short bf16x8 __attribute__((ext_vector_type(8)));
typedef float f32x4 __attribute__((ext_vector_type(4)));
typedef unsigned u32x4 __attribute__((ext_vector_type(4)));
typedef unsigned u32x2 __attribute__((ext_vector_type(2)));
typedef int v8i_t __attribute__((ext_vector_type(8)));
struct Frag2 { v8i_t w;
    __device__ __forceinline__ void ld(PG8_LAS unsigned char* p) { typedef int v4i_t __attribute__((ext_vector_type(4))); const v4i_t a = *(const PG8_LAS v4i_t*)p, b = *(const PG8_LAS v4i_t*)(p + 1024); w = (v8i_t){a[0], a[1], a[2], a[3], b[0], b[1], b[2], b[3]}; }
    __device__ __forceinline__ bf16x8 k0() const { typedef int v4i_t __attribute__((ext_vector_type(4))); const v4i_t a = {w[0], w[1], w[2], w[3]}; return __builtin_bit_cast(bf16x8, a); }
    __device__ __forceinline__ bf16x8 k1() const { typedef int v4i_t __attribute__((ext_vector_type(4))); const v4i_t a = {w[4], w[5], w[6], w[7]}; return __builtin_bit_cast(bf16x8, a); } };
__device__ __forceinline__ v8i_t pg8_cat(bf16x8 lo, bf16x8 hi) { typedef int v4i_t __attribute__((ext_vector_type(4))); const v4i_t a = __builtin_bit_cast(v4i_t, lo), b = __builtin_bit_cast(v4i_t, hi); return (v8i_t){a[0], a[1], a[2], a[3], b[0], b[1], b[2], b[3]}; }
constexpr int BM = 256, BK = 64, HALF = 128, HTB = HALF * BK * 2  , STAGE_BYTES = 8 * HTB, NXCD = 8, WGM = 8;

__host__ __device__ __forceinline__ int lds_byte(int r, int c) { const int st = (r >> 4) * 2 + (c >> 5), rr = r & 15, cc = c & 31, ob = rr * 64 + cc * 2; return st * 1024 + (ob ^ (((ob >> 9) & 1) << 5)); }
__host__ __device__ __forceinline__ void stage_rc(int b, int& R, int& C) { const int st = b / 1024, sb = b % 1024, swz = sb ^ (((sb >> 9) & 1) << 5); R = (st >> 1) * 16 + swz / 64; C = (st & 1) * 32 + (swz % 64) / 2; }
__host__ __device__ __forceinline__ int perm32(int rho) { const int n = rho >> 4, i = rho & 15; return 8 * (i >> 2) + 4 * n + (i & 3); }

struct Unit { int pm, pn, kt0, nkt; };
struct Gemm { const bf16_t* A; const bf16_t* Bt; int M, N, K; int sa, sb; };

struct StaticOrder {
    int nM, nN, nwg, G, c;
    __host__ __device__ void init(int M, int N, int G_, int c_) { nM = M / BM; nN = N / BM; nwg = nM * nN; G = G_; c = c_; }
    __host__ __device__ bool next(int i, Unit& u) const {
        const int L = i * G + c; if (L >= nwg) return false;
        int wgid = L; { const int q = nwg / NXCD, r = nwg % NXCD, xcd = wgid % NXCD, off = wgid / NXCD; wgid = (xcd < r ? xcd * (q + 1) : r * (q + 1) + (xcd - r) * q) + off; }
        const int nig = WGM * nN, gid = wgid / nig, fm = gid * WGM, gsz = (nM - fm) < WGM ? (nM - fm) : WGM;
        u.pm = fm + ((wgid % nig) % gsz); u.pn = (wgid % nig) / gsz; return true;
    }
    __device__ __forceinline__ void a_ready(const Unit&) const {}
    __device__ __forceinline__ void done(const Unit&) const {}
};
__device__ __forceinline__ unsigned cvt_pk_bf16(float lo, float hi) { unsigned r; asm volatile("v_cvt_pk_bf16_f32 %0, %1, %2" : "=v"(r) : "v"(lo), "v"(hi)); return r; }
__device__ __forceinline__ void row_scales(const float* stat, const Unit& u, int wr, int fr, float (&r)[2][4]) {
#pragma unroll
    for (int ai = 0; ai < 2; ++ai)
#pragma unroll
        for (int m = 0; m < 4; ++m) r[ai][m] = stat ? __builtin_amdgcn_rsqf(stat[u.pm * BM + ai * HALF + wr * 64 + m * 16 + fr] * (1.0f / 2048.0f) + 1e-6f) : 1.0f;
}
__device__ __forceinline__ int panel_variant(const Unit& u) { const int b = u.pm / 33; return (u.pm - b * 33) == 32 ? 2 : b; }
constexpr int CBN_ = 11264;
struct EpiF32 {
    static constexpr bool PERM = false, AFTER_DRAIN = false;
    float* C; int ldc; const float* stat; const float* cb;
    __device__ __forceinline__ void operator()(const f32x4 (&acc)[2][2][4][2], const Unit& u, int wr, int wc, int fr, int fq) const {
        const int row0 = u.pm * BM + wr * 64 + fr, col0 = u.pn * BM + wc * 32 + 4 * fq;
        float r[2][4]; row_scales(stat, u, wr, fr, r);
        f32x4 cv[2][2];
#pragma unroll
        for (int bj = 0; bj < 2; ++bj)
#pragma unroll
            for (int n = 0; n < 2; ++n) cv[bj][n] = stat ? *(const f32x4*)(cb + (size_t)panel_variant(u) * CBN_ + col0 + bj * HALF + n * 16) : (f32x4){0.f, 0.f, 0.f, 0.f};
#pragma unroll
        for (int ai = 0; ai < 2; ++ai)
#pragma unroll
            for (int m = 0; m < 4; ++m) { float* rowp = C + (size_t)(row0 + ai * HALF + m * 16) * ldc + col0;
#pragma unroll
                for (int bj = 0; bj < 2; ++bj)
#pragma unroll
                    for (int n = 0; n < 2; ++n) *(f32x4*)(rowp + bj * HALF + n * 16) = acc[ai][bj][m][n] * r[ai][m] + cv[bj][n]; }
    }
};
struct EpiBf16 {
    static constexpr bool PERM = true, AFTER_DRAIN = false;
    bf16_t* O; int ldc; const float* stat; const float* cb;
    __device__ __forceinline__ void operator()(const f32x4 (&acc)[2][2][4][2], const Unit& u, int wr, int wc, int fr, int fq) const {
        const int row0 = u.pm * BM + wr * 64 + fr, col0 = u.pn * BM + wc * 32 + 8 * fq;
        float r[2][4]; row_scales(stat, u, wr, fr, r);
        f32x4 cv[2][2];
#pragma unroll
        for (int bj = 0; bj < 2; ++bj)
#pragma unroll
            for (int n = 0; n < 2; ++n) cv[bj][n] = stat ? *(const f32x4*)(cb + (size_t)panel_variant(u) * CBN_ + col0 + bj * HALF + 4 * n) : (f32x4){0.f, 0.f, 0.f, 0.f};
#pragma unroll
        for (int ai = 0; ai < 2; ++ai)
#pragma unroll
            for (int m = 0; m < 4; ++m) { bf16_t* rowp = O + (size_t)(row0 + ai * HALF + m * 16) * ldc + col0;
#pragma unroll
                for (int bj = 0; bj < 2; ++bj) { const f32x4 v0 = acc[ai][bj][m][0] * r[ai][m] + cv[bj][0], v1 = acc[ai][bj][m][1] * r[ai][m] + cv[bj][1];
                    u32x4 w; w.x = cvt_pk_bf16(v0[0], v0[1]); w.y = cvt_pk_bf16(v0[2], v0[3]); w.z = cvt_pk_bf16(v1[0], v1[1]); w.w = cvt_pk_bf16(v1[2], v1[3]);
                    *(u32x4*)(rowp + bj * HALF) = w; } }
    }
};
__device__ __forceinline__ float dpp_ror1(float v) { return __builtin_bit_cast(float, __builtin_amdgcn_update_dpp(0, __builtin_bit_cast(int, v), 0x121, 0xf, 0xf, false)); }
__device__ __forceinline__ float dpp_rol1(float v) { return __builtin_bit_cast(float, __builtin_amdgcn_update_dpp(0, __builtin_bit_cast(int, v), 0x12f, 0xf, 0xf, false)); }
struct EpiConv {
    static constexpr bool PERM = true, AFTER_DRAIN = false;
    bf16_t* ACT; float* GH; float* VH; const float* cw; const float* cb; const float* stat; const float* cvec;
    __device__ __forceinline__ void operator()(const f32x4 (&acc_)[2][2][4][2], const Unit& u, int wr, int wc, int fr, int fq) const {
        constexpr int FF = 5632;
        const int f0 = u.pn * 128 + wc * 32 + 8 * fq;
        f32x4 acc[2][2][4][2];
        { float r[2][4]; row_scales(stat, u, wr, fr, r); const float* cp = cvec + (size_t)panel_variant(u) * CBN_ + u.pn * BM + wc * 32 + 8 * fq;
#pragma unroll
          for (int bj = 0; bj < 2; ++bj)
#pragma unroll
            for (int n = 0; n < 2; ++n) { const f32x4 cv = *(const f32x4*)(cp + bj * HALF + 4 * n);
#pragma unroll
              for (int ai = 0; ai < 2; ++ai)
#pragma unroll
                for (int m = 0; m < 4; ++m) acc[ai][bj][m][n] = acc_[ai][bj][m][n] * r[ai][m] + cv; } }
        float w0[8], w1[8], w2[8], bb[8];
#pragma unroll
        for (int h = 0; h < 2; ++h) { const f32x4 a = *(const f32x4*)(cw + f0 + 4 * h), b = *(const f32x4*)(cw + FF + f0 + 4 * h), c = *(const f32x4*)(cw + 2 * FF + f0 + 4 * h), d = *(const f32x4*)(cb + f0 + 4 * h);
#pragma unroll
            for (int i = 0; i < 4; ++i) { w0[4 * h + i] = a[i]; w1[4 * h + i] = b[i]; w2[4 * h + i] = c[i]; bb[4 * h + i] = d[i]; } }
#pragma unroll
        for (int ai = 0; ai < 2; ++ai) {
            const int sid = u.pm * 4 + ai * 2 + wr, row0 = u.pm * BM + ai * HALF + wr * 64 + fr;
#pragma unroll
            for (int m = 0; m < 4; ++m) {
                float o[8];
#pragma unroll
                for (int i = 0; i < 8; ++i) {
                    const float g = acc[ai][0][m][i >> 2][i & 3], v = acc[ai][1][m][i >> 2][i & 3];
                    const float pa = dpp_ror1(g), pb = m > 0 ? dpp_ror1(acc[ai][0][m > 0 ? m - 1 : 0][i >> 2][i & 3]) : 0.f;
                    const float na = dpp_rol1(g), nb = m < 3 ? dpp_rol1(acc[ai][0][m < 3 ? m + 1 : 3][i >> 2][i & 3]) : 0.f;
                    const float pv = fr == 0 ? pb : pa, nx = fr == 15 ? nb : na;
                    const float a = fmaf(w0[i], pv, fmaf(w1[i], g, fmaf(w2[i], nx, bb[i])));
                    o[i] = a * __builtin_amdgcn_rcpf(1.f + __builtin_amdgcn_exp2f(a * -1.4426950408889634f)) * v;
                }
                const bool edge = (m == 0 && fr == 0) || (m == 3 && fr == 15);
                if (!edge) { u32x4 w; w.x = cvt_pk_bf16(o[0], o[1]); w.y = cvt_pk_bf16(o[2], o[3]); w.z = cvt_pk_bf16(o[4], o[5]); w.w = cvt_pk_bf16(o[6], o[7]);
                    *(u32x4*)(ACT + (size_t)(row0 + m * 16) * FF + f0) = w; }
                if (m == 0 && fr < 2) { float* p = GH + ((size_t)sid * 4 + fr) * FF + f0; *(f32x4*)p = acc[ai][0][0][0]; *(f32x4*)(p + 4) = acc[ai][0][0][1]; }
                if (m == 3 && fr >= 14) { float* p = GH + ((size_t)sid * 4 + 2 + (fr - 14)) * FF + f0; *(f32x4*)p = acc[ai][0][3][0]; *(f32x4*)(p + 4) = acc[ai][0][3][1]; }
                if (m == 0 && fr == 0) { float* p = VH + ((size_t)sid * 2) * FF + f0; *(f32x4*)p = acc[ai][1][0][0]; *(f32x4*)(p + 4) = acc[ai][1][0][1]; }
                if (m == 3 && fr == 15) { float* p = VH + ((size_t)sid * 2 + 1) * FF + f0; *(f32x4*)p = acc[ai][1][3][0]; *(f32x4*)(p + 4) = acc[ai][1][3][1]; }
            }
        }
    }
};
struct EpiRes {
    static constexpr bool PERM = true, AFTER_DRAIN = false;
    const float* base; float* out; const float* gates; int to_out; float* part; int nkt_full;
    bf16_t* XS; const float* av; float* stat; unsigned char* XS8;
    __device__ __forceinline__ void operator()(const f32x4 (&acc)[2][2][4][2], const Unit& u, int wr, int wc, int fr, int fq) const {
        const int b = u.pm / 33, isctx = (u.pm - b * 33) == 32, v = isctx ? 2 : b;
        const float* g = gates + (size_t)v * 12288;
        const int row0 = u.pm * BM + wr * 64 + fr, col0 = u.pn * BM + wc * 32 + 8 * fq;
        const int orow0 = to_out ? row0 - 256 * b : row0;
        if (u.nkt != nkt_full) {
            float* pp = part + ((size_t)(u.kt0 / u.nkt) * 512 + 256 * b + wr * 64 + fr) * 2048 + u.pn * BM + wc * 32 + 8 * fq;
#pragma unroll
            for (int bj = 0; bj < 2; ++bj)
#pragma unroll
                for (int n = 0; n < 2; ++n) { const f32x4 gvv = *(const f32x4*)(g + col0 + bj * HALF + n * 4);
#pragma unroll
                    for (int ai = 0; ai < 2; ++ai)
#pragma unroll
                        for (int m = 0; m < 4; ++m) *(f32x4*)(pp + (size_t)(ai * HALF + m * 16) * 2048 + bj * HALF + n * 4) = gvv * acc[ai][bj][m][n]; }
            return;
        }
        f32x4 gv[2][2], aw[2][2];
#pragma unroll
        for (int bj = 0; bj < 2; ++bj)
#pragma unroll
            for (int n = 0; n < 2; ++n) { gv[bj][n] = *(const f32x4*)(g + col0 + bj * HALF + n * 4); aw[bj][n] = stat ? *(const f32x4*)(av + (size_t)v * 2048 + col0 + bj * HALF + n * 4) : (f32x4){0.f, 0.f, 0.f, 0.f}; }
        const int lane = fq * 16 + fr;
#pragma unroll
        for (int ai = 0; ai < 2; ++ai)
#pragma unroll
            for (int m = 0; m < 4; ++m) { const float* bp = base + (size_t)(row0 + ai * HALF + m * 16) * 2048 + col0; float* op = out + (size_t)(orow0 + ai * HALF + m * 16) * 2048 + col0;
                bf16_t* xp = XS + (size_t)(row0 + ai * HALF + m * 16) * 2048 + col0; float ss = 0.f;
#pragma unroll
                for (int bj = 0; bj < 2; ++bj) { f32x4 xx[2];
#pragma unroll
                    for (int n = 0; n < 2; ++n) { xx[n] = *(const f32x4*)(bp + bj * HALF + n * 4) + gv[bj][n] * acc[ai][bj][m][n]; *(f32x4*)(op + bj * HALF + n * 4) = xx[n]; }
                    if (stat) { ss += ((xx[0][0] * xx[0][0] + xx[0][1] * xx[0][1]) + (xx[0][2] * xx[0][2] + xx[0][3] * xx[0][3])) + ((xx[1][0] * xx[1][0] + xx[1][1] * xx[1][1]) + (xx[1][2] * xx[1][2] + xx[1][3] * xx[1][3]));
                        const f32x4 y0 = xx[0] * aw[bj][0], y1 = xx[1] * aw[bj][1];
                        u32x4 w; w.x = cvt_pk_bf16(y0[0], y0[1]); w.y = cvt_pk_bf16(y0[2], y0[3]); w.z = cvt_pk_bf16(y1[0], y1[1]); w.w = cvt_pk_bf16(y1[2], y1[3]); *(u32x4*)(xp + bj * HALF) = w;
                        if (XS8) { u32x2 w8; int t_ = 0; t_ = __builtin_amdgcn_cvt_pk_fp8_f32(y0[0], y0[1], t_, false); t_ = __builtin_amdgcn_cvt_pk_fp8_f32(y0[2], y0[3], t_, true); w8.x = (unsigned)t_; t_ = 0; t_ = __builtin_amdgcn_cvt_pk_fp8_f32(y1[0], y1[1], t_, false); t_ = __builtin_amdgcn_cvt_pk_fp8_f32(y1[2], y1[3], t_, true); w8.y = (unsigned)t_;
                            *(u32x2*)(XS8 + (size_t)(row0 + ai * HALF + m * 16) * 2048 + col0 + bj * HALF) = w8; } } }
                if (stat) {
                    ss += __builtin_bit_cast(float, __builtin_amdgcn_ds_bpermute((lane ^ 16) << 2, __builtin_bit_cast(int, ss)));
                    ss += __builtin_bit_cast(float, __builtin_amdgcn_ds_bpermute((lane ^ 32) << 2, __builtin_bit_cast(int, ss)));
                    if (fq == 0) unsafeAtomicAdd(stat + row0 + ai * HALF + m * 16, ss); } }
    }
};
struct PanelOrder : StaticOrder {
    int skip, nkt_full;
    __device__ void init2(int N, int K, int G_, int c_, int skip_) { skip = skip_; nkt_full = K / BK; init(skip_ ? 16384 : 16896, N, G_, c_); }
    __device__ __forceinline__ bool next(int i, Unit& u) const { Unit a; a.pm = 0; a.pn = 0; const bool ok = StaticOrder::next(i, a); u.pm = (skip && a.pm >= 32) ? a.pm + 1 : a.pm; u.pn = a.pn; u.kt0 = 0; u.nkt = nkt_full; return ok; }
};
struct ResOrder : StaticOrder {
    int nsplit, nkt_full;
    __device__ void init2(int K, int G_, int c_, int nsplit_) { nsplit = nsplit_; nkt_full = K / BK; init(16384, 2048, G_, c_); }
    __device__ __forceinline__ bool next(int i, Unit& u) const {
        const int L = i * G + c;
        Unit a; a.pm = 0; a.pn = 0; const bool lat = StaticOrder::next(i, a);
        const int m = L - nwg, cu = m & 15, s = m >> 4, nk = nsplit > 0 ? nkt_full / nsplit : nkt_full;
        const int pm = lat ? (a.pm >= 32 ? a.pm + 1 : a.pm) : ((cu >> 3) ? 65 : 32), pn = lat ? a.pn : (cu & 7);
        u.pm = pm; u.pn = pn; u.kt0 = lat ? 0 : s * nk; u.nkt = lat ? nkt_full : nk;
        return lat || m < 16 * nsplit;
    }
};

template <class Epi, class Sched, bool ALIGN_EPI = false, bool SP2 = false, bool F8 = false>
__device__ __forceinline__ void gemm_phase(PG8_LAS unsigned char* lds, const Gemm g, const Sched& S, const Epi& E, int wave_in) {
    int tid_; asm volatile("v_mbcnt_lo_u32_b32 %0, -1, 0\n\tv_mbcnt_hi_u32_b32 %0, -1, %0" : "=&v"(tid_)); tid_ |= wave_in << 6;
    const int tid = tid_, wid = __builtin_amdgcn_readfirstlane(tid >> 6), lane = tid & 63, wr = wid >> 2, wc = wid & 3, fr = lane & 15, fq = lane >> 4;
    const int K = g.K;
    unsigned voffA[2], voffB[2];
#pragma unroll
    for (int i = 0; i < 2; ++i) { int R, C; stage_rc(tid * 16 + i * 8192, R, C); const int Rb = Epi::PERM ? ((R & ~31) + perm32(R & 31)) : R;
        voffA[i] = (unsigned)(R * K + C) * 2u; voffB[i] = (unsigned)(Rb * K + C) * 2u; }
    const size_t kstep = (size_t)(BK * 2);
    const size_t hstep = (size_t)HALF * K * 2;
    const size_t tstep = 2 * hstep;
    const unsigned ldsw = (unsigned)wid * 1024u;
    const int aoff = lds_byte(wr * 64 + fr, fq * 8), boff = lds_byte(wc * 32 + fr, fq * 8);
#define PG8_SA(b, h) (((b) * 2 + (h)) * HTB)
#define PG8_SB(b, h) ((4 + (b) * 2 + (h)) * HTB)
#define PG8_STAGE(bufoff, gbase, voff) do { _Pragma("unroll") for (int _i = 0; _i < 2; ++_i) \
        __builtin_amdgcn_global_load_lds((const unsigned*)((const char*)(gbase) + (voff)[_i]), (PG8_LAS unsigned*)(lds + (bufoff) + ldsw + _i * 8192), 16, 0, 0); } while (0)
#define PG8_LDA(dst, b, h) do { _Pragma("unroll") for (int m = 0; m < 4; ++m) dst[m].ld(lds + PG8_SA(b, h) + aoff + m * 2048); } while (0)
#define PG8_LDB(dst, b, h) do { _Pragma("unroll") for (int n = 0; n < 2; ++n) dst[n].ld(lds + PG8_SB(b, h) + boff + n * 2048); } while (0)
#define PG8_MMA(ai, bj, At, Bt) do { __builtin_amdgcn_s_setprio(1); _Pragma("unroll") for (int m = 0; m < 4; ++m) _Pragma("unroll") for (int n = 0; n < 2; ++n) { \
        if constexpr (F8) {     \
              \
            asm volatile("v_mfma_scale_f32_16x16x128_f8f6f4 %0, %1, %2, %0, %3, %4 op_sel_hi:[0,0,0]" : "+v"(acc[ai][bj][m][n]) : "v"(Bt[n].w), "v"(At[m].w), "v"(g.sa), "v"(g.sb)); \
        } else { acc[ai][bj][m][n] = __builtin_amdgcn_mfma_f32_16x16x32_bf16(Bt[n].k0(), At[m].k0(), acc[ai][bj][m][n], 0, 0, 0); \
                 acc[ai][bj][m][n] = __builtin_amdgcn_mfma_f32_16x16x32_bf16(Bt[n].k1(), At[m].k1(), acc[ai][bj][m][n], 0, 0, 0); } } \
        __builtin_amdgcn_s_setprio(0); } while (0)
#define PG8_WAIT_V(n) asm volatile("s_waitcnt vmcnt(" #n ")" ::: "memory")
#define PG8_WAIT_L(n) asm volatile("s_waitcnt lgkmcnt(" #n ")" ::: "memory")
#define PG8_BAR __builtin_amdgcn_s_barrier()
#define PG8_SCHED __builtin_amdgcn_sched_barrier(0)
    Unit cur, nxt; int ui = 0;
    if (!S.next(0, cur)) return;
    f32x4 acc[2][2][4][2];
#pragma unroll
    for (int a = 0; a < 2; ++a)
#pragma unroll
        for (int b = 0; b < 2; ++b)
#pragma unroll
            for (int m = 0; m < 4; ++m)
#pragma unroll
                for (int n = 0; n < 2; ++n) acc[a][b][m][n] = (f32x4){0.f, 0.f, 0.f, 0.f};
    Frag2 At[4], B0[2], B1[2];
    const char* cA = (const char*)g.A + (size_t)cur.pm * tstep + (size_t)cur.kt0 * kstep; const char* cB = (const char*)g.Bt + (size_t)cur.pn * tstep + (size_t)cur.kt0 * kstep;
    S.a_ready(cur);
    if constexpr (SP2) {
        PG8_STAGE(PG8_SB(0, 0), cB, voffB); PG8_STAGE(PG8_SB(0, 1), cB + hstep, voffB); PG8_STAGE(PG8_SA(0, 0), cA, voffA); PG8_STAGE(PG8_SA(0, 1), cA + hstep, voffA);
        if (wr == 1) PG8_BAR;
        PG8_WAIT_V(2); PG8_BAR;
        PG8_STAGE(PG8_SB(1, 0), cB + kstep, voffB); PG8_STAGE(PG8_SA(1, 0), cA + kstep, voffA); PG8_STAGE(PG8_SB(1, 1), cB + hstep + kstep, voffB);
        PG8_WAIT_V(6); PG8_BAR;
    } else {
        PG8_STAGE(PG8_SB(0, 0), cB, voffB); PG8_STAGE(PG8_SA(0, 0), cA, voffA); PG8_STAGE(PG8_SB(0, 1), cB + hstep, voffB); PG8_STAGE(PG8_SA(0, 1), cA + hstep, voffA);
        if (wr == 1) PG8_BAR;
        PG8_WAIT_V(4); PG8_BAR;
        PG8_STAGE(PG8_SB(1, 0), cB + kstep, voffB); PG8_STAGE(PG8_SA(1, 0), cA + kstep, voffA); PG8_STAGE(PG8_SB(1, 1), cB + hstep + kstep, voffB);
        PG8_WAIT_V(6); PG8_BAR;
    }
    for (;;) {
        const bool has_next = S.next(ui + 1, nxt);
        const char* nA = has_next ? (const char*)g.A + (size_t)nxt.pm * tstep + (size_t)nxt.kt0 * kstep : cA; const char* nB = has_next ? (const char*)g.Bt + (size_t)nxt.pn * tstep + (size_t)nxt.kt0 * kstep : cB;
        const int nt = cur.nkt;
        for (int t = 0; t < nt; t += 2) {
            const bool last = (t == nt - 2);
            const char* a1 = cA + (size_t)(t + 1) * kstep;
            const char* a2 = last ? nA : cA + (size_t)(t + 2) * kstep; const char* b2 = last ? nB : cB + (size_t)(t + 2) * kstep;
            const char* a3 = a2 + kstep; const char* b3 = b2 + kstep;
            if (last && has_next) S.a_ready(nxt);
            if constexpr (SP2) {
            PG8_LDB(B0, 0, 0); PG8_LDB(B1, 0, 1); PG8_SCHED; PG8_LDA(At, 0, 0); PG8_STAGE(PG8_SA(1, 1), a1 + hstep, voffA);
            PG8_WAIT_V(8); PG8_WAIT_L(0); PG8_BAR; PG8_MMA(0, 0, At, B0); PG8_MMA(0, 1, At, B1); PG8_BAR; PG8_SCHED;
            PG8_LDA(At, 0, 1); PG8_STAGE(PG8_SB(0, 0), b2, voffB); PG8_STAGE(PG8_SB(0, 1), b2 + hstep, voffB); PG8_STAGE(PG8_SA(0, 0), a2, voffA);
            PG8_WAIT_V(8); PG8_WAIT_L(0); PG8_BAR; PG8_MMA(1, 0, At, B0); PG8_MMA(1, 1, At, B1); PG8_BAR; PG8_SCHED;
            PG8_LDB(B0, 1, 0); PG8_LDB(B1, 1, 1); PG8_SCHED; PG8_LDA(At, 1, 0); PG8_STAGE(PG8_SA(0, 1), a2 + hstep, voffA);
            PG8_WAIT_V(8); PG8_WAIT_L(0); PG8_BAR; PG8_MMA(0, 0, At, B0); PG8_MMA(0, 1, At, B1); PG8_BAR; PG8_SCHED;
            PG8_LDA(At, 1, 1); PG8_STAGE(PG8_SB(1, 0), b3, voffB); PG8_STAGE(PG8_SB(1, 1), b3 + hstep, voffB); PG8_STAGE(PG8_SA(1, 0), a3, voffA);
            PG8_WAIT_V(8); PG8_WAIT_L(0); PG8_BAR; PG8_MMA(1, 0, At, B0); PG8_MMA(1, 1, At, B1); PG8_BAR; PG8_SCHED;
            } else {
            PG8_LDB(B0, 0, 0); PG8_SCHED; PG8_LDA(At, 0, 0); PG8_STAGE(PG8_SA(1, 1), a1 + hstep, voffA);
            PG8_WAIT_L(8); PG8_BAR; PG8_WAIT_L(0); PG8_MMA(0, 0, At, B0); PG8_BAR; PG8_SCHED;
            PG8_LDB(B1, 0, 1); PG8_STAGE(PG8_SB(0, 0), b2, voffB);
            PG8_BAR; PG8_WAIT_L(0); PG8_MMA(0, 1, At, B1); PG8_BAR;
            PG8_LDA(At, 0, 1); PG8_STAGE(PG8_SA(0, 0), a2, voffA);
            PG8_BAR; PG8_WAIT_L(0); PG8_MMA(1, 0, At, B0); PG8_BAR; PG8_SCHED;
            PG8_STAGE(PG8_SB(0, 1), b2 + hstep, voffB);
            PG8_WAIT_V(6); PG8_BAR; PG8_MMA(1, 1, At, B1); PG8_BAR;
            PG8_LDB(B0, 1, 0); PG8_SCHED; PG8_LDA(At, 1, 0); PG8_STAGE(PG8_SA(0, 1), a2 + hstep, voffA);
            PG8_WAIT_L(8); PG8_BAR; PG8_WAIT_L(0); PG8_MMA(0, 0, At, B0); PG8_BAR; PG8_SCHED;
            PG8_LDB(B1, 1, 1); PG8_STAGE(PG8_SB(1, 0), b3, voffB);
            PG8_BAR; PG8_WAIT_L(0); PG8_MMA(0, 1, At, B1); PG8_BAR;
            PG8_LDA(At, 1, 1); PG8_STAGE(PG8_SA(1, 0), a3, voffA);
            PG8_BAR; PG8_WAIT_L(0); PG8_MMA(1, 0, At, B0); PG8_BAR; PG8_SCHED;
            PG8_STAGE(PG8_SB(1, 1), b3 + hstep, voffB);
            PG8_WAIT_V(6); PG8_BAR; PG8_MMA(1, 1, At, B1); PG8_BAR;
            }
        }
        if constexpr (ALIGN_EPI) { if (wr == 0) PG8_BAR; }
        if constexpr (F8) asm volatile("s_nop 15\n\ts_nop 15" ::: "memory");
        if constexpr (!Epi::AFTER_DRAIN) { E(acc, cur, wr, wc, fr, fq); S.done(cur); }
        if (!has_next) break;
#pragma unroll
        for (int a = 0; a < 2; ++a)
#pragma unroll
            for (int b = 0; b < 2; ++b)
#pragma unroll
                for (int m = 0; m < 4; ++m)
#pragma unroll
                    for (int n = 0; n < 2; ++n) acc[a][b][m][n] = (f32x4){0.f, 0.f, 0.f, 0.f};
        cur = nxt; cA = nA; cB = nB; ++ui;
        if constexpr (ALIGN_EPI) { if (wr == 1) PG8_BAR; }
    }
    PG8_WAIT_V(0);
    if constexpr (!ALIGN_EPI) { if (wr == 0) PG8_BAR; }
    PG8_BAR;
    if constexpr (Epi::AFTER_DRAIN) { E.fused(acc, cur, wr, wc, fr, fq, lds, wid, lane); S.done(cur); }
#undef PG8_SA
#undef PG8_SB
#undef PG8_STAGE
#undef PG8_LDA
#undef PG8_LDB
#undef PG8_MMA
#undef PG8_WAIT_V
#undef PG8_WAIT_L
#undef PG8_BAR
#undef PG8_SCHED
}
}

#define GAS __attribute__((address_space(1)))
#define LAS __attribute__((address_space(3)))
typedef unsigned short bf16;
typedef unsigned v4u __attribute__((ext_vector_type(4)));
typedef unsigned v2u __attribute__((ext_vector_type(2)));
typedef float f32x4 __attribute__((ext_vector_type(4)));
#define LDS_WAIT() asm volatile("s_waitcnt lgkmcnt(0)" ::: "memory")
#define VM_WAIT() asm volatile("s_waitcnt vmcnt(0)" ::: "memory")

#define XB_TMO      128
#define XB_XCNT(j)  (256  + 64 * (j))
#define XB_XSUB(j)  (1280 + 64 * (j))
#define XB_XGEN(j)  (2304 + 64 * (j))
#define XB_TOP      3328
#define XB_TOPGEN   3392
#define XCD_BAR_WORDS 3456
#define XB_SPIN_CAP (1u << 18)

__device__ __forceinline__ unsigned xb_ld(unsigned* p)              { return __hip_atomic_load(p, __ATOMIC_RELAXED, __HIP_MEMORY_SCOPE_AGENT); }
__device__ __forceinline__ unsigned xb_add(unsigned* p, unsigned v) { return __hip_atomic_fetch_add(p, v, __ATOMIC_RELAXED, __HIP_MEMORY_SCOPE_AGENT); }
__device__ __forceinline__ unsigned xb_xcc_id() { return (unsigned)__builtin_amdgcn_s_getreg((3 << 11) | 20) & 0xFu; }
#define XB_SPIN(cond, bar) do { unsigned _sp = 0; while (cond) { __builtin_amdgcn_s_sleep(1); \
    if ((++_sp & 255u) == 0u) { if (xb_ld(&(bar)[XB_TMO])) break; if (_sp > XB_SPIN_CAP) { atomicAdd(&(bar)[XB_TMO], 1u); break; } } } } while (0)

struct XcdBarrier {
    int tid;
    unsigned* bar; unsigned x;
    volatile LAS unsigned* st;
};

__device__ __forceinline__ XcdBarrier xcd_barrier_post(unsigned* bar, volatile LAS unsigned* st, int tid) {
    XcdBarrier b; b.tid = tid; b.bar = bar; b.x = xb_xcc_id(); b.st = st;
    if (tid == 0) (void)xb_add(&bar[XB_XCNT(b.x)], 1u);
    return b;
}
__device__ __forceinline__ void xcd_barrier_complete(unsigned* bar, unsigned x, unsigned& nloc, unsigned& nx) {
    const unsigned G = gridDim.x * gridDim.y * gridDim.z;
    unsigned sum, cnt, mine, sp = 0u;
    for (;;) {
        sum = 0u; cnt = 0u; mine = 0u;
#pragma unroll
        for (unsigned j = 0; j < 16; ++j) { const unsigned c = xb_ld(&bar[XB_XCNT(j)]); sum += c; cnt += (c > 0u) ? 1u : 0u; mine = (j == x) ? c : mine; }
        if (sum == G) break;
        __builtin_amdgcn_s_sleep(1);
        if ((++sp & 255u) == 0u) { if (xb_ld(&bar[XB_TMO])) break; if (sp > XB_SPIN_CAP) { atomicAdd(&bar[XB_TMO], 1u); break; } }
    }
    nloc = mine > 0u ? mine : 1u; nx = cnt > 0u ? cnt : 1u;
}

__device__ __forceinline__ void xcd_barrier(const XcdBarrier& b) {
    asm volatile("s_waitcnt vmcnt(0)" ::: "memory");
    __syncthreads();
    if (b.tid == 0) {
        unsigned* bar = b.bar;
        __builtin_amdgcn_s_waitcnt(0);
        unsigned nloc = b.st[0], nx = b.st[1];
        if (nloc == 0u) { xcd_barrier_complete(bar, b.x, nloc, nx); b.st[0] = nloc; b.st[1] = nx; }
        const unsigned old = xb_add(&bar[XB_XSUB(b.x)], 1u);
        const unsigned gen = old / nloc;
        if (old + 1u == (gen + 1u) * nloc) {
            __builtin_amdgcn_fence(__ATOMIC_RELEASE, "agent");
            asm volatile("s_waitcnt vmcnt(0)" ::: "memory");
            const unsigned og = xb_add(&bar[XB_TOP], 1u);
            const unsigned tg = og / nx;
            if (og + 1u == (tg + 1u) * nx) xb_add(&bar[XB_TOPGEN], 1u);
            else XB_SPIN(xb_ld(&bar[XB_TOPGEN]) == tg, bar);
            __builtin_amdgcn_fence(__ATOMIC_ACQUIRE, "agent");
            xb_add(&bar[XB_XGEN(b.x)], 1u);
            asm volatile("s_waitcnt vmcnt(0)" ::: "memory");
        } else {
            XB_SPIN(xb_ld(&bar[XB_XGEN(b.x)]) == gen, bar);
            __builtin_amdgcn_fence(__ATOMIC_ACQUIRE, "agent");
            asm volatile("s_waitcnt vmcnt(0)" ::: "memory");
        }
    }
    __syncthreads();
}
namespace att {
using bf16 = unsigned short;
using bf16x8 = __attribute__((ext_vector_type(8))) short;
using s16x4  = __attribute__((ext_vector_type(4))) short;
using f32x16 = __attribute__((ext_vector_type(16))) float;
using f32x4  = __attribute__((ext_vector_type(4))) float;
using u32x4  = __attribute__((ext_vector_type(4))) unsigned;
typedef int v4i_att __attribute__((ext_vector_type(4)));
typedef int v8i_att __attribute__((ext_vector_type(8)));
typedef int v2i_att __attribute__((ext_vector_type(2)));
constexpr int NW = 8, QBLK = 32, KVBLK = 64, DV = 128;
constexpr float THR = 8.f;
#define ATT_SBAR() __builtin_amdgcn_sched_barrier(0)
#define ATT_LAS __attribute__((address_space(3)))
__device__ __forceinline__ int crow(int r, int hi) { return (r & 3) + 8 * (r >> 2) + 4 * hi; }
__device__ __forceinline__ unsigned cvtpk(float lo, float hi) { unsigned r; asm volatile("v_cvt_pk_bf16_f32 %0, %1, %2" : "=v"(r) : "v"(lo), "v"(hi)); return r; }

__device__ __forceinline__ float att_shx(float v, int lane, int o) { return __builtin_bit_cast(float, __builtin_amdgcn_ds_bpermute((lane ^ o) << 2, __builtin_bit_cast(int, v))); }
struct CfgGQA { static constexpr int LDVT = 8448, NS = 2, KROWB = 128, RB = 128, DQK = 128, LDQ = 3072, LDK = 512, LDV = 3072, LDO = 2048, SDEPTH = 0; static constexpr bool MLA = false, MSUM = false; static constexpr float SCALE = 0.088388347648318440f; };
struct CfgMLA { static constexpr int LDVT = 8448, NS = 3, KROWB = 192, RB = 256, DQK = 192, LDQ = 3072, LDK = 3072, LDV = 4096, LDO = 2048, SDEPTH = 0; static constexpr bool MLA = true, MSUM = false;  static constexpr float SCALE = 0.072168783648703220f; };

__device__ __forceinline__ float max3f(float a, float b, float c) { float r; asm("v_max3_f32 %0, %1, %2, %3" : "=v"(r) : "v"(a), "v"(b), "v"(c)); return r; }
__device__ __forceinline__ float max2f(float a, float b) { float r; asm("v_max_f32_e32 %0, %1, %2" : "=v"(r) : "v"(a), "v"(b)); return r; }
__device__ __forceinline__ float max8(const f32x16& p, int base) {
  return max2f(max3f(max3f(max3f(p[base], p[base + 1], p[base + 2]), p[base + 3], p[base + 4]), p[base + 5], p[base + 6]), p[base + 7]);
}
template <bool FIRST>
__device__ __forceinline__ void decideSM(f32x16& p0, f32x16& p1, float pmax, float& m_reg, f32x16& negm, float& alpha) {
  constexpr float THRL = THR * 1.4426950408889634f;
  { auto rr = __builtin_amdgcn_permlane32_swap(__float_as_uint(pmax), __float_as_uint(pmax), false, false);
    pmax = fmaxf(__uint_as_float(rr[0]), __uint_as_float(rr[1])); }
  if (!FIRST && __builtin_expect(__all(pmax <= THRL), 1)) { alpha = 1.f; }
  else { const float d = FIRST ? pmax : fmaxf(pmax, 0.f); alpha = FIRST ? 0.f : __builtin_amdgcn_exp2f(-d); m_reg += d;
#pragma unroll
    for (int r = 0; r < 16; ++r) { p0[r] -= d; p1[r] -= d; negm[r] -= d; } }
}
template <bool SUMV>
__device__ __forceinline__ void finishSM(f32x16& p0, f32x16& p1, float alpha, float& l_reg, bf16x8& pa0, bf16x8& pa1, bf16x8& pa2, bf16x8& pa3) {
#pragma unroll
  for (int r = 0; r < 16; ++r) p0[r] = __builtin_amdgcn_exp2f(p0[r]);
#pragma unroll
  for (int r = 0; r < 16; ++r) p1[r] = __builtin_amdgcn_exp2f(p1[r]);
  if constexpr (SUMV) { float ps = 0;
#pragma unroll
  for (int r = 0; r < 16; ++r) ps += p0[r];
#pragma unroll
  for (int r = 0; r < 16; ++r) ps += p1[r];
  { auto rr = __builtin_amdgcn_permlane32_swap(__float_as_uint(ps), __float_as_uint(ps), false, false);
    ps = __uint_as_float(rr[0]) + __uint_as_float(rr[1]); }
  l_reg = l_reg * alpha + ps; }
#define ATT_PKB(P, B) __builtin_amdgcn_cvt_pk_bf8_f32(P[B + 2], P[B + 3], __builtin_amdgcn_cvt_pk_bf8_f32(P[B], P[B + 1], 0, false), true)
  { const v4i_att w0 = {ATT_PKB(p0, 0), ATT_PKB(p0, 4), ATT_PKB(p0, 8), ATT_PKB(p0, 12)}, w1 = {ATT_PKB(p1, 0), ATT_PKB(p1, 4), ATT_PKB(p1, 8), ATT_PKB(p1, 12)};
    pa0 = __builtin_bit_cast(bf16x8, w0); pa1 = __builtin_bit_cast(bf16x8, w1); pa2 = pa0; pa3 = pa1; }
#undef ATT_PKB
}
__device__ __forceinline__ void finishU8(const f32x16& p0, const f32x16& p1, bf16x8& pa0, bf16x8& pa1) {
  v4i_att w0 = {0, 0, 0, 0}, w1 = {0, 0, 0, 0};
#pragma unroll
  for (int r = 0; r < 16; ++r) { w0[r >> 2] = (int)__builtin_amdgcn_cvt_pk_u8_f32(p0[r], r & 3, (unsigned)w0[r >> 2]); w1[r >> 2] = (int)__builtin_amdgcn_cvt_pk_u8_f32(p1[r], r & 3, (unsigned)w1[r >> 2]); }
  pa0 = __builtin_bit_cast(bf16x8, w0); pa1 = __builtin_bit_cast(bf16x8, w1);
}
__device__ __forceinline__ void rowsum16(f32x4& ls, bf16x8 pa0, bf16x8 pa1, const v8i_att& bones) {
  constexpr int ONE = 0x7f7f7f7f;
  const v4i_att a0 = __builtin_bit_cast(v4i_att, pa0), a1 = __builtin_bit_cast(v4i_att, pa1);
  const v8i_att A = {a0[0], a0[1], a0[2], a0[3], a1[0], a1[1], a1[2], a1[3]};
  asm volatile("s_nop 1\n\tv_mfma_scale_f32_16x16x128_f8f6f4 %0, %1, %2, %0, %3, %3 op_sel_hi:[0,0,0] cbsz:1" : "+v"(ls) : "v"(A), "v"(bones), "v"(ONE));
}
typedef int v8i __attribute__((ext_vector_type(8)));
typedef int v4i __attribute__((ext_vector_type(4)));
template <int RB> __device__ __forceinline__ int kswf(int row) { return RB == 128 ? ((row >> 1) & 7) : (row & 15); }
template <int RB> __device__ __forceinline__ int kswz8(int row, int chunk) { return row * RB + ((chunk ^ kswf<RB>(row)) << 4); }
template <class Cfg, int SA>
__device__ __forceinline__ void qkt(f32x16& p0, f32x16& p1, const char* Ks, const v8i* q8, const f32x16& negm, int r32, int hi) {
  constexpr int ONE = 0x7f7f7f7f;
#pragma unroll
  for (int s = 0; s < Cfg::NS; ++s) { const int c = 4 * s + 2 * hi;
    const v4i a0 = *reinterpret_cast<const v4i*>(Ks + kswz8<Cfg::RB>(r32, c)), a1 = *reinterpret_cast<const v4i*>(Ks + kswz8<Cfg::RB>(r32, c + 1));
    const v4i b0 = *reinterpret_cast<const v4i*>(Ks + kswz8<Cfg::RB>(32 + r32, c)), b1 = *reinterpret_cast<const v4i*>(Ks + kswz8<Cfg::RB>(32 + r32, c + 1));
    const v8i A = {a0[0], a0[1], a0[2], a0[3], a1[0], a1[1], a1[2], a1[3]}, B = {b0[0], b0[1], b0[2], b0[3], b1[0], b1[1], b1[2], b1[3]};
    if (s == 0) { p0 = __builtin_amdgcn_mfma_scale_f32_32x32x64_f8f6f4(A, q8[0], negm, 2, 2, 0, SA, 0, ONE); p1 = __builtin_amdgcn_mfma_scale_f32_32x32x64_f8f6f4(B, q8[0], negm, 2, 2, 0, SA, 0, ONE); }
    else { p0 = __builtin_amdgcn_mfma_scale_f32_32x32x64_f8f6f4(A, q8[s], p0, 2, 2, 0, SA, 0, ONE); p1 = __builtin_amdgcn_mfma_scale_f32_32x32x64_f8f6f4(B, q8[s], p1, 2, 2, 0, SA, 0, ONE); } }
}
__device__ __forceinline__ int pk4_fp8(float a, float b, float c, float d) { int w = 0; w = __builtin_amdgcn_cvt_pk_fp8_f32(a, b, w, false); w = __builtin_amdgcn_cvt_pk_fp8_f32(c, d, w, true); return w; }
template <int D0> __device__ __forceinline__ void pv_one(f32x16& od, const char* vrow, int vd, bf16x8 pa0, bf16x8 pa1, bf16x8, bf16x8) {
  constexpr int ONE = 0x7f7f7f7f;
  const v4i_att b0 = *reinterpret_cast<const v4i_att*>(vrow + D0 * 2048), b1 = *reinterpret_cast<const v4i_att*>(vrow + D0 * 2048 + vd);
  asm volatile("s_waitcnt lgkmcnt(0)" ::: "memory"); ATT_SBAR();
  const v4i_att a0 = __builtin_bit_cast(v4i_att, pa0), a1 = __builtin_bit_cast(v4i_att, pa1);
  const v8i_att A = {a0[0], a0[1], a0[2], a0[3], a1[0], a1[1], a1[2], a1[3]}, B = {b0[0], b0[1], b0[2], b0[3], b1[0], b1[1], b1[2], b1[3]};
  asm volatile("s_nop 1\n\tv_mfma_scale_f32_32x32x64_f8f6f4 %0, %1, %2, %0, %3, %3 op_sel_hi:[0,0,0] cbsz:1" : "+v"(od) : "v"(A), "v"(B), "v"(ONE));
}
__device__ __forceinline__ void pv_rowsum_unused(f32x16& lacc, bf16x8 pa0, bf16x8 pa1, bf16x8 pa2, bf16x8 pa3) {
  const bf16x8 ones = {(short)0x3F80, (short)0x3F80, (short)0x3F80, (short)0x3F80, (short)0x3F80, (short)0x3F80, (short)0x3F80, (short)0x3F80};
  lacc = __builtin_amdgcn_mfma_f32_32x32x16_bf16(pa0, ones, lacc, 0, 0, 0); lacc = __builtin_amdgcn_mfma_f32_32x32x16_bf16(pa1, ones, lacc, 0, 0, 0);
  lacc = __builtin_amdgcn_mfma_f32_32x32x16_bf16(pa2, ones, lacc, 0, 0, 0); lacc = __builtin_amdgcn_mfma_f32_32x32x16_bf16(pa3, ones, lacc, 0, 0, 0);
}
#define ATT_CVT1(W, X, SEL) asm volatile("v_cvt_pk_u8_f32 %0, %1, " #SEL ", %0" : "+v"(W) : "v"(X))
#define ATT_CVT8(P, B, W, I) do { int c0_, c1_; asm volatile("v_cvt_pk_u8_f32 %0, %1, 0, 0" : "=v"(c0_) : "v"(P[B])); asm volatile("v_cvt_pk_u8_f32 %0, %1, 0, 0" : "=v"(c1_) : "v"(P[B + 4])); \
    ATT_CVT1(c0_, P[B + 1], 1); ATT_CVT1(c1_, P[B + 5], 1); ATT_CVT1(c0_, P[B + 2], 2); ATT_CVT1(c1_, P[B + 6], 2); ATT_CVT1(c0_, P[B + 3], 3); ATT_CVT1(c1_, P[B + 7], 3); \
    W[I] = c0_; W[I + 1] = c1_; } while (0)
#define ATT_CVT16(P, W) do { int c0_, c1_, c2_, c3_; asm volatile("v_cvt_pk_u8_f32 %0, %1, 0, 0" : "=v"(c0_) : "v"(P[0])); asm volatile("v_cvt_pk_u8_f32 %0, %1, 0, 0" : "=v"(c1_) : "v"(P[4])); \
    asm volatile("v_cvt_pk_u8_f32 %0, %1, 0, 0" : "=v"(c2_) : "v"(P[8])); asm volatile("v_cvt_pk_u8_f32 %0, %1, 0, 0" : "=v"(c3_) : "v"(P[12])); \
    ATT_CVT1(c0_, P[1], 1); ATT_CVT1(c1_, P[5], 1); ATT_CVT1(c2_, P[9], 1); ATT_CVT1(c3_, P[13], 1); ATT_CVT1(c0_, P[2], 2); ATT_CVT1(c1_, P[6], 2); ATT_CVT1(c2_, P[10], 2); ATT_CVT1(c3_, P[14], 2); \
    ATT_CVT1(c0_, P[3], 3); ATT_CVT1(c1_, P[7], 3); ATT_CVT1(c2_, P[11], 3); ATT_CVT1(c3_, P[15], 3); W[0] = c0_; W[1] = c1_; W[2] = c2_; W[3] = c3_; } while (0)
#define ATT_PVM(OD, B0, B1) do { const v8i_att B_ = {B0[0], B0[1], B0[2], B0[3], B1[0], B1[1], B1[2], B1[3]}; \
    asm volatile("s_nop 1\n\tv_mfma_scale_f32_32x32x64_f8f6f4 %0, %1, %2, %0, %3, %3 op_sel_hi:[0,0,0] cbsz:1" : "+v"(OD) : "v"(A), "v"(B_), "v"(ONE)); } while (0)
template <bool CVT>
__device__ __forceinline__ void pv_cvt(f32x16* o, f32x4& lsum, const char* vb, int vd, const v4i_att& a0, const v4i_att& a1, const f32x16& p0, const f32x16& p1, v4i_att& w0, v4i_att& w1, const v8i_att& bones) {
  constexpr int ONE = 0x7f7f7f7f;
  const v8i_att A = {a0[0], a0[1], a0[2], a0[3], a1[0], a1[1], a1[2], a1[3]};
  const v4i_att b00 = *reinterpret_cast<const v4i_att*>(vb), b01 = *reinterpret_cast<const v4i_att*>(vb + vd); ATT_SBAR();
  const v4i_att b10 = *reinterpret_cast<const v4i_att*>(vb + 2048), b11 = *reinterpret_cast<const v4i_att*>(vb + 2048 + vd);
  asm volatile("s_waitcnt lgkmcnt(2)" ::: "memory"); ATT_SBAR();
  ATT_PVM(o[0], b00, b01); ATT_SBAR();
  if constexpr (CVT) { asm volatile("s_nop 7" ::: "memory"); ATT_CVT8(p0, 0, w0, 0); }
  const v4i_att b20 = *reinterpret_cast<const v4i_att*>(vb + 4096), b21 = *reinterpret_cast<const v4i_att*>(vb + 4096 + vd);
  asm volatile("s_waitcnt lgkmcnt(2)" ::: "memory"); ATT_SBAR();
  ATT_PVM(o[1], b10, b11); ATT_SBAR();
  if constexpr (CVT) ATT_CVT8(p0, 8, w0, 2);
  const v4i_att b30 = *reinterpret_cast<const v4i_att*>(vb + 6144), b31 = *reinterpret_cast<const v4i_att*>(vb + 6144 + vd);
  asm volatile("s_waitcnt lgkmcnt(2)" ::: "memory"); ATT_SBAR();
  ATT_PVM(o[2], b20, b21); ATT_SBAR();
  if constexpr (CVT) ATT_CVT8(p1, 0, w1, 0);
  asm volatile("s_waitcnt lgkmcnt(0)" ::: "memory"); ATT_SBAR();
  ATT_PVM(o[3], b30, b31); ATT_SBAR();
  if constexpr (CVT) ATT_CVT8(p1, 8, w1, 2);
  asm volatile("s_nop 1\n\tv_mfma_scale_f32_16x16x128_f8f6f4 %0, %1, %2, %0, %3, %3 op_sel_hi:[0,0,0] cbsz:1" : "+v"(lsum) : "v"(A), "v"(bones), "v"(ONE));
  ATT_SBAR();
}
#define ATT_DSR(X, ADDR, OFF) asm volatile("ds_read_b128 %0, %1 offset:%2" : "=v"(X) : "v"(ADDR), "n"(OFF))
#define ATT_RK(F, S, ROFF) do { v4i x0_; v2i_att x1_; ATT_DSR(x0_, ka[2 * (S)] + kbo, (ROFF) * Cfg::RB); asm volatile("ds_read_b64 %0, %1 offset:%2" : "=v"(x1_) : "v"(ka[2 * (S) + 1] + kbo), "n"((ROFF) * Cfg::RB)); \
    F = (v8i){x0_[0], x0_[1], x0_[2], x0_[3], x1_[0], x1_[1], 0, 0}; ATT_SBAR(); } while (0)
#define ATT_RV(F, D) do { v4i x0_, x1_; ATT_DSR(x0_, va0 + vbo, (D) * 2048); ATT_DSR(x1_, va1 + vbo, (D) * 2048); \
    F = (v8i){x0_[0], x0_[1], x0_[2], x0_[3], x1_[0], x1_[1], x1_[2], x1_[3]}; ATT_SBAR(); } while (0)
#define ATT_LW(N) do { asm volatile("s_waitcnt lgkmcnt(" #N ")" ::: "memory"); ATT_SBAR(); } while (0)
#define ATT_QKM(PX, F, S) do { if ((S) == 0) PX = __builtin_amdgcn_mfma_scale_f32_32x32x64_f8f6f4(F, q8[S], negm, 2, 2, 0, SA, 0, ONE); else PX = __builtin_amdgcn_mfma_scale_f32_32x32x64_f8f6f4(F, q8[S], PX, 2, 2, 0, SA, 0, ONE); ATT_SBAR(); } while (0)
#define ATT_PVF(OD, F) do { asm volatile("s_nop 1\n\tv_mfma_scale_f32_32x32x64_f8f6f4 %0, %1, %2, %0, %3, %3 op_sel_hi:[0,0,0] cbsz:1" : "+v"(OD) : "v"(A), "v"(F), "v"(ONE)); ATT_SBAR(); } while (0)
#define ATT_PRE(KBN) do { const int kbo = (KBN); ATT_RK(fa, 0, 0); ATT_RK(fb, 0, 32); ATT_RK(fc, 1, 0); } while (0)
#define ATT_STEP_BODY(MID, PRE) do { constexpr int ONE = 0x7f7f7f7f; \
    const v8i A = {a0[0], a0[1], a0[2], a0[3], a1[0], a1[1], a1[2], a1[3]}; \
    ATT_SBAR(); \
    if constexpr (Cfg::NS == 2) { \
      ATT_LW(4); ATT_QKM(p0, fa, 0); ATT_RK(fa, 1, 32); \
      ATT_LW(4); ATT_QKM(p1, fb, 0); ATT_RV(fb, 0); \
      ATT_LW(4); ATT_QKM(p0, fc, 1); ATT_RV(fc, 1); \
      ATT_LW(4); ATT_QKM(p1, fa, 1); MID; ATT_RV(fa, 2); \
      ATT_LW(4); ATT_PVF(o[0], fb); asm volatile("s_nop 7" ::: "memory"); ATT_CVT16(p0, w0); ATT_RV(fb, 3); \
      ATT_LW(4); ATT_PVF(o[1], fc);  \
      ATT_LW(2); ATT_PVF(o[2], fa); ATT_CVT16(p1, w1); \
      ATT_LW(0); ATT_PVF(o[3], fb);  \
    } else { \
      ATT_LW(4); ATT_QKM(p0, fa, 0); ATT_RK(fa, 1, 32); \
      ATT_LW(4); ATT_QKM(p1, fb, 0); ATT_RK(fb, 2, 0); \
      ATT_LW(4); ATT_QKM(p0, fc, 1); ATT_RK(fc, 2, 32); \
      ATT_LW(4); ATT_QKM(p1, fa, 1); ATT_RV(fa, 0); \
      ATT_LW(4); ATT_QKM(p0, fb, 2); ATT_RV(fb, 1); \
      ATT_LW(4); ATT_QKM(p1, fc, 2); MID; ATT_RV(fc, 2); \
      ATT_LW(4); ATT_PVF(o[0], fa); asm volatile("s_nop 7" ::: "memory"); ATT_CVT16(p0, w0); ATT_RV(fa, 3); \
      ATT_LW(4); ATT_PVF(o[1], fb);  \
      ATT_LW(2); ATT_PVF(o[2], fc); ATT_CVT16(p1, w1); \
      ATT_LW(0); ATT_PVF(o[3], fa);  \
    } \
    asm volatile("s_nop 1\n\tv_mfma_scale_f32_16x16x128_f8f6f4 %0, %1, %2, %0, %3, %3 op_sel_hi:[0,0,0] cbsz:1" : "+v"(lsum) : "v"(A), "v"(bones), "v"(ONE)); ATT_SBAR(); PRE; } while (0)
#undef ATT_PVM
__device__ __forceinline__ void pv_d0(f32x16* o, const char* vb, int vd, bf16x8 pa0, bf16x8 pa1, bf16x8 pa2, bf16x8 pa3) {
  pv_one<0>(o[0], vb, vd, pa0, pa1, pa2, pa3); pv_one<1>(o[1], vb, vd, pa0, pa1, pa2, pa3); pv_one<2>(o[2], vb, vd, pa0, pa1, pa2, pa3); pv_one<3>(o[3], vb, vd, pa0, pa1, pa2, pa3);
}
__device__ __forceinline__ float pv_d0_max(f32x16* o, const char* vb, int vd, bf16x8 pa0, bf16x8 pa1, bf16x8 pa2, bf16x8 pa3, const f32x16& x0, const f32x16& x1) {
  pv_one<0>(o[0], vb, vd, pa0, pa1, pa2, pa3); const float m0 = max8(x0, 0);
  pv_one<1>(o[1], vb, vd, pa0, pa1, pa2, pa3); const float m1 = max8(x0, 8);
  pv_one<2>(o[2], vb, vd, pa0, pa1, pa2, pa3); const float m2 = max8(x1, 0);
  pv_one<3>(o[3], vb, vd, pa0, pa1, pa2, pa3); const float m3 = max8(x1, 8);
  return max2f(max3f(m0, m1, m2), m3);
}
__device__ __forceinline__ void unpack8(bf16x8 v, float* f) {
  const u32x4 w = *reinterpret_cast<const u32x4*>(&v);
#pragma unroll
  for (int k = 0; k < 4; ++k) { f[2 * k] = __uint_as_float(w[k] << 16); f[2 * k + 1] = __uint_as_float(w[k] & 0xffff0000u); }
}
__device__ __forceinline__ void rope8(float* a, float* b, const float* cs, const float* sn) {
  const f32x4 c0 = *(const f32x4*)cs, c1 = *(const f32x4*)(cs + 4), s0 = *(const f32x4*)sn, s1 = *(const f32x4*)(sn + 4);
#pragma unroll
  for (int i = 0; i < 8; ++i) { const float c = i < 4 ? c0[i & 3] : c1[i & 3], s = i < 4 ? s0[i & 3] : s1[i & 3]; const float x = a[i], y = b[i]; a[i] = x * c - y * s; b[i] = y * c + x * s; }
}

template <class Cfg, bool STATIC>
__device__ __forceinline__ void attn_unit(const bf16* __restrict__ Qn, const bf16* __restrict__ Qp, const unsigned char* __restrict__ Kh, const unsigned char* __restrict__ Vh,
                                          bf16* __restrict__ Ob, int seq, ATT_LAS unsigned char* ldsL, char* lds, int t0, const float* __restrict__ gq_n, const float* __restrict__ gq_p, const float* __restrict__ rope_tab, float mbound, int wave_in, int var = 0) {
  constexpr int DQK = Cfg::DQK, LDQ = Cfg::LDQ, LDK = Cfg::LDK, LDV = Cfg::LDV, LDO = Cfg::LDO;
  constexpr bool MSUM = Cfg::MSUM;
  constexpr int SHM_V = KVBLK * DV, SHM_K = KVBLK * Cfg::RB, NCH = Cfg::RB / 16, KPT = KVBLK * NCH / 512, NV = KPT + 1, NB = STATIC ? 4 : 3, KOFF = NB * SHM_V, NS = Cfg::NS, LDVT = Cfg::LDVT;
  int tid_; asm volatile("v_mbcnt_lo_u32_b32 %0, -1, 0\n\tv_mbcnt_hi_u32_b32 %0, -1, %0" : "=&v"(tid_)); tid_ |= wave_in << 6;
  const int tid = tid_, wid = __builtin_amdgcn_readfirstlane(tid >> 6), lane = tid & 63, r32 = lane & 31, hi = lane >> 5;
  char* V_lds = lds; char* K_lds = lds + KOFF;
  float* ws = (float*)(lds + KOFF + NB * SHM_K) + wid * 64; float* li_l = ws; float* al_l = ws + 32;
  unsigned kgo[KPT], vgo[2];
#pragma unroll
  for (int k = 0; k < KPT; ++k) { const int s = (k * 8 + wid) * 64 + lane, row = s / NCH, csw = s - row * NCH, c = csw ^ kswf<Cfg::RB>(row); kgo[k] = (unsigned)(row * LDK + (c * 16 < Cfg::KROWB ? c * 16 : 0)); }
  { const int s16 = wid * 64 + lane, d = s16 >> 2, c = (s16 & 3) ^ ((d >> 2) & 3); vgo[0] = (unsigned)(d * LDVT + c * 16); vgo[1] = 0u; }
#define ATT_ISSUE_K(b, k0) do { const char* kt_ = (const char*)Kh + (long)(k0) * LDK; asm volatile("" : "+s"(kt_));     \
    _Pragma("unroll") for (int k_ = 0; k_ < KPT; ++k_) __builtin_amdgcn_global_load_lds((const unsigned*)(kt_ + (size_t)kgo[k_]), (ATT_LAS unsigned*)(ldsL + KOFF + (b) * SHM_K + (k_ * 8 + wid) * 1024), 16, 0, 0); } while (0)
#define ATT_ISSUE_V(b, k0) do { const char* vt_ = (const char*)Vh + (k0); asm volatile("" : "+s"(vt_));        \
    __builtin_amdgcn_global_load_lds((const unsigned*)(vt_ + (size_t)vgo[0]), (ATT_LAS unsigned*)(ldsL + (b) * SHM_V + wid * 1024), 16, 0, 0); } while (0)
#define ATT_ISSUE(b, k0) do { ATT_ISSUE_K(b, k0); ATT_ISSUE_V(b, k0); } while (0)
#define ATT_WAITV_NV() do { if constexpr (NV == 2) asm volatile("s_waitcnt vmcnt(2)" ::: "memory"); else asm volatile("s_waitcnt vmcnt(3)" ::: "memory"); } while (0)
#define ATT_WAITV_2NV() do { if constexpr (NV == 2) asm volatile("s_waitcnt vmcnt(4)" ::: "memory"); else asm volatile("s_waitcnt vmcnt(6)" ::: "memory"); } while (0)
#define ATT_BAR() do { asm volatile("s_waitcnt lgkmcnt(0)" ::: "memory"); __builtin_amdgcn_s_barrier(); asm volatile("" ::: "memory"); } while (0)
  float m_reg = 0.f, l_reg = 0; f32x16 negm = {}; v8i q8[NS];
  if constexpr (STATIC) {
#pragma unroll
    for (int r = 0; r < 16; ++r) negm[r] = 4.f * (15.5f - mbound) + 60.5f; }
  {
    const bf16* qrow = Qn + (long)(wid * QBLK + r32) * LDQ;
    const bf16* prow = Qp + (long)(wid * QBLK + r32) * LDQ;
    const int t = (t0 >= 0 ? t0 : 0) + wid * QBLK + r32, pr = t >> 6, pc = t & 63; const bool do_rope = t0 >= 0;
    constexpr float CQ = Cfg::SCALE * 1.4426950408889634f * 16.f;
    float ssn = 0.f, ssp = 0.f;
#pragma unroll
    for (int s = 0; s < NS; ++s) {
#pragma unroll
      for (int c = 0; c < 4; ++c) {
        const bf16* src;
        if constexpr (Cfg::MLA) src = (s < 2 ? qrow + 64 * s + 32 * hi : prow + 32 * hi) + 8 * c;
        else src = qrow + 64 * s + 16 * hi + (c & 1) * 8 + (c >> 1) * 32;
        float f[8]; unpack8(*reinterpret_cast<const bf16x8*>(src), f); float sq = 0.f;
#pragma unroll
        for (int i = 0; i < 8; ++i) sq += f[i] * f[i];
        if (Cfg::MLA && s == 2) ssp += sq; else ssn += sq; } }
    ssn += att_shx(ssn, lane, 32); ssp += att_shx(ssp, lane, 32);
    const float rn = rsqrtf(ssn * (1.f / 128.f) + 1e-6f) * CQ, rp = rsqrtf(ssp * (1.f / 64.f) + 1e-6f) * CQ;
#define ATT_SCALE8(f, r, gp) do { const f32x4 g0_ = *(const f32x4*)(gp), g1_ = *(const f32x4*)((gp) + 4); \
      _Pragma("unroll") for (int i_ = 0; i_ < 8; ++i_) f[i_] *= (r) * (i_ < 4 ? g0_[i_ & 3] : g1_[i_ & 3]); } while (0)
#pragma unroll
    for (int s = 0; s < NS; ++s) {
      float fa0[8], fa1[8], fb0[8], fb1[8];
      if constexpr (Cfg::MLA) {
        const bf16* src = s < 2 ? qrow + 64 * s + 32 * hi : prow + 32 * hi; const float* gp = s < 2 ? gq_n + 64 * s + 32 * hi : gq_p + 32 * hi; const float r = s < 2 ? rn : rp;
        unpack8(*reinterpret_cast<const bf16x8*>(src), fa0); unpack8(*reinterpret_cast<const bf16x8*>(src + 8), fa1); unpack8(*reinterpret_cast<const bf16x8*>(src + 16), fb0); unpack8(*reinterpret_cast<const bf16x8*>(src + 24), fb1);
        ATT_SCALE8(fa0, r, gp); ATT_SCALE8(fa1, r, gp + 8); ATT_SCALE8(fb0, r, gp + 16); ATT_SCALE8(fb1, r, gp + 24);
        if (s == 2 && do_rope) { const float* cs = rope_tab; const float* sn = rope_tab + 128 * 16; const int p = hi ? pc : pr;
          rope8(fa0, fb0, cs + p * 16, sn + p * 16); rope8(fa1, fb1, cs + p * 16 + 8, sn + p * 16 + 8); }
      } else {
        const bf16* src = qrow + 64 * s + 16 * hi; const float* gp = gq_n + 64 * s + 16 * hi;
        unpack8(*reinterpret_cast<const bf16x8*>(src), fa0); unpack8(*reinterpret_cast<const bf16x8*>(src + 8), fa1); unpack8(*reinterpret_cast<const bf16x8*>(src + 32), fb0); unpack8(*reinterpret_cast<const bf16x8*>(src + 40), fb1);
        ATT_SCALE8(fa0, rn, gp); ATT_SCALE8(fa1, rn, gp + 8); ATT_SCALE8(fb0, rn, gp + 32); ATT_SCALE8(fb1, rn, gp + 40);
        if (do_rope) { const float* cs = rope_tab; const float* sn = rope_tab + 128 * 32; const int p = s ? pc : pr;
          rope8(fa0, fb0, cs + p * 32 + 16 * hi, sn + p * 32 + 16 * hi); rope8(fa1, fb1, cs + p * 32 + 16 * hi + 8, sn + p * 32 + 16 * hi + 8); }
      }
      { typedef float v16f_q __attribute__((ext_vector_type(16))); v16f_q xa, xb;
#pragma unroll
        for (int i = 0; i < 8; ++i) { xa[i] = fa0[i]; xa[8 + i] = fa1[i]; xb[i] = fb0[i]; xb[8 + i] = fb1[i]; }
        const auto r6 = __builtin_amdgcn_cvt_scalef32_2xpk16_fp6_f32(xa, xb, 1.0f);
        q8[s] = (v8i){(int)r6[0], (int)r6[1], (int)r6[2], (int)r6[3], (int)r6[4], (int)r6[5], 0, 0}; }
    }
#undef ATT_SCALE8
  }
  asm volatile("s_waitcnt vmcnt(0)" ::: "memory");
  const int NT = seq / KVBLK;
  ATT_ISSUE(0, 0); ATT_ISSUE(1, KVBLK); ATT_ISSUE(2, 2 * KVBLK);
  f32x16 o[4] = {}; f32x16 lacc = {}; f32x4 lsum = {0.f, 0.f, 0.f, 0.f}; v8i_att bones;
  { int on = (((lane >> 3) & 1) == ((lane >> 4) & 1)) ? 0x38383838 : 0; asm volatile("" : "+v"(on)); bones = (v8i_att){on, on, on, on, on, on, on, on}; }
  constexpr int SA = STATIC ? 0x7c7c7c7c : 0x7a7a7a7a;
  const int cA_ = (2 * hi) ^ ((r32 >> 2) & 3), vd0 = (cA_ & 1) ? -16 : 16;
  const char* vb0 = V_lds + r32 * 64 + (cA_ << 4);
#define ATT_QK_SCHED() do { } while (0)
#define ATT_RESC(a) do { if (__any((a) < 1.f)) { if (hi == 0) al_l[r32] = (a); asm volatile("s_nop 15\n\ts_nop 15\n\ts_waitcnt lgkmcnt(0)" ::: "memory"); \
    _Pragma("unroll") for (int r = 0; r < 16; ++r) { const float a_ = al_l[crow(r, hi)]; _Pragma("unroll") for (int d = 0; d < 4; ++d) o[d][r] *= a_; if constexpr (MSUM) lacc[r] *= a_; } } } while (0)
  if constexpr (STATIC) {
  f32x16 p0, p1; v4i_att wa0, wa1, wb0, wb1;
  unsigned ka[2 * NS];
#pragma unroll
  for (int s_ = 0; s_ < NS; ++s_) { ka[2 * s_] = (unsigned)(size_t)ldsL + KOFF + kswz8<Cfg::RB>(r32, 4 * s_ + 2 * hi); ka[2 * s_ + 1] = (unsigned)(size_t)ldsL + KOFF + kswz8<Cfg::RB>(r32, 4 * s_ + 2 * hi + 1); }
  const unsigned va0 = (unsigned)(size_t)ldsL + r32 * 64 + (cA_ << 4), va1 = va0 + vd0;
  v8i fa, fb, fc;
#define ATT_BARX() do { __builtin_amdgcn_s_barrier(); asm volatile("" ::: "memory"); } while (0)
  ATT_WAITV_NV(); ATT_BAR();
  ATT_ISSUE_K(3, 3 * KVBLK);
  qkt<Cfg, SA>(p0, p1, K_lds, q8, negm, r32, hi);
  ATT_SBAR(); asm volatile("s_nop 15\n\ts_nop 15" ::: "memory"); ATT_SBAR();
  ATT_CVT8(p0, 0, wa0, 0); ATT_CVT8(p0, 8, wa0, 2); ATT_CVT8(p1, 0, wa1, 0); ATT_CVT8(p1, 8, wa1, 2);
  ATT_SBAR(); ATT_PRE(SHM_K);
  ATT_WAITV_NV(); ATT_BARX();
#define ATT_SSTEP(j, WP0, WP1, WC0, WC1) do { \
    if ((j) + 3 < NT) { ATT_ISSUE_K(((j) + 3) & 3, ((j) + 3) * KVBLK); } \
    { const int kbo = ((j) & 3) * SHM_K, vbo = (((j) - 1) & 3) * SHM_V, kbn = (((j) + 1) & 3) * SHM_K; const v4i_att& a0 = WP0; const v4i_att& a1 = WP1; v4i_att& w0 = WC0; v4i_att& w1 = WC1; \
      ATT_STEP_BODY(if ((j) + 2 < NT) { ATT_ISSUE_V(((j) + 2) & 3, ((j) + 2) * KVBLK); }, ATT_PRE(kbn)); } \
    if ((j) + 3 < NT) ATT_WAITV_NV(); else if ((j) + 2 < NT) asm volatile("s_waitcnt vmcnt(1)" ::: "memory"); else asm volatile("s_waitcnt vmcnt(0)" ::: "memory"); \
    ATT_BARX(); } while (0)
  for (int j = 1; j + 1 < NT; j += 2) {
    ATT_SSTEP(j, wa0, wa1, wb0, wb1);
    ATT_SSTEP(j + 1, wb0, wb1, wa0, wa1);
  }
  { const int kbo = ((NT - 1) & 3) * SHM_K, vbo = ((NT - 2) & 3) * SHM_V;
    { const v4i_att& a0 = wa0; const v4i_att& a1 = wa1; v4i_att& w0 = wb0; v4i_att& w1 = wb1;
      ATT_STEP_BODY((void)0, (void)0); }
    pv_cvt<false>(o, lsum, vb0 + ((NT - 1) & 3) * SHM_V, vd0, wb0, wb1, p0, p1, wa0, wa1, bones);
    ATT_SBAR(); asm volatile("s_nop 15\n\ts_nop 15" ::: "memory"); ATT_SBAR(); }
#undef ATT_BARX
#undef ATT_SSTEP
  } else {
  f32x16 pA0, pA1, pB0, pB1; float alA, alB; bf16x8 pa0, pa1, pa2, pa3;
  ATT_WAITV_2NV(); ATT_BAR();
  qkt<Cfg, SA>(pA0, pA1, K_lds, q8, negm, r32, hi); alA = 1.f; alB = 1.f; if constexpr (!STATIC) decideSM<true>(pA0, pA1, max2f(max3f(max8(pA0, 0), max8(pA0, 8), max8(pA1, 0)), max8(pA1, 8)), m_reg, negm, alA);
  ATT_WAITV_NV(); ATT_BAR();
  int bc = 1;
#define ATT_FIN(Y0, Y1, alY) do { if constexpr (STATIC) finishU8(Y0, Y1, pa0, pa1); else finishSM<true>(Y0, Y1, alY, l_reg, pa0, pa1, pa2, pa3); } while (0)
#define ATT_STEP(j, X0, X1, mnX, alX, Y0, Y1, alY) do { const int bp = bc == 0 ? 2 : bc - 1, bn = bc == 2 ? 0 : bc + 1; \
    ATT_SBAR(); qkt<Cfg, SA>(X0, X1, K_lds + bc * SHM_K, q8, negm, r32, hi); \
    ATT_FIN(Y0, Y1, alY); ATT_QK_SCHED(); ATT_SBAR(); \
    if ((j) >= 2 && (j) + 1 < NT) { ATT_ISSUE_V(bn, ((j) + 1) * KVBLK); }     \
    {  if constexpr (STATIC) { pv_d0(o, vb0 + bp * SHM_V, vd0, pa0, pa1, pa2, pa3); rowsum16(lsum, pa0, pa1, bones); } else { const float pm_ = pv_d0_max(o, vb0 + bp * SHM_V, vd0, pa0, pa1, pa2, pa3, X0, X1); decideSM<false>(X0, X1, pm_, m_reg, negm, alX); } } \
    if ((j) + 2 < NT) asm volatile("s_waitcnt vmcnt(1)" ::: "memory"); else asm volatile("s_waitcnt vmcnt(0)" ::: "memory");     \
    ATT_BAR();                                              \
    if ((j) + 2 < NT) { ATT_ISSUE_K(bp, ((j) + 2) * KVBLK); } \
    if constexpr (!STATIC) { ATT_RESC(alX); } bc = bn; } while (0)
  for (int j = 1; j + 1 < NT; j += 2) {
    ATT_STEP(j, pB0, pB1, mnB, alB, pA0, pA1, alA);
    ATT_STEP(j + 1, pA0, pA1, mnA, alA, pB0, pB1, alB);
  }
  { const int bp = bc == 0 ? 2 : bc - 1;
    ATT_SBAR(); qkt<Cfg, SA>(pB0, pB1, K_lds + bc * SHM_K, q8, negm, r32, hi);
    ATT_FIN(pA0, pA1, alA); ATT_SBAR();
    {  if constexpr (STATIC) { pv_d0(o, vb0 + bp * SHM_V, vd0, pa0, pa1, pa2, pa3); rowsum16(lsum, pa0, pa1, bones); } else { const float pm_ = pv_d0_max(o, vb0 + bp * SHM_V, vd0, pa0, pa1, pa2, pa3, pB0, pB1); decideSM<false>(pB0, pB1, pm_, m_reg, negm, alB); } }
    if constexpr (!STATIC) { ATT_RESC(alB); }
    ATT_FIN(pB0, pB1, alB); ATT_SBAR();
    pv_d0(o, vb0 + bc * SHM_V, vd0, pa0, pa1, pa2, pa3); if constexpr (STATIC) rowsum16(lsum, pa0, pa1, bones); ATT_SBAR(); asm volatile("s_nop 15\n\ts_nop 15" ::: "memory"); ATT_SBAR(); }
  }
  float rli[16];
  if constexpr (MSUM) {
#pragma unroll
    for (int r = 0; r < 16; ++r) rli[r] = __builtin_amdgcn_rcpf(lacc[r]);
  } else { if constexpr (STATIC) { if ((lane & 7) == 0) { float* dl = li_l + ((lane & 8) ? 16 : 0) + 4 * (lane >> 4); dl[0] = lsum[0]; dl[1] = lsum[1]; dl[2] = lsum[2]; dl[3] = lsum[3]; } }
    else { if (hi == 0) li_l[r32] = l_reg; }
    asm volatile("s_waitcnt lgkmcnt(0)" ::: "memory");
#pragma unroll
    for (int r = 0; r < 16; ++r) rli[r] = __builtin_amdgcn_rcpf(li_l[crow(r, hi)]); }
  bf16* Ow = Ob + (long)(wid * QBLK) * LDO;
  const int odd = lane & 1;
#pragma unroll
  for (int r = 0; r < 16; r += 2) {
#pragma unroll
    for (int d0 = 0; d0 < 4; ++d0) {
      const float v0 = o[d0][r] * rli[r], v1 = o[d0][r + 1] * rli[r + 1];
      const float snd = odd ? v0 : v1, rcv = att_shx(snd, lane, 1);
      const unsigned w = odd ? cvtpk(rcv, v1) : cvtpk(v0, rcv);
      const int orow = crow(odd ? r + 1 : r, hi);
      *reinterpret_cast<unsigned*>(Ow + (long)orow * LDO + d0 * 32 + (r32 & ~1)) = w; } }
  ATT_BAR();
#undef ATT_ISSUE
#undef ATT_WAITV_NV
#undef ATT_WAITV_2NV
#undef ATT_BAR
#undef ATT_RESC
#undef ATT_STEP
#undef ATT_FIN
#undef ATT_CVT8
#undef ATT_CVT16
#undef ATT_RK
#undef ATT_DSR
#undef ATT_LW
#undef ATT_RV
#undef ATT_QKM
#undef ATT_PVF
#undef ATT_STEP_BODY
#undef ATT_PRE
#undef ATT_CVT1
}
}

constexpr int D = 2048, BATCH = 2, SEQ = 8192, CTX = 256, DEPTH = 4, DFF = 5632;
constexpr int SB = SEQ + CTX;
constexpr int R = BATCH * SB;
constexpr int NMOD = 6 * D;
constexpr float EPS = 1e-6f;
constexpr int NWAVES = 8;
constexpr int PH_PER_LAYER = 11, N_PHASES = 1 + DEPTH * PH_PER_LAYER;

constexpr size_t MiB = 1u << 20;
constexpr size_t WS_CTL = 0, CTL_ZERO_BYTES = 1 * MiB;
constexpr size_t WS_MOD = 1 * MiB;
constexpr size_t WS_ROPE = 2 * MiB;
constexpr size_t WS_W = 4 * MiB;
constexpr size_t SZ_W1 = (size_t)1280 * 2048 * 2, SZ_WUQ = (size_t)3072 * 512 * 2, SZ_WUKV = (size_t)4096 * 512 * 2, SZ_WO = (size_t)2048 * 2048 * 2;
constexpr size_t SZ_WQKV = (size_t)3072 * 2048 * 2, SZ_WUP = (size_t)11264 * 2048 * 2, SZ_WDN = (size_t)2048 * 5632 * 2;
constexpr size_t SZ_MLA = SZ_W1 + SZ_WUQ + SZ_WUKV + SZ_WO, SZ_GQA = SZ_WQKV + SZ_WO, SZ_FFN = SZ_WUP + SZ_WDN;
constexpr size_t WS_WMLA = WS_W, WS_WGQA = WS_WMLA + 2 * SZ_MLA, WS_WFFN = WS_WGQA + 2 * SZ_GQA, WS_WEND = WS_WFFN + 4 * SZ_FFN;
static_assert(WS_WEND <= 376 * MiB, "weights");
constexpr size_t WS_X = 376 * MiB;
constexpr size_t WS_H = 508 * MiB;
constexpr size_t WS_BIG = 576 * MiB;
constexpr size_t WS_U = WS_BIG;
constexpr size_t WS_GH = WS_BIG, WS_VH = WS_BIG + 24 * MiB;
constexpr size_t WS_ACT = 940 * MiB;
constexpr size_t WS_RAW1 = WS_BIG;
constexpr size_t WS_CQ = 660 * MiB, WS_CKV = 677 * MiB, WS_KPE = 694 * MiB;
constexpr size_t WS_QRAW = 700 * MiB;
constexpr size_t WS_KVRAW = 800 * MiB;
constexpr size_t WS_KMLA = 932 * MiB;
constexpr size_t WS_QKV = WS_BIG;
constexpr size_t WS_KGQA = 676 * MiB;
constexpr size_t WS_OGQA = 700 * MiB;
constexpr size_t WS_END = 1124 * MiB;
static_assert(WS_X + (size_t)R * D * 4 <= WS_H && WS_H + (size_t)R * D * 2 <= WS_BIG && WS_GH + (size_t)264 * 4 * 5632 * 4 <= WS_VH && WS_VH + (size_t)264 * 2 * 5632 * 4 <= WS_ACT && WS_ACT + (size_t)R * DFF * 2 <= WS_END, "ws map 1");
static_assert(WS_RAW1 + (size_t)R * 1280 * 4 <= WS_CQ && WS_CQ + (size_t)R * 512 * 2 <= WS_CKV && WS_CKV + (size_t)R * 512 * 2 <= WS_KPE && WS_KPE + (size_t)R * 64 * 2 <= WS_QRAW, "ws map 2");
static_assert(WS_QRAW + (size_t)R * 3072 * 2 <= WS_KVRAW && WS_KVRAW + (size_t)R * 4096 * 2 <= WS_KMLA && WS_KMLA + (size_t)R * 3072 * 2 <= WS_END, "ws map 3");
static_assert(WS_QKV + (size_t)R * 3072 * 2 <= WS_KGQA && WS_KGQA + (size_t)R * 512 * 2 <= WS_OGQA && WS_OGQA + (size_t)R * 2048 * 2 <= WS_END, "ws map 4");
constexpr size_t WS_PART = 800 * MiB;
constexpr int NSPLIT_WO = 8, NSPLIT_DN = 11;
constexpr size_t WS_CB = 352 * MiB;
constexpr size_t WS_STAT = 354 * MiB;
constexpr size_t WS_AV = 355 * MiB;
constexpr size_t WS_W8GQA = 360 * MiB, SZ_W8GQA = (size_t)3072 * 2048;
constexpr size_t WS_V8T_MLA = 990 * MiB, WS_V8T_GQA = 780 * MiB;
constexpr size_t WS_XS8 = 720 * MiB;
constexpr int CBN = 11264;
static_assert(WS_KMLA + (size_t)R * 3072 <= WS_V8T_MLA && WS_V8T_MLA + (size_t)2 * 16 * 128 * 8448 <= WS_END && WS_OGQA + (size_t)R * 2048 * 2 <= WS_V8T_GQA && WS_V8T_GQA + (size_t)2 * 4 * 128 * 8448 <= WS_PART, "ws map 7");
static_assert(WS_W8GQA + 2 * SZ_W8GQA <= WS_X && WS_XS8 + (size_t)R * 2048 <= WS_PART, "ws map 6");
static_assert(WS_WEND <= WS_CB && WS_CB + (size_t)8 * 3 * CBN * 4 <= WS_STAT && WS_STAT + (size_t)8 * R * 4 <= WS_AV && WS_AV + (size_t)8 * 3 * D * 4 <= WS_X, "ws map 5");
constexpr int CW_BAR = 4096;

constexpr int RING_OFF = 0, RING_BYTES = 131072;
constexpr int LDSCTL_OFF = RING_BYTES, MISC_OFF = LDSCTL_OFF + 320;
constexpr int LDS_BYTES = 147456;

struct Args {
    const float* in[28]; float* out; unsigned char* ws; int ph_lo, ph_hi, var;
};

struct Frame {
    LAS unsigned char* lds; char* ldsg;
    int tid, lane, wave, G, gw, NGW, bid;
};

__device__ __forceinline__ float shx(float v, int lane, int o) { return __builtin_bit_cast(float, __builtin_amdgcn_ds_bpermute((lane ^ o) << 2, __builtin_bit_cast(int, v))); }
__device__ __forceinline__ float wave_sum(float v, int lane) {
#pragma unroll
    for (int o = 1; o < 64; o <<= 1) v += shx(v, lane, o);
    return v;
}
__device__ __forceinline__ float sum16(float v, int lane) {
#pragma unroll
    for (int o = 1; o < 16; o <<= 1) v += shx(v, lane, o);
    return v;
}
__device__ __forceinline__ unsigned pk2(float lo, float hi) { unsigned r; asm volatile("v_cvt_pk_bf16_f32 %0, %1, %2" : "=v"(r) : "v"(lo), "v"(hi)); return r; }
__device__ __forceinline__ float bf_lo(unsigned w) { return __uint_as_float(w << 16); }
__device__ __forceinline__ float bf_hi(unsigned w) { return __uint_as_float(w & 0xffff0000u); }
__device__ __forceinline__ float silu_f(float x) { return x / (1.f + __expf(-x)); }

__device__ __forceinline__ unsigned pk4f8(float a, float b, float c, float d) { int w = 0; w = __builtin_amdgcn_cvt_pk_fp8_f32(a, b, w, false); w = __builtin_amdgcn_cvt_pk_fp8_f32(c, d, w, true); return (unsigned)w; }
constexpr float W8_SCALE = 64.0f; constexpr int W8_E8M0 = 0x79797979;
__device__ __forceinline__ void transpose_item(const float* W, int K, int N, bf16* WT, int drow0, int k0, int n0, LAS float* scr, int lane, const float* shv, float* cacc, int f8 = 0, unsigned char* WT8 = nullptr) {
    { f32x4 r[8]; const int kr = lane >> 3, n4 = (lane & 7) * 4;
#pragma unroll
      for (int i = 0; i < 8; ++i) r[i] = *(const f32x4*)(W + (size_t)(k0 + 8 * i + kr) * N + n0 + n4);
      asm volatile("" ::: "memory");
#pragma unroll
      for (int i = 0; i < 8; ++i) { LAS float* d = scr + (8 * i + kr) * 33 + n4; d[0] = r[i].x; d[1] = r[i].y; d[2] = r[i].z; d[3] = r[i].w; } }
    LDS_WAIT(); asm volatile("" ::: "memory");
    const int c = lane & 7;
#pragma unroll
    for (int j = 0; j < 4; ++j) { const int n = (lane >> 3) + 8 * j; const LAS float* s = scr + (8 * c) * 33 + n;
        v4u o; o.x = pk2(s[0 * 33], s[1 * 33]); o.y = pk2(s[2 * 33], s[3 * 33]); o.z = pk2(s[4 * 33], s[5 * 33]); o.w = pk2(s[6 * 33], s[7 * 33]);
        if (f8) { v2u o8; o8.x = pk4f8(s[0 * 33] * W8_SCALE, s[1 * 33] * W8_SCALE, s[2 * 33] * W8_SCALE, s[3 * 33] * W8_SCALE); o8.y = pk4f8(s[4 * 33] * W8_SCALE, s[5 * 33] * W8_SCALE, s[6 * 33] * W8_SCALE, s[7 * 33] * W8_SCALE);
            *(v2u*)((f8 == 2 ? WT8 : (unsigned char*)WT) + (size_t)(drow0 + n) * K + k0 + 8 * c) = o8; }
        if (f8 != 1) *(v4u*)(WT + (size_t)(drow0 + n) * K + k0 + 8 * c) = o; }
    if (shv) {
        const float s0 = shv[k0 + lane], s1 = shv[NMOD + k0 + lane], s2 = shv[2 * NMOD + k0 + lane];
        const int n = lane & 31; float a0 = 0.f, a1 = 0.f, a2 = 0.f;
#pragma unroll 4
        for (int kk = 0; kk < 64; ++kk) { const float w = scr[kk * 33 + n];
            a0 = fmaf(__builtin_bit_cast(float, __builtin_amdgcn_readlane(__builtin_bit_cast(int, s0), kk)), w, a0);
            a1 = fmaf(__builtin_bit_cast(float, __builtin_amdgcn_readlane(__builtin_bit_cast(int, s1), kk)), w, a1);
            a2 = fmaf(__builtin_bit_cast(float, __builtin_amdgcn_readlane(__builtin_bit_cast(int, s2), kk)), w, a2); }
        if (lane < 32) { float* cp = cacc + drow0 + n; unsafeAtomicAdd(cp, a0); unsafeAtomicAdd(cp + CBN, a1); unsafeAtomicAdd(cp + 2 * CBN, a2); }
    }
    LDS_WAIT(); asm volatile("" ::: "memory");
}
__device__ __forceinline__ int dest_row(int mode, int roff, int n0) {
    if (mode == 1) { const int h = n0 / 192, d = n0 - h * 192; return d < 128 ? h * 128 + d : 2048 + h * 64 + (d - 128); }
    if (mode == 2) { const int h = n0 >> 8, d = n0 & 255; return d < 128 ? h * 128 + d : 2048 + h * 128 + (d - 128); }
    if (mode == 3) { const int f = n0 < 5632 ? n0 : n0 - 5632; return (f >> 7) * 256 + (f & 127) + (n0 < 5632 ? 0 : 128); }
    return roff + n0;
}
__device__ __forceinline__ void transpose_matrix(const Frame& F, const float* W, int K, int N, bf16* WT, int mode, int roff, int rot, const float* shv = nullptr, float* cacc = nullptr, int f8 = 0, unsigned char* WT8 = nullptr) {
    LAS float* scr = (LAS float*)(F.lds + RING_OFF + F.wave * 16384);
    const int nblk = N / 32, items = (K / 64) * nblk;
    int g = F.gw + rot; if (g >= F.NGW) g -= F.NGW;
    for (int it = g; it < items; it += F.NGW) { const int kb = it / nblk, nb = it - kb * nblk; transpose_item(W, K, N, WT, dest_row(mode, roff, nb * 32), kb * 64, nb * 32, scr, F.lane, shv, cacc, f8, WT8); }
}

typedef const __attribute__((address_space(4))) Args* KargPtr0;
__device__ __forceinline__ void p0a_prologue(const Frame& F, KargPtr0 ap) {
    unsigned char* ws = ap->ws;
    __syncthreads();
    {
        LAS float* S = (LAS float*)(F.lds + RING_OFF);
        LAS float* P = (LAS float*)(F.lds + RING_OFF + 24576);
        for (int i = F.tid; i < 3 * D; i += 512) { const int v = i / D, k = i - v * D; const float x = v < 2 ? ap->in[1][v * D + k] : ap->in[3][k]; S[i] = silu_f(x); }
        __syncthreads();
        for (int u = F.bid; u < 256; u += F.G) {
            const int l = u >> 6, n0 = (u & 63) * 192;
            const float* Wl = ap->in[4] + (size_t)l * D * NMOD + n0 + 4 * F.lane;
            f32x4 acc0 = {0.f, 0.f, 0.f, 0.f}, acc1 = acc0, acc2 = acc0;
            if (F.lane < 48) {
                const int kb = F.wave * 256;
#pragma unroll 8
                for (int k = 0; k < 256; ++k) { const f32x4 w = *(const f32x4*)(Wl + (size_t)(kb + k) * NMOD); acc0 += w * S[kb + k]; acc1 += w * S[D + kb + k]; acc2 += w * S[2 * D + kb + k]; }
#pragma unroll
                for (int j = 0; j < 4; ++j) { P[(F.wave * 3 + 0) * 192 + 4 * F.lane + j] = acc0[j]; P[(F.wave * 3 + 1) * 192 + 4 * F.lane + j] = acc1[j]; P[(F.wave * 3 + 2) * 192 + 4 * F.lane + j] = acc2[j]; }
            }
            __syncthreads();
            for (int i = F.tid; i < 576; i += 512) { const int v = i / 192, n = i - v * 192; float s = ap->in[5][(size_t)l * NMOD + n0 + n];
#pragma unroll
                for (int w = 0; w < 8; ++w) s += P[(w * 3 + v) * 192 + n];
                ((float*)(ws + WS_MOD))[(size_t)(l * 3 + v) * NMOD + n0 + n] = s; }
            __syncthreads();
        }
    }
    {
        float* T = (float*)(ws + WS_ROPE);
        for (int i = F.bid * 512 + F.tid; i < 128 * 16 + 128 * 32; i += F.G * 512) {
            int p, j, ad, base; if (i < 128 * 16) { p = i >> 4; j = i & 15; ad = 32; base = 0; } else { const int q = i - 128 * 16; p = q >> 5; j = q & 31; ad = 64; base = 2 * 128 * 16; }
            const float e = -(float)(2 * j) / (float)ad, inv = powf(10000.0f, e), ang = (float)p * inv;
            const int J = ad / 2;
            T[base + p * J + j] = cosf(ang); T[base + 128 * J + p * J + j] = sinf(ang);
        }
    }
    { const int gt = F.bid * 512 + F.tid, NT_ = F.G * 512; const v4u z = {0u, 0u, 0u, 0u};
      for (int i = gt; i < 8 * R / 4; i += NT_) ((v4u*)(ws + WS_STAT))[i] = z;
      for (int i = gt; i < 8 * 3 * CBN / 4; i += NT_) ((v4u*)(ws + WS_CB))[i] = z;
      for (int j = 0; j < 2; ++j) { bf16* w1 = (bf16*)(ws + WS_WMLA + j * SZ_MLA); for (int i = gt; i < 192 * 2048 / 8; i += NT_) *(v4u*)(w1 + (size_t)1088 * 2048 + (size_t)i * 8) = z; } }
}
__device__ __forceinline__ void p0b_prologue(const Frame& F, KargPtr0 ap, bool dummy_cb = false) {
    unsigned char* ws = ap->ws;
    const float* MOD = (const float*)(ws + WS_MOD);
    __syncthreads();
    for (int i = F.bid * 512 + F.tid; i < 8 * 3 * D; i += F.G * 512) { const int sl = i / (3 * D), r = i - sl * 3 * D, v = r / D, k = r - v * D, layer = sl >> 1, sub = sl & 1;
        const float g = (sub ? ap->in[7] : ap->in[6])[layer * D + k], sc = MOD[(size_t)(layer * 3 + v) * NMOD + (sub ? 4 : 1) * D + k];
        ((float*)(ws + WS_AV))[i] = g * (1.f + sc); }
    for (int row = F.gw; row < R; row += F.NGW) {
        const int b = row / SB, t = row - b * SB, v = t >= SEQ ? 2 : b;
        const float* src = t < SEQ ? ap->in[0] + ((size_t)b * SEQ + t) * D : ap->in[2] + ((size_t)b * CTX + (t - SEQ)) * D;
        float* dst = (float*)(ws + WS_X) + (size_t)row * D; bf16* xs = (bf16*)(ws + WS_H) + (size_t)row * D;
        const float* gn = ap->in[6]; const float* sc = MOD + (size_t)v * NMOD + D;
        float ss = 0.f;
#pragma unroll
        for (int j = 0; j < 8; ++j) { const int c = 4 * F.lane + 256 * j; const f32x4 x = *(const f32x4*)(src + c); *(f32x4*)(dst + c) = x;
            ss += (x.x * x.x + x.y * x.y) + (x.z * x.z + x.w * x.w);
            const f32x4 y = x * *(const f32x4*)(gn + c) * (*(const f32x4*)(sc + c) + 1.f);
            v2u o; o.x = pk2(y.x, y.y); o.y = pk2(y.z, y.w); *(v2u*)(xs + c) = o; }
        ss = wave_sum(ss, F.lane);
        if (F.lane == 0) ((float*)(ws + WS_STAT))[row] = ss;
    }
    __syncthreads();
    float* CB = (float*)(ws + (dummy_cb ? WS_ACT : WS_CB));
    int rot = 0;
    for (int j = 0; j < 2; ++j) { const int layer = 2 * j;
        bf16* w1 = (bf16*)(ws + WS_WMLA + j * SZ_MLA); bf16* wuq = (bf16*)((unsigned char*)w1 + SZ_W1); bf16* wukv = (bf16*)((unsigned char*)wuq + SZ_WUQ); bf16* wo = (bf16*)((unsigned char*)wukv + SZ_WUKV);
        const float* shv = MOD + (size_t)layer * 3 * NMOD; float* cacc = CB + (size_t)(2 * layer) * 3 * CBN;
        transpose_matrix(F, ap->in[8] + (size_t)j * 2048 * 512, 2048, 512, w1, 0, 0, rot, shv, cacc); rot = (rot + 512) % F.NGW;
        transpose_matrix(F, ap->in[13] + (size_t)j * 2048 * 576, 2048, 576, w1, 0, 512, rot, shv, cacc); rot = (rot + 576) % F.NGW;
        transpose_matrix(F, ap->in[10] + (size_t)j * 512 * 3072, 512, 3072, wuq, 1, 0, rot, nullptr, nullptr, 1); rot = (rot + 768) % F.NGW;
        transpose_matrix(F, ap->in[16] + (size_t)j * 512 * 4096, 512, 4096, wukv, 2, 0, rot); rot = (rot + 1024) % F.NGW;
        transpose_matrix(F, ap->in[18] + (size_t)j * 2048 * 2048, 2048, 2048, wo, 0, 0, rot);
    }
    for (int j = 0; j < 2; ++j) { const int layer = 2 * j + 1;
        bf16* wqkv = (bf16*)(ws + WS_WGQA + j * SZ_GQA); bf16* wo = (bf16*)((unsigned char*)wqkv + SZ_WQKV);
        const float* shv = MOD + (size_t)layer * 3 * NMOD; float* cacc = CB + (size_t)(2 * layer) * 3 * CBN;
        unsigned char* w8 = ws + WS_W8GQA + j * SZ_W8GQA;
        transpose_matrix(F, ap->in[19] + (size_t)j * 2048 * 2048, 2048, 2048, wqkv, 0, 0, rot, shv, cacc, 2, w8);
        transpose_matrix(F, ap->in[21] + (size_t)j * 2048 * 1024, 2048, 1024, wqkv, 0, 2048, rot, shv, cacc, 2, w8);
        transpose_matrix(F, ap->in[23] + (size_t)j * 2048 * 2048, 2048, 2048, wo, 0, 0, rot);
    }
    for (int l = 0; l < 4; ++l) {
        bf16* wup = (bf16*)(ws + WS_WFFN + l * SZ_FFN); bf16* wdn = (bf16*)((unsigned char*)wup + SZ_WUP);
        transpose_matrix(F, ap->in[24] + (size_t)l * 2048 * 11264, 2048, 11264, wup, 3, 0, rot, MOD + (size_t)l * 3 * NMOD + 3 * D, CB + (size_t)(2 * l + 1) * 3 * CBN);
        transpose_matrix(F, ap->in[27] + (size_t)l * 5632 * 2048, 5632, 2048, wdn, 0, 0, rot);
    }
}

__device__ __forceinline__ void ctx_finalize_phase(const Frame& F, float* X, bf16* XS, float* stat, const float* av, const float* P, int nsplit, unsigned char* XS8) {
    LAS float* red = (LAS float*)(F.lds + RING_OFF);
    for (int pr = F.bid; pr < CTX; pr += F.G) {
        const int q = pr * 2 + (F.wave >> 2), b = q >> 8, row = b * SB + SEQ + (q & 255), c0 = (F.wave & 3) * 512 + 4 * F.lane;
        const float* a = av + 2 * D;
        float* xr = X + (size_t)row * D + c0;
        f32x4 x0 = *(const f32x4*)xr, x1 = *(const f32x4*)(xr + 256);
        for (int s = 0; s < nsplit; ++s) { const float* pp = P + ((size_t)s * 512 + q) * D + c0; x0 += *(const f32x4*)pp; x1 += *(const f32x4*)(pp + 256); }
        *(f32x4*)xr = x0; *(f32x4*)(xr + 256) = x1;
        const float ssw = wave_sum((x0.x * x0.x + x0.y * x0.y) + (x0.z * x0.z + x0.w * x0.w) + (x1.x * x1.x + x1.y * x1.y) + (x1.z * x1.z + x1.w * x1.w), F.lane);
        if (F.lane == 0) red[F.wave] = ssw;
        const f32x4 y0 = x0 * *(const f32x4*)(a + c0), y1 = x1 * *(const f32x4*)(a + c0 + 256);
        bf16* hr = XS + (size_t)row * D + c0;
        v2u o0, o1; o0.x = pk2(y0.x, y0.y); o0.y = pk2(y0.z, y0.w); o1.x = pk2(y1.x, y1.y); o1.y = pk2(y1.z, y1.w);
        *(v2u*)hr = o0; *(v2u*)(hr + 256) = o1;
        if (XS8) { unsigned char* h8 = XS8 + (size_t)row * D + c0; *(unsigned*)h8 = pk4f8(y0.x, y0.y, y0.z, y0.w); *(unsigned*)(h8 + 256) = pk4f8(y1.x, y1.y, y1.z, y1.w); }
        __syncthreads();
        if ((F.wave & 3) == 0 && F.lane == 0) { const int w0 = F.wave; stat[row] = (red[w0] + red[w0 + 1]) + (red[w0 + 2] + red[w0 + 3]); }
        __syncthreads();
    }
}
__device__ __forceinline__ void mla_norm_phase(const Frame& F, const float* RAW, bf16* CQ, bf16* CKV, bf16* KPE, const float* g_dq, const float* g_dkv, const float* g_kpe, const float* ropeM) {
    for (int row = F.gw; row < R; row += F.NGW) {
        const int b = row / SB, t = row - b * SB;
        const float* rr = RAW + (size_t)row * 1280;
#pragma unroll
        for (int part = 0; part < 2; ++part) {
            const float* src = rr + part * 512 + 4 * F.lane; const float* g = (part ? g_dkv : g_dq) + 4 * F.lane; bf16* dst = (part ? CKV : CQ) + (size_t)row * 512 + 4 * F.lane;
            const f32x4 a0 = *(const f32x4*)src, a1 = *(const f32x4*)(src + 256);
            const float ss = wave_sum((a0.x * a0.x + a0.y * a0.y) + (a0.z * a0.z + a0.w * a0.w) + (a1.x * a1.x + a1.y * a1.y) + (a1.z * a1.z + a1.w * a1.w), F.lane);
            const float r = rsqrtf(ss * (1.f / 512.f) + EPS);
            const f32x4 y0 = a0 * r * *(const f32x4*)g, y1 = a1 * r * *(const f32x4*)(g + 256);
            if (part) { v2u o0, o1; o0.x = pk2(y0.x, y0.y); o0.y = pk2(y0.z, y0.w); o1.x = pk2(y1.x, y1.y); o1.y = pk2(y1.z, y1.w); *(v2u*)dst = o0; *(v2u*)(dst + 256) = o1; }
            else { unsigned char* d8 = (unsigned char*)CQ + (size_t)row * 512 + 4 * F.lane;
                *(unsigned*)d8 = pk4f8(y0.x, y0.y, y0.z, y0.w); *(unsigned*)(d8 + 256) = pk4f8(y1.x, y1.y, y1.z, y1.w); }
        }
        const int e = F.lane; const float x = rr[1024 + e];
        const float r = rsqrtf(wave_sum(x * x, F.lane) * (1.f / 64.f) + EPS);
        float y = x * r * g_kpe[e];
        const float yp = shx(y, F.lane, 16);
        if (t < SEQ) { const int j = e & 15, p = e < 32 ? (t >> 6) : (t & 63); const float c = ropeM[p * 16 + j], s = ropeM[128 * 16 + p * 16 + j];
            y = (e & 16) ? (y * c + yp * s) : (y * c - yp * s); }
        KPE[(size_t)row * 64 + e] = (bf16)(pk2(y, y) & 0xffffu);
    }
}
typedef float v16f_t __attribute__((ext_vector_type(16)));
typedef unsigned v6u_t __attribute__((ext_vector_type(6)));
constexpr float K6_SCALE = 2.0f;
__device__ __forceinline__ void st24(unsigned char* dst, const v6u_t& o) { v4u a; a.x = o[0]; a.y = o[1]; a.z = o[2]; a.w = o[3]; v2u b; b.x = o[4]; b.y = o[5]; *(v4u*)dst = a; *(v2u*)(dst + 16) = b; }
__device__ __forceinline__ void unpack16(const bf16* src, v16f_t& f) { const v4u w0 = *(const v4u*)src, w1 = *(const v4u*)(src + 8);
    f[0] = bf_lo(w0.x); f[1] = bf_hi(w0.x); f[2] = bf_lo(w0.y); f[3] = bf_hi(w0.y); f[4] = bf_lo(w0.z); f[5] = bf_hi(w0.z); f[6] = bf_lo(w0.w); f[7] = bf_hi(w0.w);
    f[8] = bf_lo(w1.x); f[9] = bf_hi(w1.x); f[10] = bf_lo(w1.y); f[11] = bf_hi(w1.y); f[12] = bf_lo(w1.z); f[13] = bf_hi(w1.z); f[14] = bf_lo(w1.w); f[15] = bf_hi(w1.w); }
__device__ __forceinline__ void mla_kbuild_phase(const Frame& F, const bf16* KVRAW, const bf16* KPE, unsigned char* K, const float* g_kn) {
    const int h = F.lane >> 2, blk = F.lane & 3;
    v16f_t ga, gb;
#pragma unroll
    for (int i = 0; i < 16; ++i) { ga[i] = g_kn[32 * blk + i]; gb[i] = g_kn[32 * blk + 16 + i]; }
    for (int row = F.gw; row < R; row += F.NGW) {
        v16f_t fa, fb; unpack16(KVRAW + (size_t)row * 4096 + h * 128 + 32 * blk, fa); unpack16(KVRAW + (size_t)row * 4096 + h * 128 + 32 * blk + 16, fb);
        float ss = 0.f;
#pragma unroll
        for (int i = 0; i < 16; ++i) ss += fa[i] * fa[i] + fb[i] * fb[i];
        ss += shx(ss, F.lane, 1); ss += shx(ss, F.lane, 2);
        const float r = rsqrtf(ss * (1.f / 128.f) + EPS) * K6_SCALE;
#pragma unroll
        for (int i = 0; i < 16; ++i) { fa[i] *= r * ga[i]; fb[i] *= r * gb[i]; }
        st24(K + (size_t)row * 3072 + h * 192 + 32 * blk, __builtin_amdgcn_cvt_scalef32_2xpk16_fp6_f32(fa, fb, 1.0f));
        if (F.lane < 32) { const int h2 = F.lane >> 1, b2 = F.lane & 1;
            v16f_t pa, pb; unpack16(KPE + (size_t)row * 64 + 32 * b2, pa); unpack16(KPE + (size_t)row * 64 + 32 * b2 + 16, pb);
#pragma unroll
            for (int i = 0; i < 16; ++i) { pa[i] *= K6_SCALE; pb[i] *= K6_SCALE; }
            st24(K + (size_t)row * 3072 + h2 * 192 + 128 + 32 * b2, __builtin_amdgcn_cvt_scalef32_2xpk16_fp6_f32(pa, pb, 1.0f)); }
    }
}
__device__ __forceinline__ void gqa_knorm_phase(const Frame& F, const bf16* QKV, unsigned char* K, const float* g_k, const float* ropeG) {
    const int blk = F.lane & 3, kh = (F.lane >> 2) & 3, rr = F.lane >> 4, s_ = blk >> 1, hi = blk & 1, da = 64 * s_ + 16 * hi, db = da + 32;
    v16f_t ga, gb;
#pragma unroll
    for (int i = 0; i < 16; ++i) { ga[i] = g_k[da + i]; gb[i] = g_k[db + i]; }
    for (int row0 = F.gw * 4; row0 < R; row0 += F.NGW * 4) {
        const int row = row0 + rr, b = row / SB, t = row - b * SB;
        const bf16* src = QKV + (size_t)row * 3072 + 2048 + kh * 128;
        v16f_t fa, fb; unpack16(src + da, fa); unpack16(src + db, fb);
        float ss = 0.f;
#pragma unroll
        for (int i = 0; i < 16; ++i) ss += fa[i] * fa[i] + fb[i] * fb[i];
        ss += shx(ss, F.lane, 1); ss += shx(ss, F.lane, 2);
        const float r = rsqrtf(ss * (1.f / 128.f) + EPS) * K6_SCALE;
#pragma unroll
        for (int i = 0; i < 16; ++i) { fa[i] *= r * ga[i]; fb[i] *= r * gb[i]; }
        if (t < SEQ) { const int p = s_ == 0 ? (t >> 6) : (t & 63); const float* cs = ropeG + p * 32 + 16 * hi; const float* sn = ropeG + 128 * 32 + p * 32 + 16 * hi;
#pragma unroll
            for (int i = 0; i < 16; ++i) { const float c = cs[i], sv = sn[i], x = fa[i], y = fb[i]; fa[i] = x * c - y * sv; fb[i] = y * c + x * sv; } }
        st24(K + (size_t)row * 512 + kh * 128 + 64 * s_ + 32 * hi, __builtin_amdgcn_cvt_scalef32_2xpk16_fp6_f32(fa, fb, 1.0f));
    }
}
__device__ __forceinline__ void tr4x4(unsigned a0, unsigned a1, unsigned a2, unsigned a3, unsigned* t) {
    const unsigned x0 = __builtin_amdgcn_perm(a1, a0, 0x05010400u), x1 = __builtin_amdgcn_perm(a1, a0, 0x07030602u), y0 = __builtin_amdgcn_perm(a3, a2, 0x05010400u), y1 = __builtin_amdgcn_perm(a3, a2, 0x07030602u);
    t[0] = __builtin_amdgcn_perm(y0, x0, 0x05040100u); t[1] = __builtin_amdgcn_perm(y0, x0, 0x07060302u); t[2] = __builtin_amdgcn_perm(y1, x1, 0x05040100u); t[3] = __builtin_amdgcn_perm(y1, x1, 0x07060302u);
}
__device__ __forceinline__ void v8t_items(const Frame& F, const bf16* Vsrc, int ldv, int vcol0, int nkv, unsigned char* V8T) {
    LAS unsigned char* scr = F.lds + RING_OFF + F.wave * 16384;
    const int l16 = F.lane & 15, kq = F.lane >> 4;
    for (int it = F.gw; it < BATCH * nkv * (SB / 64); it += F.NGW) {
        const int tile = it % (SB / 64), bh = it / (SB / 64), kvh = bh % nkv, b = bh / nkv;
        const bf16* src = Vsrc + (size_t)(b * SB + tile * 64 + 4 * kq) * ldv + vcol0 + kvh * 128 + l16 * 8;
        v4u wl[16];
#pragma unroll
        for (int i = 0; i < 16; ++i) wl[i] = *(const v4u*)(src + (size_t)(16 * (i >> 2) + (i & 3)) * ldv);
        asm volatile("" ::: "memory");
#pragma unroll
        for (int g = 0; g < 4; ++g) { unsigned lo[4], hi[4], t[8];
#pragma unroll
            for (int j = 0; j < 4; ++j) { const v4u w = wl[4 * g + j]; lo[j] = pk4f8(bf_lo(w.x), bf_hi(w.x), bf_lo(w.y), bf_hi(w.y)); hi[j] = pk4f8(bf_lo(w.z), bf_hi(w.z), bf_lo(w.w), bf_hi(w.w)); }
            tr4x4(lo[0], lo[1], lo[2], lo[3], t); tr4x4(hi[0], hi[1], hi[2], hi[3], t + 4);
            const int q = 4 * g + kq, sdw = 8 * (q & 1) + 4 * (q >> 3) + ((q & 7) >> 1);
            LAS unsigned* p = (LAS unsigned*)(scr + (l16 * 8) * 64 + 4 * sdw);
#pragma unroll
            for (int e = 0; e < 8; ++e) p[16 * e] = t[e]; }
        LDS_WAIT(); asm volatile("" ::: "memory");
#pragma unroll
        for (int k = 0; k < 8; ++k) { const int d = 16 * k + (F.lane >> 2), c = F.lane & 3;
            *(v4u*)(V8T + ((size_t)bh * 128 + d) * 8448 + tile * 64 + c * 16) = *(const LAS v4u*)(scr + d * 64 + c * 16); }
        LDS_WAIT(); asm volatile("" ::: "memory");
    }
}
__device__ __forceinline__ void conv_fix_phase(const Frame& F, const float* GH, const float* VH, bf16* ACT, const float* cw, const float* cb, bool skip_ctx) {
    constexpr int NCG = DFF / 512, NST = R / 64;
    for (int it = F.gw; it < NST * 2 * NCG; it += F.NGW) {
        const int cg = it % NCG, se = it / NCG, sid = se >> 1, lastedge = se & 1, f0 = cg * 512 + F.lane * 8;
        const int row = sid * 64 + (lastedge ? 63 : 0), t = row % SB;
        if (skip_ctx && t >= SEQ) continue;
        const bool zp = !lastedge && (t == 0 || t == SEQ), zn = lastedge && (t == SEQ - 1 || t == SB - 1);
        const float* gp = lastedge ? GH + ((size_t)sid * 4 + 2) * DFF : GH + ((size_t)sid * 4 - 1) * DFF;
        const float* gc = GH + ((size_t)sid * 4 + (lastedge ? 3 : 0)) * DFF;
        const float* gn = lastedge ? GH + ((size_t)sid * 4 + 4) * DFF : GH + ((size_t)sid * 4 + 1) * DFF;
        const float* vp = VH + ((size_t)sid * 2 + lastedge) * DFF;
        float o[8];
#pragma unroll
        for (int h = 0; h < 2; ++h) {
            const int f = f0 + 4 * h;
            const f32x4 z = {0.f, 0.f, 0.f, 0.f};
            const f32x4 p = zp ? z : *(const f32x4*)(gp + f), c = *(const f32x4*)(gc + f), n = zn ? z : *(const f32x4*)(gn + f), v = *(const f32x4*)(vp + f);
            const f32x4 w0 = *(const f32x4*)(cw + f), w1 = *(const f32x4*)(cw + DFF + f), w2 = *(const f32x4*)(cw + 2 * DFF + f), b = *(const f32x4*)(cb + f);
#pragma unroll
            for (int i = 0; i < 4; ++i) { const float a = fmaf(w0[i], p[i], fmaf(w1[i], c[i], fmaf(w2[i], n[i], b[i]))); o[4 * h + i] = a * __builtin_amdgcn_rcpf(1.f + __builtin_amdgcn_exp2f(a * -1.4426950408889634f)) * v[i]; }
        }
        v4u ow; ow.x = pk2(o[0], o[1]); ow.y = pk2(o[2], o[3]); ow.z = pk2(o[4], o[5]); ow.w = pk2(o[6], o[7]);
        *(v4u*)(ACT + (size_t)row * DFF + f0) = ow;
    }
}

#ifndef UP_PROBE
#define UP_PROBE 0
#endif
#ifndef PROBE_EXTRA
#define PROBE_EXTRA 0
#endif
#ifndef ATT_STATIC_MAX
#define ATT_STATIC_MAX 29
#endif
#ifndef ATT_FALLBACK
#define ATT_FALLBACK 1
#endif
template <class Cfg>
__device__ __forceinline__ void attention_phase(const Frame& F, const bf16* Q, const unsigned char* K, const unsigned char* V8T, bf16* O, const float* gq_n, const float* gq_p, const float* gk_n, const float* gk_p, const float* rope_tab, bool with_ctx, int var_in) {
    constexpr int QPE = Cfg::MLA ? 2048 : 0, KHD = Cfg::KROWB;
    float mbound;
    { float a = fmaxf(fabsf(gq_n[F.lane]), fabsf(gq_n[64 + F.lane])), b = fmaxf(fabsf(gk_n[F.lane]), fabsf(gk_n[64 + F.lane])), c = 0.f, d = 0.f;
      if constexpr (Cfg::MLA) { c = fabsf(gq_p[F.lane]); d = fabsf(gk_p[F.lane]); }
#pragma unroll
      for (int o = 1; o < 64; o <<= 1) { a = fmaxf(a, shx(a, F.lane, o)); b = fmaxf(b, shx(b, F.lane, o)); if constexpr (Cfg::MLA) { c = fmaxf(c, shx(c, F.lane, o)); d = fmaxf(d, shx(d, F.lane, o)); } }
      const float qn2 = 128.f * a * a + (Cfg::MLA ? 64.f * c * c : 0.f), kn2 = 128.f * b * b + (Cfg::MLA ? 64.f * d * d : 0.f);
      mbound = 1.20f * Cfg::SCALE * 1.4426950408889634f * sqrtf(qn2 * kn2) + 0.5f; }
    const bool use_static = __builtin_amdgcn_readfirstlane((mbound <= ATT_STATIC_MAX) ? 1 : 0) != 0;
    const int var = PROBE_EXTRA ? __builtin_amdgcn_readfirstlane(var_in) : 0;
    const int c = F.bid;
    const int nlat = (F.G == 256) ? 4 : (1024 - c + F.G - 1) / F.G;
    const int ntot = nlat + ((with_ctx && c < 32) ? 1 : 0);
    for (int i = 0; i < ntot; ++i) {
        int bh, qb, seq, t0; size_t row0, krow0;
        if (i < nlat) {
            if (F.G == 256) { bh = i * 8 + (c & 7); qb = c >> 3; }
            else { const int L = i * F.G + c; bh = L >> 5; qb = L & 31; }
            const int b = bh >> 4; row0 = (size_t)b * SB + qb * 256; krow0 = (size_t)b * SB; seq = SB; t0 = qb * 256;
        } else { bh = c; const int b = bh >> 4; row0 = (size_t)b * SB + SEQ; krow0 = row0; seq = CTX; t0 = -1; }
        const int h = bh & 15, kvh = Cfg::MLA ? h : (h >> 2), b_ = bh >> 4;
        if (use_static || !ATT_FALLBACK)
            att::attn_unit<Cfg, true>(Q + row0 * Cfg::LDQ + h * 128, Q + row0 * Cfg::LDQ + QPE + h * 64, K + krow0 * Cfg::LDK + kvh * KHD, V8T + (size_t)((b_ * (Cfg::MLA ? 16 : 4) + kvh) * 128) * Cfg::LDVT + (i < nlat ? 0 : SEQ),
                            O + row0 * Cfg::LDO + h * 128, seq, F.lds + RING_OFF, F.ldsg + RING_OFF, t0, gq_n, gq_p, rope_tab, mbound, F.wave, var);
        else
            att::attn_unit<Cfg, false>(Q + row0 * Cfg::LDQ + h * 128, Q + row0 * Cfg::LDQ + QPE + h * 64, K + krow0 * Cfg::LDK + kvh * KHD, V8T + (size_t)((b_ * (Cfg::MLA ? 16 : 4) + kvh) * 128) * Cfg::LDVT + (i < nlat ? 0 : SEQ),
                            O + row0 * Cfg::LDO + h * 128, seq, F.lds + RING_OFF, F.ldsg + RING_OFF, t0, gq_n, gq_p, rope_tab, mbound, F.wave, var);
    }
}

#ifndef REP_ATT
#define REP_ATT 1
#endif
#ifndef REP_GBF
#define REP_GBF 1
#endif
#ifndef REP_GRES
#define REP_GRES 1
#endif
#ifndef REP_THIN
#define REP_THIN 1
#endif
#ifndef REP_PRO
#define REP_PRO 1
#endif
#ifndef REP_CONV
#define REP_CONV 1
#endif
#ifndef REP_MOD
#define REP_MOD 1
#endif
#ifndef REP_BAR
#define REP_BAR 1
#endif
#ifndef EN_ATT_MLA
#define EN_ATT_MLA 1
#endif
#ifndef EN_ATT_GQA
#define EN_ATT_GQA 1
#endif
#ifndef EN_GEMM
#define EN_GEMM 63
#endif
#ifndef EN_THIN
#define EN_THIN 1
#endif
typedef const __attribute__((address_space(4))) Args* KargPtr;
__device__ __forceinline__ KargPtr kargs() { KargPtr p = (KargPtr)__builtin_amdgcn_kernarg_segment_ptr(); asm volatile("" : "+s"(p)); return p; }

__global__ void __launch_bounds__(NWAVES * 64, 2) fwd_kernel(Args args_unused) {
    extern __shared__ __attribute__((aligned(16))) unsigned char lds[];
#define MKFRAME() Frame F; { int t_; asm volatile("v_mbcnt_lo_u32_b32 %0, -1, 0\n\tv_mbcnt_hi_u32_b32 %0, -1, %0" : "=&v"(t_)); t_ |= wave_s << 6;     F.lds = (LAS unsigned char*)lds; F.ldsg = (char*)lds; F.tid = t_; F.lane = t_ & 63; F.wave = wave_s; \
    F.bid = blockIdx.x; asm volatile("" : "+s"(F.bid)); F.G = gridDim.x; F.gw = F.bid * NWAVES + F.wave; F.NGW = F.G * NWAVES; }
    LAS unsigned char* const ldsl = (LAS unsigned char*)lds;
    const int wave_s = __builtin_amdgcn_readfirstlane(threadIdx.x >> 6);
    for (int u = threadIdx.x; u < (LDS_BYTES - LDSCTL_OFF) / 4; u += NWAVES * 64) ((LAS unsigned*)(ldsl + LDSCTL_OFF))[u] = 0u;
    __syncthreads();
    const int lo = kargs()->ph_lo, hi = kargs()->ph_hi;
    if (hi - lo > 1) { MKFRAME(); (void)xcd_barrier_post((unsigned*)(kargs()->ws + WS_CTL) + CW_BAR, (volatile LAS unsigned*)(ldsl + MISC_OFF) + 8, F.tid); }
#define IN(k) (lo <= (k) && (k) < hi)
#define SEAM(k) do { if (IN(k) && IN((k) + 1)) { MKFRAME(); XcdBarrier bar_; bar_.tid = F.tid; bar_.bar = (unsigned*)(kargs()->ws + WS_CTL) + CW_BAR; bar_.x = xb_xcc_id(); bar_.st = (volatile LAS unsigned*)(ldsl + MISC_OFF) + 8; _Pragma("unroll 1") for (int rb_ = 0; rb_ < REP_BAR; ++rb_) xcd_barrier(bar_); } } while (0)
#define WSP(off) (kargs()->ws + (off))

    if (EN_THIN && IN(0)) { MKFRAME(); p0a_prologue(F, kargs()); } SEAM(0);

    for (int layer = 0; layer < DEPTH; ++layer) {
        const int pb = 1 + layer * PH_PER_LAYER, j = layer >> 1; const bool mla = (layer & 1) == 0, last = layer == DEPTH - 1;
        if (EN_THIN && IN(pb + 0)) { MKFRAME(); KargPtr a = kargs(); unsigned char* ws = a->ws;
            if (layer == 0) { if (REP_PRO > 1) p0b_prologue(F, a, true); p0b_prologue(F, a); }
            else ctx_finalize_phase(F, (float*)(ws + WS_X), (bf16*)(ws + WS_H), (float*)(ws + WS_STAT) + (size_t)(2 * layer) * R, (const float*)(ws + WS_AV) + (size_t)(2 * layer) * 3 * D, (const float*)(ws + WS_PART), NSPLIT_DN, mla ? nullptr : ws + WS_XS8); }
        SEAM(pb + 0);
        if (mla) {
            if ((EN_GEMM & 1) && IN(pb + 1)) {
                MKFRAME(); unsigned char* ws = WSP(0);
                pg8::Gemm g{(const bf16*)(ws + WS_H), (const bf16*)(ws + WS_WMLA + j * SZ_MLA), R, 1280, 2048}; pg8::PanelOrder S; S.init2(1280, 2048, F.G, F.bid, 0);
                pg8::EpiF32 E{(float*)(ws + WS_RAW1), 1280, (const float*)(ws + WS_STAT) + (size_t)(2 * layer) * R, (const float*)(ws + WS_CB) + (size_t)(2 * layer) * 3 * CBN};
                _Pragma("unroll 1") for (int rp_ = 0; rp_ < REP_GBF; ++rp_) pg8::gemm_phase<pg8::EpiF32, pg8::PanelOrder, true, true>(F.lds + RING_OFF, g, S, E, F.wave);
            }
            SEAM(pb + 1);
            if (EN_THIN && IN(pb + 2)) { MKFRAME(); KargPtr a = kargs(); unsigned char* ws = a->ws;
                _Pragma("unroll 1") for (int rp_ = 0; rp_ < REP_THIN; ++rp_) mla_norm_phase(F, (const float*)(ws + WS_RAW1), (bf16*)(ws + WS_CQ), (bf16*)(ws + WS_CKV), (bf16*)(ws + WS_KPE), a->in[9] + j * 512, a->in[14] + j * 512, a->in[15] + j * 64, (const float*)(ws + WS_ROPE)); }
            SEAM(pb + 2);
            if ((EN_GEMM & 2) && IN(pb + 3)) {
                { MKFRAME(); unsigned char* ws = WSP(0);
                  pg8::Gemm g{(const bf16*)(ws + WS_CQ), (const bf16*)(ws + WS_WMLA + j * SZ_MLA + SZ_W1), R, 3072, 256, W8_E8M0, 0x7f7f7f7f}; pg8::PanelOrder S; S.init2(3072, 256, F.G, F.bid, 0);
                  pg8::EpiBf16 E{(bf16*)(ws + WS_QRAW), 3072, nullptr, nullptr};
                  _Pragma("unroll 1") for (int rp_ = 0; rp_ < REP_GBF; ++rp_) pg8::gemm_phase<pg8::EpiBf16, pg8::PanelOrder, true, true, true>(F.lds + RING_OFF, g, S, E, F.wave); }
                { MKFRAME(); unsigned char* ws = WSP(0);
                  pg8::Gemm g{(const bf16*)(ws + WS_CKV), (const bf16*)(ws + WS_WMLA + j * SZ_MLA + SZ_W1 + SZ_WUQ), R, 4096, 512}; pg8::PanelOrder S; S.init2(4096, 512, F.G, F.bid, 0);
                  pg8::EpiBf16 E{(bf16*)(ws + WS_KVRAW), 4096, nullptr, nullptr};
                  _Pragma("unroll 1") for (int rp_ = 0; rp_ < REP_GBF; ++rp_) pg8::gemm_phase<pg8::EpiBf16, pg8::PanelOrder, true, true>(F.lds + RING_OFF, g, S, E, F.wave); }
            }
            SEAM(pb + 3);
            if (EN_THIN && IN(pb + 4)) { MKFRAME(); KargPtr a = kargs(); unsigned char* ws = a->ws; _Pragma("unroll 1") for (int rp_ = 0; rp_ < REP_THIN; ++rp_) { mla_kbuild_phase(F, (const bf16*)(ws + WS_KVRAW), (const bf16*)(ws + WS_KPE), (unsigned char*)(ws + WS_KMLA), a->in[17] + j * 128); v8t_items(F, (const bf16*)(ws + WS_KVRAW), 4096, 2048, 16, ws + WS_V8T_MLA); } }
            SEAM(pb + 4);
            if (EN_ATT_MLA && IN(pb + 5)) { MKFRAME(); KargPtr a = kargs(); unsigned char* ws = a->ws; __syncthreads();
                _Pragma("unroll 1") for (int rp_ = 0; rp_ < REP_ATT; ++rp_)
                attention_phase<att::CfgMLA>(F, (const bf16*)(ws + WS_QRAW), (const unsigned char*)(ws + WS_KMLA), (const unsigned char*)(ws + WS_V8T_MLA), (bf16*)(ws + WS_RAW1), a->in[11] + j * 128, a->in[12] + j * 64, a->in[17] + j * 128, a->in[15] + j * 64, (const float*)(ws + WS_ROPE), !last, PROBE_EXTRA ? a->var : 0); }
            SEAM(pb + 5);
        } else {
            if ((EN_GEMM & 4) && IN(pb + 1)) {
                { MKFRAME(); unsigned char* ws = WSP(0);
                  pg8::Gemm g{(const bf16*)(ws + WS_XS8), (const bf16*)(ws + WS_W8GQA + j * SZ_W8GQA), R, 2560, 1024, W8_E8M0, 0x7f7f7f7f}; pg8::PanelOrder S; S.init2(2560, 1024, F.G, F.bid, 0);
                  pg8::EpiBf16 E{(bf16*)(ws + WS_QKV), 3072, (const float*)(ws + WS_STAT) + (size_t)(2 * layer) * R, (const float*)(ws + WS_CB) + (size_t)(2 * layer) * 3 * CBN};
                  pg8::gemm_phase<pg8::EpiBf16, pg8::PanelOrder, true, true, true>(F.lds + RING_OFF, g, S, E, F.wave); }
                { MKFRAME(); unsigned char* ws = WSP(0);
                  pg8::Gemm g{(const bf16*)(ws + WS_H), (const bf16*)(ws + WS_WGQA + j * SZ_GQA) + (size_t)2560 * 2048, R, 512, 2048}; pg8::PanelOrder S; S.init2(512, 2048, F.G, F.bid, 0);
                  pg8::EpiBf16 E{(bf16*)(ws + WS_QKV) + 2560, 3072, (const float*)(ws + WS_STAT) + (size_t)(2 * layer) * R, (const float*)(ws + WS_CB) + (size_t)(2 * layer) * 3 * CBN + 2560};
                  pg8::gemm_phase<pg8::EpiBf16, pg8::PanelOrder, true, true>(F.lds + RING_OFF, g, S, E, F.wave); }
            }
            SEAM(pb + 1);
            if (EN_THIN && IN(pb + 2)) { MKFRAME(); KargPtr a = kargs(); unsigned char* ws = a->ws; _Pragma("unroll 1") for (int rp_ = 0; rp_ < REP_THIN; ++rp_) { gqa_knorm_phase(F, (const bf16*)(ws + WS_QKV), (unsigned char*)(ws + WS_KGQA), a->in[22] + j * 128, (const float*)(ws + WS_ROPE) + 2 * 128 * 16); v8t_items(F, (const bf16*)(ws + WS_QKV), 3072, 2560, 4, ws + WS_V8T_GQA); } }
            SEAM(pb + 2);
            if (EN_ATT_GQA && IN(pb + 5)) { MKFRAME(); KargPtr a = kargs(); unsigned char* ws = a->ws; __syncthreads();
                _Pragma("unroll 1") for (int rp_ = 0; rp_ < REP_ATT; ++rp_)
                attention_phase<att::CfgGQA>(F, (const bf16*)(ws + WS_QKV), (const unsigned char*)(ws + WS_KGQA), (const unsigned char*)(ws + WS_V8T_GQA), (bf16*)(ws + WS_OGQA), a->in[20] + j * 128, nullptr, a->in[22] + j * 128, nullptr, (const float*)(ws + WS_ROPE) + 2 * 128 * 16, !last, PROBE_EXTRA ? a->var : 0); }
            SEAM(pb + 5);
        }
        if ((EN_GEMM & 8) && IN(pb + 6)) {
            MKFRAME(); unsigned char* ws = WSP(0);
            const bf16* wo = mla ? (const bf16*)(ws + WS_WMLA + j * SZ_MLA + SZ_W1 + SZ_WUQ + SZ_WUKV) : (const bf16*)(ws + WS_WGQA + j * SZ_GQA + SZ_WQKV);
            const bf16* O = mla ? (const bf16*)(ws + WS_RAW1) : (const bf16*)(ws + WS_OGQA);
            pg8::Gemm g{O, wo, R, 2048, 2048}; pg8::ResOrder S; S.init2(2048, F.G, F.bid, last ? 0 : NSPLIT_WO);
            pg8::EpiRes E{(const float*)(ws + WS_X), (float*)(ws + WS_X), (const float*)(ws + WS_MOD) + (size_t)layer * 3 * NMOD + 2 * D, 0, (float*)(ws + WS_PART), 2048 / 64,
                          (bf16*)(ws + WS_H), (const float*)(ws + WS_AV) + (size_t)(2 * layer + 1) * 3 * D, (float*)(ws + WS_STAT) + (size_t)(2 * layer + 1) * R, nullptr};
            pg8::gemm_phase<pg8::EpiRes, pg8::ResOrder, true, true>(F.lds + RING_OFF, g, S, E, F.wave);
        }
        SEAM(pb + 6);
        if (EN_THIN && IN(pb + 7) && !last) { MKFRAME(); KargPtr a = kargs(); unsigned char* ws = a->ws;
            ctx_finalize_phase(F, (float*)(ws + WS_X), (bf16*)(ws + WS_H), (float*)(ws + WS_STAT) + (size_t)(2 * layer + 1) * R, (const float*)(ws + WS_AV) + (size_t)(2 * layer + 1) * 3 * D, (const float*)(ws + WS_PART), NSPLIT_WO, nullptr); }
        if (!last) SEAM(pb + 7);
        if ((EN_GEMM & 16) && IN(pb + 8)) {
            MKFRAME(); KargPtr ka_ = kargs(); unsigned char* ws = ka_->ws;
            pg8::Gemm g{(const bf16*)(ws + WS_H), (const bf16*)(ws + WS_WFFN + layer * SZ_FFN), R, 11264, 2048}; pg8::PanelOrder S; S.init2(11264, 2048, F.G, F.bid, last ? 1 : 0);
            pg8::EpiConv E{(bf16*)(ws + WS_ACT), (float*)(ws + WS_GH), (float*)(ws + WS_VH), ka_->in[25] + (size_t)layer * 3 * DFF, ka_->in[26] + (size_t)layer * DFF,
                           (const float*)(ws + WS_STAT) + (size_t)(2 * layer + 1) * R, (const float*)(ws + WS_CB) + (size_t)(2 * layer + 1) * 3 * CBN};
            if (UP_PROBE == 1) { pg8::EpiConv E2 = E; pg8::gemm_phase<pg8::EpiConv, pg8::PanelOrder, true, true>(F.lds + RING_OFF, g, S, E2, F.wave); }
            if (UP_PROBE == 2) { pg8::EpiBf16 E3{(bf16*)(ws + WS_PART), 11264, nullptr, nullptr}; pg8::gemm_phase<pg8::EpiBf16, pg8::PanelOrder, true, true>(F.lds + RING_OFF, g, S, E3, F.wave); }
            _Pragma("unroll 1") for (int rp_ = 0; rp_ < REP_GBF; ++rp_) pg8::gemm_phase<pg8::EpiConv, pg8::PanelOrder, true, true>(F.lds + RING_OFF, g, S, E, F.wave);
        }
        SEAM(pb + 8);
        if (EN_THIN && IN(pb + 9)) { MKFRAME(); KargPtr a = kargs(); _Pragma("unroll 1") for (int rp_ = 0; rp_ < REP_CONV; ++rp_) conv_fix_phase(F, (const float*)(a->ws + WS_GH), (const float*)(a->ws + WS_VH), (bf16*)(a->ws + WS_ACT), a->in[25] + (size_t)layer * 3 * DFF, a->in[26] + (size_t)layer * DFF, last); }
        SEAM(pb + 9);
        if ((EN_GEMM & 32) && IN(pb + 10)) {
            MKFRAME(); KargPtr a = kargs(); unsigned char* ws = a->ws;
            pg8::Gemm g{(const bf16*)(ws + WS_ACT), (const bf16*)(ws + WS_WFFN + layer * SZ_FFN + SZ_WUP), R, 2048, 5632}; pg8::ResOrder S; S.init2(5632, F.G, F.bid, last ? 0 : NSPLIT_DN);
            pg8::EpiRes E{(const float*)(ws + WS_X), last ? a->out : (float*)(ws + WS_X), (const float*)(ws + WS_MOD) + (size_t)layer * 3 * NMOD + 5 * D, last ? 1 : 0, (float*)(ws + WS_PART), 5632 / 64,
                          (bf16*)(ws + WS_H), (const float*)(ws + WS_AV) + (size_t)(last ? 0 : 2 * layer + 2) * 3 * D, last ? nullptr : (float*)(ws + WS_STAT) + (size_t)(2 * layer + 2) * R, (!last && mla) ? ws + WS_XS8 : nullptr};
            pg8::gemm_phase<pg8::EpiRes, pg8::ResOrder, true, true>(F.lds + RING_OFF, g, S, E, F.wave);
        }
        SEAM(pb + 10);
    }
#undef IN
#undef SEAM
#undef WSP
}

#ifndef PROBE_EXTRA
#define PROBE_EXTRA 0
#endif
#ifndef PROBE_VAR
#define PROBE_VAR 0
#endif
#ifndef MK_PER_PHASE
#define MK_PER_PHASE 0
#endif
extern "C" void kernel_launch(void* const* d_in, const int* in_sizes, int n_in, void* d_out, int out_size, void* d_ws, size_t ws_size, hipStream_t stream) {
    static int grid = 0;
    if (grid == 0) {
        if (n_in != 28 || out_size != BATCH * SEQ * D || ws_size < WS_END) { fprintf(stderr, "kernel_launch: unexpected shapes: n_in %d out %d ws %zu (need %zu)\n", n_in, out_size, ws_size, (size_t)WS_END); grid = -1; return; }
        int dev = 0, cus = 0;
        if (hipGetDevice(&dev) != hipSuccess || hipDeviceGetAttribute(&cus, hipDeviceAttributeMultiprocessorCount, dev) != hipSuccess) { grid = -1; return; }
        if (hipFuncSetAttribute((const void*)fwd_kernel, hipFuncAttributeMaxDynamicSharedMemorySize, LDS_BYTES) != hipSuccess) { fprintf(stderr, "kernel_launch: hipFuncSetAttribute failed\n"); grid = -1; return; }
        int per_cu = 0;
        if (hipOccupancyMaxActiveBlocksPerMultiprocessor(&per_cu, (const void*)fwd_kernel, NWAVES * 64, LDS_BYTES) != hipSuccess || per_cu < 1) { fprintf(stderr, "kernel_launch: occupancy query says %d\n", per_cu); }
        (void)hipGetLastError();
        grid = cus;
    }
    if (grid < 0) return;
    (void)hipMemsetAsync((char*)d_ws + WS_CTL, 0, CTL_ZERO_BYTES, stream);
    Args a{};
    for (int i = 0; i < 28; ++i) a.in[i] = (const float*)d_in[i];
    a.out = (float*)d_out; a.ws = (unsigned char*)d_ws;
#if MK_PER_PHASE
    for (int ph = 0; ph < N_PHASES; ++ph) {
        if (ph >= 1) { const int l = (ph - 1) / PH_PER_LAYER, s = (ph - 1) % PH_PER_LAYER; if ((l & 1) && (s == 3 || s == 4)) continue; }
        a.ph_lo = ph; a.ph_hi = ph + 1;
        hipLaunchKernelGGL(fwd_kernel, dim3(grid), dim3(NWAVES * 64), LDS_BYTES, stream, a);
    }
#else
    a.ph_lo = 0; a.ph_hi = N_PHASES; a.var = 0;
    hipLaunchKernelGGL(fwd_kernel, dim3(grid), dim3(NWAVES * 64), LDS_BYTES, stream, a);
#if PROBE_EXTRA
    for (int l = 0; l < 4; ++l) for (int sl = 0; sl < PH_PER_LAYER; ++sl) if ((PROBE_EXTRA >> sl) & 1) { if ((l & 1) && (sl == 3 || sl == 4)) continue; a.ph_lo = 1 + l * PH_PER_LAYER + sl; a.ph_hi = a.ph_lo + 1; a.var = PROBE_VAR;
        hipLaunchKernelGGL(fwd_kernel, dim3(grid), dim3(NWAVES * 64), LDS_BYTES, stream, a); }
#endif
#endif
    const hipError_t le = hipPeekAtLastError();
    if (le != hipSuccess) fprintf(stderr, "kernel_launch: launch failed: %s\n", hipGetErrorName(le));
}
```

```cpp
#include <hip/hip_runtime.h>
#include <cstdio>
#include <cstdint>
namespace pg8 {
#define PG8_LAS __attribute__((address_space(3)))
typedef unsigned short bf16_t;
typedef short bf16x8 __attribute__((ext_vector_type(8)));
typedef float f32x4 __attribute__((ext_vector_type(4)));
typedef unsigned u32x4 __attribute__((ext_vector_type(4)));
typedef unsigned u32x2 __attribute__((ext_vector_type(2)));
typedef int v8i_t __attribute__((ext_vector_type(8)));
struct Frag2 { v8i_t w;
    __device__ __forceinline__ void ld(PG8_LAS unsigned char* p) { typedef int v4i_t __attribute__((ext_vector_type(4))); const v4i_t a = *(const PG8_LAS v4i_t*)p, b = *(const PG8_LAS v4i_t*)(p + 1024); w = (v8i_t){a[0], a[1], a[2], a[3], b[0], b[1], b[2], b[3]}; }
    __device__ __forceinline__ bf16x8 k0() const { typedef int v4i_t __attribute__((ext_vector_type(4))); const v4i_t a = {w[0], w[1], w[2], w[3]}; return __builtin_bit_cast(bf16x8, a); }
    __device__ __forceinline__ bf16x8 k1() const { typedef int v4i_t __attribute__((ext_vector_type(4))); const v4i_t a = {w[4], w[5], w[6], w[7]}; return __builtin_bit_cast(bf16x8, a); } };
__device__ __forceinline__ v8i_t pg8_cat(bf16x8 lo, bf16x8 hi) { typedef int v4i_t __attribute__((ext_vector_type(4))); const v4i_t a = __builtin_bit_cast(v4i_t, lo), b = __builtin_bit_cast(v4i_t, hi); return (v8i_t){a[0], a[1], a[2], a[3], b[0], b[1], b[2], b[3]}; }
constexpr int BM = 256, BK = 64, HALF = 128, HTB = HALF * BK * 2  , STAGE_BYTES = 8 * HTB, NXCD = 8, WGM = 8;

__host__ __device__ __forceinline__ int lds_byte(int r, int c) { const int st = (r >> 4) * 2 + (c >> 5), rr = r & 15, cc = c & 31, ob = rr * 64 + cc * 2; return st * 1024 + (ob ^ (((ob >> 9) & 1) << 5)); }
__host__ __device__ __forceinline__ void stage_rc(int b, int& R, int& C) { const int st = b / 1024, sb = b % 1024, swz = sb ^ (((sb >> 9) & 1) << 5); R = (st >> 1) * 16 + swz / 64; C = (st & 1) * 32 + (swz % 64) / 2; }
__host__ __device__ __forceinline__ int perm32(int rho) { const int n = rho >> 4, i = rho & 15; return 8 * (i >> 2) + 4 * n + (i & 3); }

struct Unit { int pm, pn, kt0, nkt; };
struct Gemm { const bf16_t* A; const bf16_t* Bt; int M, N, K; int sa, sb; };

struct StaticOrder {
    int nM, nN, nwg, G, c;
    __host__ __device__ void init(int M, int N, int G_, int c_) { nM = M / BM; nN = N / BM; nwg = nM * nN; G = G_; c = c_; }
    __host__ __device__ bool next(int i, Unit& u) const {
        const int L = i * G + c; if (L >= nwg) return false;
        int wgid = L; { const int q = nwg / NXCD, r = nwg % NXCD, xcd = wgid % NXCD, off = wgid / NXCD; wgid = (xcd < r ? xcd * (q + 1) : r * (q + 1) + (xcd - r) * q) + off; }
        const int nig = WGM * nN, gid = wgid / nig, fm = gid * WGM, gsz = (nM - fm) < WGM ? (nM - fm) : WGM;
        u.pm = fm + ((wgid % nig) % gsz); u.pn = (wgid % nig) / gsz; return true;
    }
    __device__ __forceinline__ void a_ready(const Unit&) const {}
    __device__ __forceinline__ void done(const Unit&) const {}
};
__device__ __forceinline__ unsigned cvt_pk_bf16(float lo, float hi) { unsigned r; asm volatile("v_cvt_pk_bf16_f32 %0, %1, %2" : "=v"(r) : "v"(lo), "v"(hi)); return r; }
__device__ __forceinline__ void row_scales(const float* stat, const Unit& u, int wr, int fr, float (&r)[2][4]) {
#pragma unroll
    for (int ai = 0; ai < 2; ++ai)
#pragma unroll
        for (int m = 0; m < 4; ++m) r[ai][m] = stat ? __builtin_amdgcn_rsqf(stat[u.pm * BM + ai * HALF + wr * 64 + m * 16 + fr] * (1.0f / 2048.0f) + 1e-6f) : 1.0f;
}
__device__ __forceinline__ int panel_variant(const Unit& u) { const int b = u.pm / 33; return (u.pm - b * 33) == 32 ? 2 : b; }
constexpr int CBN_ = 11264;
struct EpiF32 {
    static constexpr bool PERM = false, AFTER_DRAIN = false;
    float* C; int ldc; const float* stat; const float* cb;
    __device__ __forceinline__ void operator()(const f32x4 (&acc)[2][2][4][2], const Unit& u, int wr, int wc, int fr, int fq) const {
        const int row0 = u.pm * BM + wr * 64 + fr, col0 = u.pn * BM + wc * 32 + 4 * fq;
        float r[2][4]; row_scales(stat, u, wr, fr, r);
        f32x4 cv[2][2];
#pragma unroll
        for (int bj = 0; bj < 2; ++bj)
#pragma unroll
            for (int n = 0; n < 2; ++n) cv[bj][n] = stat ? *(const f32x4*)(cb + (size_t)panel_variant(u) * CBN_ + col0 + bj * HALF + n * 16) : (f32x4){0.f, 0.f, 0.f, 0.f};
#pragma unroll
        for (int ai = 0; ai < 2; ++ai)
#pragma unroll
            for (int m = 0; m < 4; ++m) { float* rowp = C + (size_t)(row0 + ai * HALF + m * 16) * ldc + col0;
#pragma unroll
                for (int bj = 0; bj < 2; ++bj)
#pragma unroll
                    for (int n = 0; n < 2; ++n) *(f32x4*)(rowp + bj * HALF + n * 16) = acc[ai][bj][m][n] * r[ai][m] + cv[bj][n]; }
    }
};
struct EpiBf16 {
    static constexpr bool PERM = true, AFTER_DRAIN = false;
    bf16_t* O; int ldc; const float* stat; const float* cb;
    __device__ __forceinline__ void operator()(const f32x4 (&acc)[2][2][4][2], const Unit& u, int wr, int wc, int fr, int fq) const {
        const int row0 = u.pm * BM + wr * 64 + fr, col0 = u.pn * BM + wc * 32 + 8 * fq;
        float r[2][4]; row_scales(stat, u, wr, fr, r);
        f32x4 cv[2][2];
#pragma unroll
        for (int bj = 0; bj < 2; ++bj)
#pragma unroll
            for (int n = 0; n < 2; ++n) cv[bj][n] = stat ? *(const f32x4*)(cb + (size_t)panel_variant(u) * CBN_ + col0 + bj * HALF + 4 * n) : (f32x4){0.f, 0.f, 0.f, 0.f};
#pragma unroll
        for (int ai = 0; ai < 2; ++ai)
#pragma unroll
            for (int m = 0; m < 4; ++m) { bf16_t* rowp = O + (size_t)(row0 + ai * HALF + m * 16) * ldc + col0;
#pragma unroll
                for (int bj = 0; bj < 2; ++bj) { const f32x4 v0 = acc[ai][bj][m][0] * r[ai][m] + cv[bj][0], v1 = acc[ai][bj][m][1] * r[ai][m] + cv[bj][1];
                    u32x4 w; w.x = cvt_pk_bf16(v0[0], v0[1]); w.y = cvt_pk_bf16(v0[2], v0[3]); w.z = cvt_pk_bf16(v1[0], v1[1]); w.w = cvt_pk_bf16(v1[2], v1[3]);
                    *(u32x4*)(rowp + bj * HALF) = w; } }
    }
};
__device__ __forceinline__ float dpp_ror1(float v) { return __builtin_bit_cast(float, __builtin_amdgcn_update_dpp(0, __builtin_bit_cast(int, v), 0x121, 0xf, 0xf, false)); }
__device__ __forceinline__ float dpp_rol1(float v) { return __builtin_bit_cast(float, __builtin_amdgcn_update_dpp(0, __builtin_bit_cast(int, v), 0x12f, 0xf, 0xf, false)); }
struct EpiConv {
    static constexpr bool PERM = true, AFTER_DRAIN = false;
    bf16_t* ACT; float* GH; float* VH; const float* cw; const float* cb; const float* stat; const float* cvec;
    __device__ __forceinline__ void operator()(const f32x4 (&acc_)[2][2][4][2], const Unit& u, int wr, int wc, int fr, int fq) const {
        constexpr int FF = 5632;
        const int f0 = u.pn * 128 + wc * 32 + 8 * fq;
        f32x4 acc[2][2][4][2];
        { float r[2][4]; row_scales(stat, u, wr, fr, r); const float* cp = cvec + (size_t)panel_variant(u) * CBN_ + u.pn * BM + wc * 32 + 8 * fq;
#pragma unroll
          for (int bj = 0; bj < 2; ++bj)
#pragma unroll
            for (int n = 0; n < 2; ++n) { const f32x4 cv = *(const f32x4*)(cp + bj * HALF + 4 * n);
#pragma unroll
              for (int ai = 0; ai < 2; ++ai)
#pragma unroll
                for (int m = 0; m < 4; ++m) acc[ai][bj][m][n] = acc_[ai][bj][m][n] * r[ai][m] + cv; } }
        float w0[8], w1[8], w2[8], bb[8];
#pragma unroll
        for (int h = 0; h < 2; ++h) { const f32x4 a = *(const f32x4*)(cw + f0 + 4 * h), b = *(const f32x4*)(cw + FF + f0 + 4 * h), c = *(const f32x4*)(cw + 2 * FF + f0 + 4 * h), d = *(const f32x4*)(cb + f0 + 4 * h);
#pragma unroll
            for (int i = 0; i < 4; ++i) { w0[4 * h + i] = a[i]; w1[4 * h + i] = b[i]; w2[4 * h + i] = c[i]; bb[4 * h + i] = d[i]; } }
#pragma unroll
        for (int ai = 0; ai < 2; ++ai) {
            const int sid = u.pm * 4 + ai * 2 + wr, row0 = u.pm * BM + ai * HALF + wr * 64 + fr;
#pragma unroll
            for (int m = 0; m < 4; ++m) {
                float o[8];
#pragma unroll
                for (int i = 0; i < 8; ++i) {
                    const float g = acc[ai][0][m][i >> 2][i & 3], v = acc[ai][1][m][i >> 2][i & 3];
                    const float pa = dpp_ror1(g), pb = m > 0 ? dpp_ror1(acc[ai][0][m > 0 ? m - 1 : 0][i >> 2][i & 3]) : 0.f;
                    const float na = dpp_rol1(g), nb = m < 3 ? dpp_rol1(acc[ai][0][m < 3 ? m + 1 : 3][i >> 2][i & 3]) : 0.f;
                    const float pv = fr == 0 ? pb : pa, nx = fr == 15 ? nb : na;
                    const float a = fmaf(w0[i], pv, fmaf(w1[i], g, fmaf(w2[i], nx, bb[i])));
                    o[i] = a * __builtin_amdgcn_rcpf(1.f + __builtin_amdgcn_exp2f(a * -1.4426950408889634f)) * v;
                }
                const bool edge = (m == 0 && fr == 0) || (m == 3 && fr == 15);
                if (!edge) { u32x4 w; w.x = cvt_pk_bf16(o[0], o[1]); w.y = cvt_pk_bf16(o[2], o[3]); w.z = cvt_pk_bf16(o[4], o[5]); w.w = cvt_pk_bf16(o[6], o[7]);
                    *(u32x4*)(ACT + (size_t)(row0 + m * 16) * FF + f0) = w; }
                if (m == 0 && fr < 2) { float* p = GH + ((size_t)sid * 4 + fr) * FF + f0; *(f32x4*)p = acc[ai][0][0][0]; *(f32x4*)(p + 4) = acc[ai][0][0][1]; }
                if (m == 3 && fr >= 14) { float* p = GH + ((size_t)sid * 4 + 2 + (fr - 14)) * FF + f0; *(f32x4*)p = acc[ai][0][3][0]; *(f32x4*)(p + 4) = acc[ai][0][3][1]; }
                if (m == 0 && fr == 0) { float* p = VH + ((size_t)sid * 2) * FF + f0; *(f32x4*)p = acc[ai][1][0][0]; *(f32x4*)(p + 4) = acc[ai][1][0][1]; }
                if (m == 3 && fr == 15) { float* p = VH + ((size_t)sid * 2 + 1) * FF + f0; *(f32x4*)p = acc[ai][1][3][0]; *(f32x4*)(p + 4) = acc[ai][1][3][1]; }
            }
        }
    }
};
struct EpiRes {
    static constexpr bool PERM = true, AFTER_DRAIN = false;
    const float* base; float* out; const float* gates; int to_out; float* part; int nkt_full;
    bf16_t* XS; const float* av; float* stat; unsigned char* XS8;
    __device__ __forceinline__ void operator()(const f32x4 (&acc)[2][2][4][2], const Unit& u, int wr, int wc, int fr, int fq) const {
        const int b = u.pm / 33, isctx = (u.pm - b * 33) == 32, v = isctx ? 2 : b;
        const float* g = gates + (size_t)v * 12288;
        const int row0 = u.pm * BM + wr * 64 + fr, col0 = u.pn * BM + wc * 32 + 8 * fq;
        const int orow0 = to_out ? row0 - 256 * b : row0;
        if (u.nkt != nkt_full) {
            float* pp = part + ((size_t)(u.kt0 / u.nkt) * 512 + 256 * b + wr * 64 + fr) * 2048 + u.pn * BM + wc * 32 + 8 * fq;
#pragma unroll
            for (int bj = 0; bj < 2; ++bj)
#pragma unroll
                for (int n = 0; n < 2; ++n) { const f32x4 gvv = *(const f32x4*)(g + col0 + bj * HALF + n * 4);
#pragma unroll
                    for (int ai = 0; ai < 2; ++ai)
#pragma unroll
                        for (int m = 0; m < 4; ++m) *(f32x4*)(pp + (size_t)(ai * HALF + m * 16) * 2048 + bj * HALF + n * 4) = gvv * acc[ai][bj][m][n]; }
            return;
        }
        f32x4 gv[2][2], aw[2][2];
#pragma unroll
        for (int bj = 0; bj < 2; ++bj)
#pragma unroll
            for (int n = 0; n < 2; ++n) { gv[bj][n] = *(const f32x4*)(g + col0 + bj * HALF + n * 4); aw[bj][n] = stat ? *(const f32x4*)(av + (size_t)v * 2048 + col0 + bj * HALF + n * 4) : (f32x4){0.f, 0.f, 0.f, 0.f}; }
        const int lane = fq * 16 + fr;
#pragma unroll
        for (int ai = 0; ai < 2; ++ai)
#pragma unroll
            for (int m = 0; m < 4; ++m) { const float* bp = base + (size_t)(row0 + ai * HALF + m * 16) * 2048 + col0; float* op = out + (size_t)(orow0 + ai * HALF + m * 16) * 2048 + col0;
                bf16_t* xp = XS + (size_t)(row0 + ai * HALF + m * 16) * 2048 + col0; float ss = 0.f;
#pragma unroll
                for (int bj = 0; bj < 2; ++bj) { f32x4 xx[2];
#pragma unroll
                    for (int n = 0; n < 2; ++n) { xx[n] = *(const f32x4*)(bp + bj * HALF + n * 4) + gv[bj][n] * acc[ai][bj][m][n]; *(f32x4*)(op + bj * HALF + n * 4) = xx[n]; }
                    if (stat) { ss += ((xx[0][0] * xx[0][0] + xx[0][1] * xx[0][1]) + (xx[0][2] * xx[0][2] + xx[0][3] * xx[0][3])) + ((xx[1][0] * xx[1][0] + xx[1][1] * xx[1][1]) + (xx[1][2] * xx[1][2] + xx[1][3] * xx[1][3]));
                        const f32x4 y0 = xx[0] * aw[bj][0], y1 = xx[1] * aw[bj][1];
                        u32x4 w; w.x = cvt_pk_bf16(y0[0], y0[1]); w.y = cvt_pk_bf16(y0[2], y0[3]); w.z = cvt_pk_bf16(y1[0], y1[1]); w.w = cvt_pk_bf16(y1[2], y1[3]); *(u32x4*)(xp + bj * HALF) = w;
                        if (XS8) { u32x2 w8; int t_ = 0; t_ = __builtin_amdgcn_cvt_pk_fp8_f32(y0[0], y0[1], t_, false); t_ = __builtin_amdgcn_cvt_pk_fp8_f32(y0[2], y0[3], t_, true); w8.x = (unsigned)t_; t_ = 0; t_ = __builtin_amdgcn_cvt_pk_fp8_f32(y1[0], y1[1], t_, false); t_ = __builtin_amdgcn_cvt_pk_fp8_f32(y1[2], y1[3], t_, true); w8.y = (unsigned)t_;
                            *(u32x2*)(XS8 + (size_t)(row0 + ai * HALF + m * 16) * 2048 + col0 + bj * HALF) = w8; } } }
                if (stat) {
                    ss += __builtin_bit_cast(float, __builtin_amdgcn_ds_bpermute((lane ^ 16) << 2, __builtin_bit_cast(int, ss)));
                    ss += __builtin_bit_cast(float, __builtin_amdgcn_ds_bpermute((lane ^ 32) << 2, __builtin_bit_cast(int, ss)));
                    if (fq == 0) unsafeAtomicAdd(stat + row0 + ai * HALF + m * 16, ss); } }
    }
};
struct PanelOrder : StaticOrder {
    int skip, nkt_full;
    __device__ void init2(int N, int K, int G_, int c_, int skip_) { skip = skip_; nkt_full = K / BK; init(skip_ ? 16384 : 16896, N, G_, c_); }
    __device__ __forceinline__ bool next(int i, Unit& u) const { Unit a; a.pm = 0; a.pn = 0; const bool ok = StaticOrder::next(i, a); u.pm = (skip && a.pm >= 32) ? a.pm + 1 : a.pm; u.pn = a.pn; u.kt0 = 0; u.nkt = nkt_full; return ok; }
};
struct ResOrder : StaticOrder {
    int nsplit, nkt_full;
    __device__ void init2(int K, int G_, int c_, int nsplit_) { nsplit = nsplit_; nkt_full = K / BK; init(16384, 2048, G_, c_); }
    __device__ __forceinline__ bool next(int i, Unit& u) const {
        const int L = i * G + c;
        Unit a; a.pm = 0; a.pn = 0; const bool lat = StaticOrder::next(i, a);
        const int m = L - nwg, cu = m & 15, s = m >> 4, nk = nsplit > 0 ? nkt_full / nsplit : nkt_full;
        const int pm = lat ? (a.pm >= 32 ? a.pm + 1 : a.pm) : ((cu >> 3) ? 65 : 32), pn = lat ? a.pn : (cu & 7);
        u.pm = pm; u.pn = pn; u.kt0 = lat ? 0 : s * nk; u.nkt = lat ? nkt_full : nk;
        return lat || m < 16 * nsplit;
    }
};

template <class Epi, class Sched, bool ALIGN_EPI = false, bool SP2 = false, bool F8 = false>
__device__ __forceinline__ void gemm_phase(PG8_LAS unsigned char* lds, const Gemm g, const Sched& S, const Epi& E, int wave_in) {
    int tid_; asm volatile("v_mbcnt_lo_u32_b32 %0, -1, 0\n\tv_mbcnt_hi_u32_b32 %0, -1, %0" : "=&v"(tid_)); tid_ |= wave_in << 6;
    const int tid = tid_, wid = __builtin_amdgcn_readfirstlane(tid >> 6), lane = tid & 63, wr = wid >> 2, wc = wid & 3, fr = lane & 15, fq = lane >> 4;
    const int K = g.K;
    unsigned voffA[2], voffB[2];
#pragma unroll
    for (int i = 0; i < 2; ++i) { int R, C; stage_rc(tid * 16 + i * 8192, R, C); const int Rb = Epi::PERM ? ((R & ~31) + perm32(R & 31)) : R;
        voffA[i] = (unsigned)(R * K + C) * 2u; voffB[i] = (unsigned)(Rb * K + C) * 2u; }
    const size_t kstep = (size_t)(BK * 2);
    const size_t hstep = (size_t)HALF * K * 2;
    const size_t tstep = 2 * hstep;
    const unsigned ldsw = (unsigned)wid * 1024u;
    const int aoff = lds_byte(wr * 64 + fr, fq * 8), boff = lds_byte(wc * 32 + fr, fq * 8);
#define PG8_SA(b, h) (((b) * 2 + (h)) * HTB)
#define PG8_SB(b, h) ((4 + (b) * 2 + (h)) * HTB)
#define PG8_STAGE(bufoff, gbase, voff) do { _Pragma("unroll") for (int _i = 0; _i < 2; ++_i) \
        __builtin_amdgcn_global_load_lds((const unsigned*)((const char*)(gbase) + (voff)[_i]), (PG8_LAS unsigned*)(lds + (bufoff) + ldsw + _i * 8192), 16, 0, 0); } while (0)
#define PG8_LDA(dst, b, h) do { _Pragma("unroll") for (int m = 0; m < 4; ++m) dst[m].ld(lds + PG8_SA(b, h) + aoff + m * 2048); } while (0)
#define PG8_LDB(dst, b, h) do { _Pragma("unroll") for (int n = 0; n < 2; ++n) dst[n].ld(lds + PG8_SB(b, h) + boff + n * 2048); } while (0)
#define PG8_MMA(ai, bj, At, Bt) do { __builtin_amdgcn_s_setprio(1); _Pragma("unroll") for (int m = 0; m < 4; ++m) _Pragma("unroll") for (int n = 0; n < 2; ++n) { \
        if constexpr (F8) {     \
              \
            asm volatile("v_mfma_scale_f32_16x16x128_f8f6f4 %0, %1, %2, %0, %3, %4 op_sel_hi:[0,0,0]" : "+v"(acc[ai][bj][m][n]) : "v"(Bt[n].w), "v"(At[m].w), "v"(g.sa), "v"(g.sb)); \
        } else { acc[ai][bj][m][n] = __builtin_amdgcn_mfma_f32_16x16x32_bf16(Bt[n].k0(), At[m].k0(), acc[ai][bj][m][n], 0, 0, 0); \
                 acc[ai][bj][m][n] = __builtin_amdgcn_mfma_f32_16x16x32_bf16(Bt[n].k1(), At[m].k1(), acc[ai][bj][m][n], 0, 0, 0); } } \
        __builtin_amdgcn_s_setprio(0); } while (0)
#define PG8_WAIT_V(n) asm volatile("s_waitcnt vmcnt(" #n ")" ::: "memory")
#define PG8_WAIT_L(n) asm volatile("s_waitcnt lgkmcnt(" #n ")" ::: "memory")
#define PG8_BAR __builtin_amdgcn_s_barrier()
#define PG8_SCHED __builtin_amdgcn_sched_barrier(0)
    Unit cur, nxt; int ui = 0;
    if (!S.next(0, cur)) return;
    f32x4 acc[2][2][4][2];
#pragma unroll
    for (int a = 0; a < 2; ++a)
#pragma unroll
        for (int b = 0; b < 2; ++b)
#pragma unroll
            for (int m = 0; m < 4; ++m)
#pragma unroll
                for (int n = 0; n < 2; ++n) acc[a][b][m][n] = (f32x4){0.f, 0.f, 0.f, 0.f};
    Frag2 At[4], B0[2], B1[2];
    const char* cA = (const char*)g.A + (size_t)cur.pm * tstep + (size_t)cur.kt0 * kstep; const char* cB = (const char*)g.Bt + (size_t)cur.pn * tstep + (size_t)cur.kt0 * kstep;
    S.a_ready(cur);
    if constexpr (SP2) {
        PG8_STAGE(PG8_SB(0, 0), cB, voffB); PG8_STAGE(PG8_SB(0, 1), cB + hstep, voffB); PG8_STAGE(PG8_SA(0, 0), cA, voffA); PG8_STAGE(PG8_SA(0, 1), cA + hstep, voffA);
        if (wr == 1) PG8_BAR;
        PG8_WAIT_V(2); PG8_BAR;
        PG8_STAGE(PG8_SB(1, 0), cB + kstep, voffB); PG8_STAGE(PG8_SA(1, 0), cA + kstep, voffA); PG8_STAGE(PG8_SB(1, 1), cB + hstep + kstep, voffB);
        PG8_WAIT_V(6); PG8_BAR;
    } else {
        PG8_STAGE(PG8_SB(0, 0), cB, voffB); PG8_STAGE(PG8_SA(0, 0), cA, voffA); PG8_STAGE(PG8_SB(0, 1), cB + hstep, voffB); PG8_STAGE(PG8_SA(0, 1), cA + hstep, voffA);
        if (wr == 1) PG8_BAR;
        PG8_WAIT_V(4); PG8_BAR;
        PG8_STAGE(PG8_SB(1, 0), cB + kstep, voffB); PG8_STAGE(PG8_SA(1, 0), cA + kstep, voffA); PG8_STAGE(PG8_SB(1, 1), cB + hstep + kstep, voffB);
        PG8_WAIT_V(6); PG8_BAR;
    }
    for (;;) {
        const bool has_next = S.next(ui + 1, nxt);
        const char* nA = has_next ? (const char*)g.A + (size_t)nxt.pm * tstep + (size_t)nxt.kt0 * kstep : cA; const char* nB = has_next ? (const char*)g.Bt + (size_t)nxt.pn * tstep + (size_t)nxt.kt0 * kstep : cB;
        const int nt = cur.nkt;
        for (int t = 0; t < nt; t += 2) {
            const bool last = (t == nt - 2);
            const char* a1 = cA + (size_t)(t + 1) * kstep;
            const char* a2 = last ? nA : cA + (size_t)(t + 2) * kstep; const char* b2 = last ? nB : cB + (size_t)(t + 2) * kstep;
            const char* a3 = a2 + kstep; const char* b3 = b2 + kstep;
            if (last && has_next) S.a_ready(nxt);
            if constexpr (SP2) {
            PG8_LDB(B0, 0, 0); PG8_LDB(B1, 0, 1); PG8_SCHED; PG8_LDA(At, 0, 0); PG8_STAGE(PG8_SA(1, 1), a1 + hstep, voffA);
            PG8_WAIT_V(8); PG8_WAIT_L(0); PG8_BAR; PG8_MMA(0, 0, At, B0); PG8_MMA(0, 1, At, B1); PG8_BAR; PG8_SCHED;
            PG8_LDA(At, 0, 1); PG8_STAGE(PG8_SB(0, 0), b2, voffB); PG8_STAGE(PG8_SB(0, 1), b2 + hstep, voffB); PG8_STAGE(PG8_SA(0, 0), a2, voffA);
            PG8_WAIT_V(8); PG8_WAIT_L(0); PG8_BAR; PG8_MMA(1, 0, At, B0); PG8_MMA(1, 1, At, B1); PG8_BAR; PG8_SCHED;
            PG8_LDB(B0, 1, 0); PG8_LDB(B1, 1, 1); PG8_SCHED; PG8_LDA(At, 1, 0); PG8_STAGE(PG8_SA(0, 1), a2 + hstep, voffA);
            PG8_WAIT_V(8); PG8_WAIT_L(0); PG8_BAR; PG8_MMA(0, 0, At, B0); PG8_MMA(0, 1, At, B1); PG8_BAR; PG8_SCHED;
            PG8_LDA(At, 1, 1); PG8_STAGE(PG8_SB(1, 0), b3, voffB); PG8_STAGE(PG8_SB(1, 1), b3 + hstep, voffB); PG8_STAGE(PG8_SA(1, 0), a3, voffA);
            PG8_WAIT_V(8); PG8_WAIT_L(0); PG8_BAR; PG8_MMA(1, 0, At, B0); PG8_MMA(1, 1, At, B1); PG8_BAR; PG8_SCHED;
            } else {
            PG8_LDB(B0, 0, 0); PG8_SCHED; PG8_LDA(At, 0, 0); PG8_STAGE(PG8_SA(1, 1), a1 + hstep, voffA);
            PG8_WAIT_L(8); PG8_BAR; PG8_WAIT_L(0); PG8_MMA(0, 0, At, B0); PG8_BAR; PG8_SCHED;
            PG8_LDB(B1, 0, 1); PG8_STAGE(PG8_SB(0, 0), b2, voffB);
            PG8_BAR; PG8_WAIT_L(0); PG8_MMA(0, 1, At, B1); PG8_BAR;
            PG8_LDA(At, 0, 1); PG8_STAGE(PG8_SA(0, 0), a2, voffA);
            PG8_BAR; PG8_WAIT_L(0); PG8_MMA(1, 0, At, B0); PG8_BAR; PG8_SCHED;
            PG8_STAGE(PG8_SB(0, 1), b2 + hstep, voffB);
            PG8_WAIT_V(6); PG8_BAR; PG8_MMA(1, 1, At, B1); PG8_BAR;
            PG8_LDB(B0, 1, 0); PG8_SCHED; PG8_LDA(At, 1, 0); PG8_STAGE(PG8_SA(0, 1), a2 + hstep, voffA);
            PG8_WAIT_L(8); PG8_BAR; PG8_WAIT_L(0); PG8_MMA(0, 0, At, B0); PG8_BAR; PG8_SCHED;
            PG8_LDB(B1, 1, 1); PG8_STAGE(PG8_SB(1, 0), b3, voffB);
            PG8_BAR; PG8_WAIT_L(0); PG8_MMA(0, 1, At, B1); PG8_BAR;
            PG8_LDA(At, 1, 1); PG8_STAGE(PG8_SA(1, 0), a3, voffA);
            PG8_BAR; PG8_WAIT_L(0); PG8_MMA(1, 0, At, B0); PG8_BAR; PG8_SCHED;
            PG8_STAGE(PG8_SB(1, 1), b3 + hstep, voffB);
            PG8_WAIT_V(6); PG8_BAR; PG8_MMA(1, 1, At, B1); PG8_BAR;
            }
        }
        if constexpr (ALIGN_EPI) { if (wr == 0) PG8_BAR; }
        if constexpr (F8) asm volatile("s_nop 15\n\ts_nop 15" ::: "memory");
        if constexpr (!Epi::AFTER_DRAIN) { E(acc, cur, wr, wc, fr, fq); S.done(cur); }
        if (!has_next) break;
#pragma unroll
        for (int a = 0; a < 2; ++a)
#pragma unroll
            for (int b = 0; b < 2; ++b)
#pragma unroll
                for (int m = 0; m < 4; ++m)
#pragma unroll
                    for (int n = 0; n < 2; ++n) acc[a][b][m][n] = (f32x4){0.f, 0.f, 0.f, 0.f};
        cur = nxt; cA = nA; cB = nB; ++ui;
        if constexpr (ALIGN_EPI) { if (wr == 1) PG8_BAR; }
    }
    PG8_WAIT_V(0);
    if constexpr (!ALIGN_EPI) { if (wr == 0) PG8_BAR; }
    PG8_BAR;
    if constexpr (Epi::AFTER_DRAIN) { E.fused(acc, cur, wr, wc, fr, fq, lds, wid, lane); S.done(cur); }
#undef PG8_SA
#undef PG8_SB
#undef PG8_STAGE
#undef PG8_LDA
#undef PG8_LDB
#undef PG8_MMA
#undef PG8_WAIT_V
#undef PG8_WAIT_L
#undef PG8_BAR
#undef PG8_SCHED
}
}

#define GAS __attribute__((address_space(1)))
#define LAS __attribute__((address_space(3)))
typedef unsigned short bf16;
typedef unsigned v4u __attribute__((ext_vector_type(4)));
typedef unsigned v2u __attribute__((ext_vector_type(2)));
typedef float f32x4 __attribute__((ext_vector_type(4)));
#define LDS_WAIT() asm volatile("s_waitcnt lgkmcnt(0)" ::: "memory")
#define VM_WAIT() asm volatile("s_waitcnt vmcnt(0)" ::: "memory")

#define XB_TMO      128
#define XB_XCNT(j)  (256  + 64 * (j))
#define XB_XSUB(j)  (1280 + 64 * (j))
#define XB_XGEN(j)  (2304 + 64 * (j))
#define XB_TOP      3328
#define XB_TOPGEN   3392
#define XCD_BAR_WORDS 3456
#define XB_SPIN_CAP (1u << 18)

__device__ __forceinline__ unsigned xb_ld(unsigned* p)              { return __hip_atomic_load(p, __ATOMIC_RELAXED, __HIP_MEMORY_SCOPE_AGENT); }
__device__ __forceinline__ unsigned xb_add(unsigned* p, unsigned v) { return __hip_atomic_fetch_add(p, v, __ATOMIC_RELAXED, __HIP_MEMORY_SCOPE_AGENT); }
__device__ __forceinline__ unsigned xb_xcc_id() { return (unsigned)__builtin_amdgcn_s_getreg((3 << 11) | 20) & 0xFu; }
#define XB_SPIN(cond, bar) do { unsigned _sp = 0; while (cond) { __builtin_amdgcn_s_sleep(1); \
    if ((++_sp & 255u) == 0u) { if (xb_ld(&(bar)[XB_TMO])) break; if (_sp > XB_SPIN_CAP) { atomicAdd(&(bar)[XB_TMO], 1u); break; } } } } while (0)

struct XcdBarrier {
    int tid;
    unsigned* bar; unsigned x;
    volatile LAS unsigned* st;
};

__device__ __forceinline__ XcdBarrier xcd_barrier_post(unsigned* bar, volatile LAS unsigned* st, int tid) {
    XcdBarrier b; b.tid = tid; b.bar = bar; b.x = xb_xcc_id(); b.st = st;
    if (tid == 0) (void)xb_add(&bar[XB_XCNT(b.x)], 1u);
    return b;
}
__device__ __forceinline__ void xcd_barrier_complete(unsigned* bar, unsigned x, unsigned& nloc, unsigned& nx) {
    const unsigned G = gridDim.x * gridDim.y * gridDim.z;
    unsigned sum, cnt, mine, sp = 0u;
    for (;;) {
        sum = 0u; cnt = 0u; mine = 0u;
#pragma unroll
        for (unsigned j = 0; j < 16; ++j) { const unsigned c = xb_ld(&bar[XB_XCNT(j)]); sum += c; cnt += (c > 0u) ? 1u : 0u; mine = (j == x) ? c : mine; }
        if (sum == G) break;
        __builtin_amdgcn_s_sleep(1);
        if ((++sp & 255u) == 0u) { if (xb_ld(&bar[XB_TMO])) break; if (sp > XB_SPIN_CAP) { atomicAdd(&bar[XB_TMO], 1u); break; } }
    }
    nloc = mine > 0u ? mine : 1u; nx = cnt > 0u ? cnt : 1u;
}

__device__ __forceinline__ void xcd_barrier(const XcdBarrier& b) {
    asm volatile("s_waitcnt vmcnt(0)" ::: "memory");
    __syncthreads();
    if (b.tid == 0) {
        unsigned* bar = b.bar;
        __builtin_amdgcn_s_waitcnt(0);
        unsigned nloc = b.st[0], nx = b.st[1];
        if (nloc == 0u) { xcd_barrier_complete(bar, b.x, nloc, nx); b.st[0] = nloc; b.st[1] = nx; }
        const unsigned old = xb_add(&bar[XB_XSUB(b.x)], 1u);
        const unsigned gen = old / nloc;
        if (old + 1u == (gen + 1u) * nloc) {
            __builtin_amdgcn_fence(__ATOMIC_RELEASE, "agent");
            asm volatile("s_waitcnt vmcnt(0)" ::: "memory");
            const unsigned og = xb_add(&bar[XB_TOP], 1u);
            const unsigned tg = og / nx;
            if (og + 1u == (tg + 1u) * nx) xb_add(&bar[XB_TOPGEN], 1u);
            else XB_SPIN(xb_ld(&bar[XB_TOPGEN]) == tg, bar);
            __builtin_amdgcn_fence(__ATOMIC_ACQUIRE, "agent");
            xb_add(&bar[XB_XGEN(b.x)], 1u);
            asm volatile("s_waitcnt vmcnt(0)" ::: "memory");
        } else {
            XB_SPIN(xb_ld(&bar[XB_XGEN(b.x)]) == gen, bar);
            __builtin_amdgcn_fence(__ATOMIC_ACQUIRE, "agent");
            asm volatile("s_waitcnt vmcnt(0)" ::: "memory");
        }
    }
    __syncthreads();
}
namespace att {
using bf16 = unsigned short;
using bf16x8 = __attribute__((ext_vector_type(8))) short;
using s16x4  = __attribute__((ext_vector_type(4))) short;
using f32x16 = __attribute__((ext_vector_type(16))) float;
using f32x4  = __attribute__((ext_vector_type(4))) float;
using u32x4  = __attribute__((ext_vector_type(4))) unsigned;
typedef int v4i_att __attribute__((ext_vector_type(4)));
typedef int v8i_att __attribute__((ext_vector_type(8)));
typedef int v2i_att __attribute__((ext_vector_type(2)));
constexpr int NW = 8, QBLK = 32, KVBLK = 64, DV = 128;
constexpr float THR = 8.f;
#define ATT_SBAR() __builtin_amdgcn_sched_barrier(0)
#define ATT_LAS __attribute__((address_space(3)))
__device__ __forceinline__ int crow(int r, int hi) { return (r & 3) + 8 * (r >> 2) + 4 * hi; }
__device__ __forceinline__ unsigned cvtpk(float lo, float hi) { unsigned r; asm volatile("v_cvt_pk_bf16_f32 %0, %1, %2" : "=v"(r) : "v"(lo), "v"(hi)); return r; }

__device__ __forceinline__ float att_shx(float v, int lane, int o) { return __builtin_bit_cast(float, __builtin_amdgcn_ds_bpermute((lane ^ o) << 2, __builtin_bit_cast(int, v))); }
struct CfgGQA { static constexpr int LDVT = 8448, NS = 2, KROWB = 128, RB = 128, DQK = 128, LDQ = 3072, LDK = 512, LDV = 3072, LDO = 2048, SDEPTH = 0; static constexpr bool MLA = false, MSUM = false; static constexpr float SCALE = 0.088388347648318440f; };
struct CfgMLA { static constexpr int LDVT = 8448, NS = 3, KROWB = 192, RB = 256, DQK = 192, LDQ = 3072, LDK = 3072, LDV = 4096, LDO = 2048, SDEPTH = 0; static constexpr bool MLA = true, MSUM = false;  static constexpr float SCALE = 0.072168783648703220f; };

__device__ __forceinline__ float max3f(float a, float b, float c) { float r; asm("v_max3_f32 %0, %1, %2, %3" : "=v"(r) : "v"(a), "v"(b), "v"(c)); return r; }
__device__ __forceinline__ float max2f(float a, float b) { float r; asm("v_max_f32_e32 %0, %1, %2" : "=v"(r) : "v"(a), "v"(b)); return r; }
__device__ __forceinline__ float max8(const f32x16& p, int base) {
  return max2f(max3f(max3f(max3f(p[base], p[base + 1], p[base + 2]), p[base + 3], p[base + 4]), p[base + 5], p[base + 6]), p[base + 7]);
}
template <bool FIRST>
__device__ __forceinline__ void decideSM(f32x16& p0, f32x16& p1, float pmax, float& m_reg, f32x16& negm, float& alpha) {
  constexpr float THRL = THR * 1.4426950408889634f;
  { auto rr = __builtin_amdgcn_permlane32_swap(__float_as_uint(pmax), __float_as_uint(pmax), false, false);
    pmax = fmaxf(__uint_as_float(rr[0]), __uint_as_float(rr[1])); }
  if (!FIRST && __builtin_expect(__all(pmax <= THRL), 1)) { alpha = 1.f; }
  else { const float d = FIRST ? pmax : fmaxf(pmax, 0.f); alpha = FIRST ? 0.f : __builtin_amdgcn_exp2f(-d); m_reg += d;
#pragma unroll
    for (int r = 0; r < 16; ++r) { p0[r] -= d; p1[r] -= d; negm[r] -= d; } }
}
template <bool SUMV>
__device__ __forceinline__ void finishSM(f32x16& p0, f32x16& p1, float alpha, float& l_reg, bf16x8& pa0, bf16x8& pa1, bf16x8& pa2, bf16x8& pa3) {
#pragma unroll
  for (int r = 0; r < 16; ++r) p0[r] = __builtin_amdgcn_exp2f(p0[r]);
#pragma unroll
  for (int r = 0; r < 16; ++r) p1[r] = __builtin_amdgcn_exp2f(p1[r]);
  if constexpr (SUMV) { float ps = 0;
#pragma unroll
  for (int r = 0; r < 16; ++r) ps += p0[r];
#pragma unroll
  for (int r = 0; r < 16; ++r) ps += p1[r];
  { auto rr = __builtin_amdgcn_permlane32_swap(__float_as_uint(ps), __float_as_uint(ps), false, false);
    ps = __uint_as_float(rr[0]) + __uint_as_float(rr[1]); }
  l_reg = l_reg * alpha + ps; }
#define ATT_PKB(P, B) __builtin_amdgcn_cvt_pk_bf8_f32(P[B + 2], P[B + 3], __builtin_amdgcn_cvt_pk_bf8_f32(P[B], P[B + 1], 0, false), true)
  { const v4i_att w0 = {ATT_PKB(p0, 0), ATT_PKB(p0, 4), ATT_PKB(p0, 8), ATT_PKB(p0, 12)}, w1 = {ATT_PKB(p1, 0), ATT_PKB(p1, 4), ATT_PKB(p1, 8), ATT_PKB(p1, 12)};
    pa0 = __builtin_bit_cast(bf16x8, w0); pa1 = __builtin_bit_cast(bf16x8, w1); pa2 = pa0; pa3 = pa1; }
#undef ATT_PKB
}
__device__ __forceinline__ void finishU8(const f32x16& p0, const f32x16& p1, bf16x8& pa0, bf16x8& pa1) {
  v4i_att w0 = {0, 0, 0, 0}, w1 = {0, 0, 0, 0};
#pragma unroll
  for (int r = 0; r < 16; ++r) { w0[r >> 2] = (int)__builtin_amdgcn_cvt_pk_u8_f32(p0[r], r & 3, (unsigned)w0[r >> 2]); w1[r >> 2] = (int)__builtin_amdgcn_cvt_pk_u8_f32(p1[r], r & 3, (unsigned)w1[r >> 2]); }
  pa0 = __builtin_bit_cast(bf16x8, w0); pa1 = __builtin_bit_cast(bf16x8, w1);
}
__device__ __forceinline__ void rowsum16(f32x4& ls, bf16x8 pa0, bf16x8 pa1, const v8i_att& bones) {
  constexpr int ONE = 0x7f7f7f7f;
  const v4i_att a0 = __builtin_bit_cast(v4i_att, pa0), a1 = __builtin_bit_cast(v4i_att, pa1);
  const v8i_att A = {a0[0], a0[1], a0[2], a0[3], a1[0], a1[1], a1[2], a1[3]};
  asm volatile("s_nop 1\n\tv_mfma_scale_f32_16x16x128_f8f6f4 %0, %1, %2, %0, %3, %3 op_sel_hi:[0,0,0] cbsz:1" : "+v"(ls) : "v"(A), "v"(bones), "v"(ONE));
}
typedef int v8i __attribute__((ext_vector_type(8)));
typedef int v4i __attribute__((ext_vector_type(4)));
template <int RB> __device__ __forceinline__ int kswf(int row) { return RB == 128 ? ((row >> 1) & 7) : (row & 15); }
template <int RB> __device__ __forceinline__ int kswz8(int row, int chunk) { return row * RB + ((chunk ^ kswf<RB>(row)) << 4); }
template <class Cfg, int SA>
__device__ __forceinline__ void qkt(f32x16& p0, f32x16& p1, const char* Ks, const v8i* q8, const f32x16& negm, int r32, int hi) {
  constexpr int ONE = 0x7f7f7f7f;
#pragma unroll
  for (int s = 0; s < Cfg::NS; ++s) { const int c = 4 * s + 2 * hi;
    const v4i a0 = *reinterpret_cast<const v4i*>(Ks + kswz8<Cfg::RB>(r32, c)), a1 = *reinterpret_cast<const v4i*>(Ks + kswz8<Cfg::RB>(r32, c + 1));
    const v4i b0 = *reinterpret_cast<const v4i*>(Ks + kswz8<Cfg::RB>(32 + r32, c)), b1 = *reinterpret_cast<const v4i*>(Ks + kswz8<Cfg::RB>(32 + r32, c + 1));
    const v8i A = {a0[0], a0[1], a0[2], a0[3], a1[0], a1[1], a1[2], a1[3]}, B = {b0[0], b0[1], b0[2], b0[3], b1[0], b1[1], b1[2], b1[3]};
    if (s == 0) { p0 = __builtin_amdgcn_mfma_scale_f32_32x32x64_f8f6f4(A, q8[0], negm, 2, 2, 0, SA, 0, ONE); p1 = __builtin_amdgcn_mfma_scale_f32_32x32x64_f8f6f4(B, q8[0], negm, 2, 2, 0, SA, 0, ONE); }
    else { p0 = __builtin_amdgcn_mfma_scale_f32_32x32x64_f8f6f4(A, q8[s], p0, 2, 2, 0, SA, 0, ONE); p1 = __builtin_amdgcn_mfma_scale_f32_32x32x64_f8f6f4(B, q8[s], p1, 2, 2, 0, SA, 0, ONE); } }
}
__device__ __forceinline__ int pk4_fp8(float a, float b, float c, float d) { int w = 0; w = __builtin_amdgcn_cvt_pk_fp8_f32(a, b, w, false); w = __builtin_amdgcn_cvt_pk_fp8_f32(c, d, w, true); return w; }
template <int D0> __device__ __forceinline__ void pv_one(f32x16& od, const char* vrow, int vd, bf16x8 pa0, bf16x8 pa1, bf16x8, bf16x8) {
  constexpr int ONE = 0x7f7f7f7f;
  const v4i_att b0 = *reinterpret_cast<const v4i_att*>(vrow + D0 * 2048), b1 = *reinterpret_cast<const v4i_att*>(vrow + D0 * 2048 + vd);
  asm volatile("s_waitcnt lgkmcnt(0)" ::: "memory"); ATT_SBAR();
  const v4i_att a0 = __builtin_bit_cast(v4i_att, pa0), a1 = __builtin_bit_cast(v4i_att, pa1);
  const v8i_att A = {a0[0], a0[1], a0[2], a0[3], a1[0], a1[1], a1[2], a1[3]}, B = {b0[0], b0[1], b0[2], b0[3], b1[0], b1[1], b1[2], b1[3]};
  asm volatile("s_nop 1\n\tv_mfma_scale_f32_32x32x64_f8f6f4 %0, %1, %2, %0, %3, %3 op_sel_hi:[0,0,0] cbsz:1" : "+v"(od) : "v"(A), "v"(B), "v"(ONE));
}
__device__ __forceinline__ void pv_rowsum_unused(f32x16& lacc, bf16x8 pa0, bf16x8 pa1, bf16x8 pa2, bf16x8 pa3) {
  const bf16x8 ones = {(short)0x3F80, (short)0x3F80, (short)0x3F80, (short)0x3F80, (short)0x3F80, (short)0x3F80, (short)0x3F80, (short)0x3F80};
  lacc = __builtin_amdgcn_mfma_f32_32x32x16_bf16(pa0, ones, lacc, 0, 0, 0); lacc = __builtin_amdgcn_mfma_f32_32x32x16_bf16(pa1, ones, lacc, 0, 0, 0);
  lacc = __builtin_amdgcn_mfma_f32_32x32x16_bf16(pa2, ones, lacc, 0, 0, 0); lacc = __builtin_amdgcn_mfma_f32_32x32x16_bf16(pa3, ones, lacc, 0, 0, 0);
}
#define ATT_CVT1(W, X, SEL) asm volatile("v_cvt_pk_u8_f32 %0, %1, " #SEL ", %0" : "+v"(W) : "v"(X))
#define ATT_CVT8(P, B, W, I) do { int c0_, c1_; asm volatile("v_cvt_pk_u8_f32 %0, %1, 0, 0" : "=v"(c0_) : "v"(P[B])); asm volatile("v_cvt_pk_u8_f32 %0, %1, 0, 0" : "=v"(c1_) : "v"(P[B + 4])); \
    ATT_CVT1(c0_, P[B + 1], 1); ATT_CVT1(c1_, P[B + 5], 1); ATT_CVT1(c0_, P[B + 2], 2); ATT_CVT1(c1_, P[B + 6], 2); ATT_CVT1(c0_, P[B + 3], 3); ATT_CVT1(c1_, P[B + 7], 3); \
    W[I] = c0_; W[I + 1] = c1_; } while (0)
#define ATT_CVT16(P, W) do { int c0_, c1_, c2_, c3_; asm volatile("v_cvt_pk_u8_f32 %0, %1, 0, 0" : "=v"(c0_) : "v"(P[0])); asm volatile("v_cvt_pk_u8_f32 %0, %1, 0, 0" : "=v"(c1_) : "v"(P[4])); \
    asm volatile("v_cvt_pk_u8_f32 %0, %1, 0, 0" : "=v"(c2_) : "v"(P[8])); asm volatile("v_cvt_pk_u8_f32 %0, %1, 0, 0" : "=v"(c3_) : "v"(P[12])); \
    ATT_CVT1(c0_, P[1], 1); ATT_CVT1(c1_, P[5], 1); ATT_CVT1(c2_, P[9], 1); ATT_CVT1(c3_, P[13], 1); ATT_CVT1(c0_, P[2], 2); ATT_CVT1(c1_, P[6], 2); ATT_CVT1(c2_, P[10], 2); ATT_CVT1(c3_, P[14], 2); \
    ATT_CVT1(c0_, P[3], 3); ATT_CVT1(c1_, P[7], 3); ATT_CVT1(c2_, P[11], 3); ATT_CVT1(c3_, P[15], 3); W[0] = c0_; W[1] = c1_; W[2] = c2_; W[3] = c3_; } while (0)
#define ATT_PVM(OD, B0, B1) do { const v8i_att B_ = {B0[0], B0[1], B0[2], B0[3], B1[0], B1[1], B1[2], B1[3]}; \
    asm volatile("s_nop 1\n\tv_mfma_scale_f32_32x32x64_f8f6f4 %0, %1, %2, %0, %3, %3 op_sel_hi:[0,0,0] cbsz:1" : "+v"(OD) : "v"(A), "v"(B_), "v"(ONE)); } while (0)
template <bool CVT>
__device__ __forceinline__ void pv_cvt(f32x16* o, f32x4& lsum, const char* vb, int vd, const v4i_att& a0, const v4i_att& a1, const f32x16& p0, const f32x16& p1, v4i_att& w0, v4i_att& w1, const v8i_att& bones) {
  constexpr int ONE = 0x7f7f7f7f;
  const v8i_att A = {a0[0], a0[1], a0[2], a0[3], a1[0], a1[1], a1[2], a1[3]};
  const v4i_att b00 = *reinterpret_cast<const v4i_att*>(vb), b01 = *reinterpret_cast<const v4i_att*>(vb + vd); ATT_SBAR();
  const v4i_att b10 = *reinterpret_cast<const v4i_att*>(vb + 2048), b11 = *reinterpret_cast<const v4i_att*>(vb + 2048 + vd);
  asm volatile("s_waitcnt lgkmcnt(2)" ::: "memory"); ATT_SBAR();
  ATT_PVM(o[0], b00, b01); ATT_SBAR();
  if constexpr (CVT) { asm volatile("s_nop 7" ::: "memory"); ATT_CVT8(p0, 0, w0, 0); }
  const v4i_att b20 = *reinterpret_cast<const v4i_att*>(vb + 4096), b21 = *reinterpret_cast<const v4i_att*>(vb + 4096 + vd);
  asm volatile("s_waitcnt lgkmcnt(2)" ::: "memory"); ATT_SBAR();
  ATT_PVM(o[1], b10, b11); ATT_SBAR();
  if constexpr (CVT) ATT_CVT8(p0, 8, w0, 2);
  const v4i_att b30 = *reinterpret_cast<const v4i_att*>(vb + 6144), b31 = *reinterpret_cast<const v4i_att*>(vb + 6144 + vd);
  asm volatile("s_waitcnt lgkmcnt(2)" ::: "memory"); ATT_SBAR();
  ATT_PVM(o[2], b20, b21); ATT_SBAR();
  if constexpr (CVT) ATT_CVT8(p1, 0, w1, 0);
  asm volatile("s_waitcnt lgkmcnt(0)" ::: "memory"); ATT_SBAR();
  ATT_PVM(o[3], b30, b31); ATT_SBAR();
  if constexpr (CVT) ATT_CVT8(p1, 8, w1, 2);
  asm volatile("s_nop 1\n\tv_mfma_scale_f32_16x16x128_f8f6f4 %0, %1, %2, %0, %3, %3 op_sel_hi:[0,0,0] cbsz:1" : "+v"(lsum) : "v"(A), "v"(bones), "v"(ONE));
  ATT_SBAR();
}
#define ATT_DSR(X, ADDR, OFF) asm volatile("ds_read_b128 %0, %1 offset:%2" : "=v"(X) : "v"(ADDR), "n"(OFF))
#define ATT_RK(F, S, ROFF) do { v4i x0_; v2i_att x1_; ATT_DSR(x0_, ka[2 * (S)] + kbo, (ROFF) * Cfg::RB); asm volatile("ds_read_b64 %0, %1 offset:%2" : "=v"(x1_) : "v"(ka[2 * (S) + 1] + kbo), "n"((ROFF) * Cfg::RB)); \
    F = (v8i){x0_[0], x0_[1], x0_[2], x0_[3], x1_[0], x1_[1], 0, 0}; ATT_SBAR(); } while (0)
#define ATT_RV(F, D) do { v4i x0_, x1_; ATT_DSR(x0_, va0 + vbo, (D) * 2048); ATT_DSR(x1_, va1 + vbo, (D) * 2048); \
    F = (v8i){x0_[0], x0_[1], x0_[2], x0_[3], x1_[0], x1_[1], x1_[2], x1_[3]}; ATT_SBAR(); } while (0)
#define ATT_LW(N) do { asm volatile("s_waitcnt lgkmcnt(" #N ")" ::: "memory"); ATT_SBAR(); } while (0)
#define ATT_QKM(PX, F, S) do { if ((S) == 0) PX = __builtin_amdgcn_mfma_scale_f32_32x32x64_f8f6f4(F, q8[S], negm, 2, 2, 0, SA, 0, ONE); else PX = __builtin_amdgcn_mfma_scale_f32_32x32x64_f8f6f4(F, q8[S], PX, 2, 2, 0, SA, 0, ONE); ATT_SBAR(); } while (0)
#define ATT_PVF(OD, F) do { asm volatile("s_nop 1\n\tv_mfma_scale_f32_32x32x64_f8f6f4 %0, %1, %2, %0, %3, %3 op_sel_hi:[0,0,0] cbsz:1" : "+v"(OD) : "v"(A), "v"(F), "v"(ONE)); ATT_SBAR(); } while (0)
#define ATT_PRE(KBN) do { const int kbo = (KBN); ATT_RK(fa, 0, 0); ATT_RK(fb, 0, 32); ATT_RK(fc, 1, 0); } while (0)
#define ATT_STEP_BODY(MID, PRE) do { constexpr int ONE = 0x7f7f7f7f; \
    const v8i A = {a0[0], a0[1], a0[2], a0[3], a1[0], a1[1], a1[2], a1[3]}; \
    ATT_SBAR(); \
    if constexpr (Cfg::NS == 2) { \
      ATT_LW(4); ATT_QKM(p0, fa, 0); ATT_RK(fa, 1, 32); \
      ATT_LW(4); ATT_QKM(p1, fb, 0); ATT_RV(fb, 0); \
      ATT_LW(4); ATT_QKM(p0, fc, 1); ATT_RV(fc, 1); \
      ATT_LW(4); ATT_QKM(p1, fa, 1); MID; ATT_RV(fa, 2); \
      ATT_LW(4); ATT_PVF(o[0], fb); asm volatile("s_nop 7" ::: "memory"); ATT_CVT16(p0, w0); ATT_RV(fb, 3); \
      ATT_LW(4); ATT_PVF(o[1], fc);  \
      ATT_LW(2); ATT_PVF(o[2], fa); ATT_CVT16(p1, w1); \
      ATT_LW(0); ATT_PVF(o[3], fb);  \
    } else { \
      ATT_LW(4); ATT_QKM(p0, fa, 0); ATT_RK(fa, 1, 32); \
      ATT_LW(4); ATT_QKM(p1, fb, 0); ATT_RK(fb, 2, 0); \
      ATT_LW(4); ATT_QKM(p0, fc, 1); ATT_RK(fc, 2, 32); \
      ATT_LW(4); ATT_QKM(p1, fa, 1); ATT_RV(fa, 0); \
      ATT_LW(4); ATT_QKM(p0, fb, 2); ATT_RV(fb, 1); \
      ATT_LW(4); ATT_QKM(p1, fc, 2); MID; ATT_RV(fc, 2); \
      ATT_LW(4); ATT_PVF(o[0], fa); asm volatile("s_nop 7" ::: "memory"); ATT_CVT16(p0, w0); ATT_RV(fa, 3); \
      ATT_LW(4); ATT_PVF(o[1], fb);  \
      ATT_LW(2); ATT_PVF(o[2], fc); ATT_CVT16(p1, w1); \
      ATT_LW(0); ATT_PVF(o[3], fa);  \
    } \
    asm volatile("s_nop 1\n\tv_mfma_scale_f32_16x16x128_f8f6f4 %0, %1, %2, %0, %3, %3 op_sel_hi:[0,0,0] cbsz:1" : "+v"(lsum) : "v"(A), "v"(bones), "v"(ONE)); ATT_SBAR(); PRE; } while (0)
#undef ATT_PVM
__device__ __forceinline__ void pv_d0(f32x16* o, const char* vb, int vd, bf16x8 pa0, bf16x8 pa1, bf16x8 pa2, bf16x8 pa3) {
  pv_one<0>(o[0], vb, vd, pa0, pa1, pa2, pa3); pv_one<1>(o[1], vb, vd, pa0, pa1, pa2, pa3); pv_one<2>(o[2], vb, vd, pa0, pa1, pa2, pa3); pv_one<3>(o[3], vb, vd, pa0, pa1, pa2, pa3);
}
__device__ __forceinline__ float pv_d0_max(f32x16* o, const char* vb, int vd, bf16x8 pa0, bf16x8 pa1, bf16x8 pa2, bf16x8 pa3, const f32x16& x0, const f32x16& x1) {
  pv_one<0>(o[0], vb, vd, pa0, pa1, pa2, pa3); const float m0 = max8(x0, 0);
  pv_one<1>(o[1], vb, vd, pa0, pa1, pa2, pa3); const float m1 = max8(x0, 8);
  pv_one<2>(o[2], vb, vd, pa0, pa1, pa2, pa3); const float m2 = max8(x1, 0);
  pv_one<3>(o[3], vb, vd, pa0, pa1, pa2, pa3); const float m3 = max8(x1, 8);
  return max2f(max3f(m0, m1, m2), m3);
}
__device__ __forceinline__ void unpack8(bf16x8 v, float* f) {
  const u32x4 w = *reinterpret_cast<const u32x4*>(&v);
#pragma unroll
  for (int k = 0; k < 4; ++k) { f[2 * k] = __uint_as_float(w[k] << 16); f[2 * k + 1] = __uint_as_float(w[k] & 0xffff0000u); }
}
__device__ __forceinline__ void rope8(float* a, float* b, const float* cs, const float* sn) {
  const f32x4 c0 = *(const f32x4*)cs, c1 = *(const f32x4*)(cs + 4), s0 = *(const f32x4*)sn, s1 = *(const f32x4*)(sn + 4);
#pragma unroll
  for (int i = 0; i < 8; ++i) { const float c = i < 4 ? c0[i & 3] : c1[i & 3], s = i < 4 ? s0[i & 3] : s1[i & 3]; const float x = a[i], y = b[i]; a[i] = x * c - y * s; b[i] = y * c + x * s; }
}

template <class Cfg, bool STATIC>
__device__ __forceinline__ void attn_unit(const bf16* __restrict__ Qn, const bf16* __restrict__ Qp, const unsigned char* __restrict__ Kh, const unsigned char* __restrict__ Vh,
                                          bf16* __restrict__ Ob, int seq, ATT_LAS unsigned char* ldsL, char* lds, int t0, const float* __restrict__ gq_n, const float* __restrict__ gq_p, const float* __restrict__ rope_tab, float mbound, int wave_in, int var = 0) {
  constexpr int DQK = Cfg::DQK, LDQ = Cfg::LDQ, LDK = Cfg::LDK, LDV = Cfg::LDV, LDO = Cfg::LDO;
  constexpr bool MSUM = Cfg::MSUM;
  constexpr int SHM_V = KVBLK * DV, SHM_K = KVBLK * Cfg::RB, NCH = Cfg::RB / 16, KPT = KVBLK * NCH / 512, NV = KPT + 1, NB = STATIC ? 4 : 3, KOFF = NB * SHM_V, NS = Cfg::NS, LDVT = Cfg::LDVT;
  int tid_; asm volatile("v_mbcnt_lo_u32_b32 %0, -1, 0\n\tv_mbcnt_hi_u32_b32 %0, -1, %0" : "=&v"(tid_)); tid_ |= wave_in << 6;
  const int tid = tid_, wid = __builtin_amdgcn_readfirstlane(tid >> 6), lane = tid & 63, r32 = lane & 31, hi = lane >> 5;
  char* V_lds = lds; char* K_lds = lds + KOFF;
  float* ws = (float*)(lds + KOFF + NB * SHM_K) + wid * 64; float* li_l = ws; float* al_l = ws + 32;
  unsigned kgo[KPT], vgo[2];
#pragma unroll
  for (int k = 0; k < KPT; ++k) { const int s = (k * 8 + wid) * 64 + lane, row = s / NCH, csw = s - row * NCH, c = csw ^ kswf<Cfg::RB>(row); kgo[k] = (unsigned)(row * LDK + (c * 16 < Cfg::KROWB ? c * 16 : 0)); }
  { const int s16 = wid * 64 + lane, d = s16 >> 2, c = (s16 & 3) ^ ((d >> 2) & 3); vgo[0] = (unsigned)(d * LDVT + c * 16); vgo[1] = 0u; }
#define ATT_ISSUE_K(b, k0) do { const char* kt_ = (const char*)Kh + (long)(k0) * LDK; asm volatile("" : "+s"(kt_));     \
    _Pragma("unroll") for (int k_ = 0; k_ < KPT; ++k_) __builtin_amdgcn_global_load_lds((const unsigned*)(kt_ + (size_t)kgo[k_]), (ATT_LAS unsigned*)(ldsL + KOFF + (b) * SHM_K + (k_ * 8 + wid) * 1024), 16, 0, 0); } while (0)
#define ATT_ISSUE_V(b, k0) do { const char* vt_ = (const char*)Vh + (k0); asm volatile("" : "+s"(vt_));        \
    __builtin_amdgcn_global_load_lds((const unsigned*)(vt_ + (size_t)vgo[0]), (ATT_LAS unsigned*)(ldsL + (b) * SHM_V + wid * 1024), 16, 0, 0); } while (0)
#define ATT_ISSUE(b, k0) do { ATT_ISSUE_K(b, k0); ATT_ISSUE_V(b, k0); } while (0)
#define ATT_WAITV_NV() do { if constexpr (NV == 2) asm volatile("s_waitcnt vmcnt(2)" ::: "memory"); else asm volatile("s_waitcnt vmcnt(3)" ::: "memory"); } while (0)
#define ATT_WAITV_2NV() do { if constexpr (NV == 2) asm volatile("s_waitcnt vmcnt(4)" ::: "memory"); else asm volatile("s_waitcnt vmcnt(6)" ::: "memory"); } while (0)
#define ATT_BAR() do { asm volatile("s_waitcnt lgkmcnt(0)" ::: "memory"); __builtin_amdgcn_s_barrier(); asm volatile("" ::: "memory"); } while (0)
  float m_reg = 0.f, l_reg = 0; f32x16 negm = {}; v8i q8[NS];
  if constexpr (STATIC) {
#pragma unroll
    for (int r = 0; r < 16; ++r) negm[r] = 4.f * (15.5f - mbound) + 60.5f; }
  {
    const bf16* qrow = Qn + (long)(wid * QBLK + r32) * LDQ;
    const bf16* prow = Qp + (long)(wid * QBLK + r32) * LDQ;
    const int t = (t0 >= 0 ? t0 : 0) + wid * QBLK + r32, pr = t >> 6, pc = t & 63; const bool do_rope = t0 >= 0;
    constexpr float CQ = Cfg::SCALE * 1.4426950408889634f * 16.f;
    float ssn = 0.f, ssp = 0.f;
#pragma unroll
    for (int s = 0; s < NS; ++s) {
#pragma unroll
      for (int c = 0; c < 4; ++c) {
        const bf16* src;
        if constexpr (Cfg::MLA) src = (s < 2 ? qrow + 64 * s + 32 * hi : prow + 32 * hi) + 8 * c;
        else src = qrow + 64 * s + 16 * hi + (c & 1) * 8 + (c >> 1) * 32;
        float f[8]; unpack8(*reinterpret_cast<const bf16x8*>(src), f); float sq = 0.f;
#pragma unroll
        for (int i = 0; i < 8; ++i) sq += f[i] * f[i];
        if (Cfg::MLA && s == 2) ssp += sq; else ssn += sq; } }
    ssn += att_shx(ssn, lane, 32); ssp += att_shx(ssp, lane, 32);
    const float rn = rsqrtf(ssn * (1.f / 128.f) + 1e-6f) * CQ, rp = rsqrtf(ssp * (1.f / 64.f) + 1e-6f) * CQ;
#define ATT_SCALE8(f, r, gp) do { const f32x4 g0_ = *(const f32x4*)(gp), g1_ = *(const f32x4*)((gp) + 4); \
      _Pragma("unroll") for (int i_ = 0; i_ < 8; ++i_) f[i_] *= (r) * (i_ < 4 ? g0_[i_ & 3] : g1_[i_ & 3]); } while (0)
#pragma unroll
    for (int s = 0; s < NS; ++s) {
      float fa0[8], fa1[8], fb0[8], fb1[8];
      if constexpr (Cfg::MLA) {
        const bf16* src = s < 2 ? qrow + 64 * s + 32 * hi : prow + 32 * hi; const float* gp = s < 2 ? gq_n + 64 * s + 32 * hi : gq_p + 32 * hi; const float r = s < 2 ? rn : rp;
        unpack8(*reinterpret_cast<const bf16x8*>(src), fa0); unpack8(*reinterpret_cast<const bf16x8*>(src + 8), fa1); unpack8(*reinterpret_cast<const bf16x8*>(src + 16), fb0); unpack8(*reinterpret_cast<const bf16x8*>(src + 24), fb1);
        ATT_SCALE8(fa0, r, gp); ATT_SCALE8(fa1, r, gp + 8); ATT_SCALE8(fb0, r, gp + 16); ATT_SCALE8(fb1, r, gp + 24);
        if (s == 2 && do_rope) { const float* cs = rope_tab; const float* sn = rope_tab + 128 * 16; const int p = hi ? pc : pr;
          rope8(fa0, fb0, cs + p * 16, sn + p * 16); rope8(fa1, fb1, cs + p * 16 + 8, sn + p * 16 + 8); }
      } else {
        const bf16* src = qrow + 64 * s + 16 * hi; const float* gp = gq_n + 64 * s + 16 * hi;
        unpack8(*reinterpret_cast<const bf16x8*>(src), fa0); unpack8(*reinterpret_cast<const bf16x8*>(src + 8), fa1); unpack8(*reinterpret_cast<const bf16x8*>(src + 32), fb0); unpack8(*reinterpret_cast<const bf16x8*>(src + 40), fb1);
        ATT_SCALE8(fa0, rn, gp); ATT_SCALE8(fa1, rn, gp + 8); ATT_SCALE8(fb0, rn, gp + 32); ATT_SCALE8(fb1, rn, gp + 40);
        if (do_rope) { const float* cs = rope_tab; const float* sn = rope_tab + 128 * 32; const int p = s ? pc : pr;
          rope8(fa0, fb0, cs + p * 32 + 16 * hi, sn + p * 32 + 16 * hi); rope8(fa1, fb1, cs + p * 32 + 16 * hi + 8, sn + p * 32 + 16 * hi + 8); }
      }
      { typedef float v16f_q __attribute__((ext_vector_type(16))); v16f_q xa, xb;
#pragma unroll
        for (int i = 0; i < 8; ++i) { xa[i] = fa0[i]; xa[8 + i] = fa1[i]; xb[i] = fb0[i]; xb[8 + i] = fb1[i]; }
        const auto r6 = __builtin_amdgcn_cvt_scalef32_2xpk16_fp6_f32(xa, xb, 1.0f);
        q8[s] = (v8i){(int)r6[0], (int)r6[1], (int)r6[2], (int)r6[3], (int)r6[4], (int)r6[5], 0, 0}; }
    }
#undef ATT_SCALE8
  }
  asm volatile("s_waitcnt vmcnt(0)" ::: "memory");
  const int NT = seq / KVBLK;
  ATT_ISSUE(0, 0); ATT_ISSUE(1, KVBLK); ATT_ISSUE(2, 2 * KVBLK);
  f32x16 o[4] = {}; f32x16 lacc = {}; f32x4 lsum = {0.f, 0.f, 0.f, 0.f}; v8i_att bones;
  { int on = (((lane >> 3) & 1) == ((lane >> 4) & 1)) ? 0x38383838 : 0; asm volatile("" : "+v"(on)); bones = (v8i_att){on, on, on, on, on, on, on, on}; }
  constexpr int SA = STATIC ? 0x7c7c7c7c : 0x7a7a7a7a;
  const int cA_ = (2 * hi) ^ ((r32 >> 2) & 3), vd0 = (cA_ & 1) ? -16 : 16;
  const char* vb0 = V_lds + r32 * 64 + (cA_ << 4);
#define ATT_QK_SCHED() do { } while (0)
#define ATT_RESC(a) do { if (__any((a) < 1.f)) { if (hi == 0) al_l[r32] = (a); asm volatile("s_nop 15\n\ts_nop 15\n\ts_waitcnt lgkmcnt(0)" ::: "memory"); \
    _Pragma("unroll") for (int r = 0; r < 16; ++r) { const float a_ = al_l[crow(r, hi)]; _Pragma("unroll") for (int d = 0; d < 4; ++d) o[d][r] *= a_; if constexpr (MSUM) lacc[r] *= a_; } } } while (0)
  if constexpr (STATIC) {
  f32x16 p0, p1; v4i_att wa0, wa1, wb0, wb1;
  unsigned ka[2 * NS];
#pragma unroll
  for (int s_ = 0; s_ < NS; ++s_) { ka[2 * s_] = (unsigned)(size_t)ldsL + KOFF + kswz8<Cfg::RB>(r32, 4 * s_ + 2 * hi); ka[2 * s_ + 1] = (unsigned)(size_t)ldsL + KOFF + kswz8<Cfg::RB>(r32, 4 * s_ + 2 * hi + 1); }
  const unsigned va0 = (unsigned)(size_t)ldsL + r32 * 64 + (cA_ << 4), va1 = va0 + vd0;
  v8i fa, fb, fc;
#define ATT_BARX() do { __builtin_amdgcn_s_barrier(); asm volatile("" ::: "memory"); } while (0)
  ATT_WAITV_NV(); ATT_BAR();
  ATT_ISSUE_K(3, 3 * KVBLK);
  qkt<Cfg, SA>(p0, p1, K_lds, q8, negm, r32, hi);
  ATT_SBAR(); asm volatile("s_nop 15\n\ts_nop 15" ::: "memory"); ATT_SBAR();
  ATT_CVT8(p0, 0, wa0, 0); ATT_CVT8(p0, 8, wa0, 2); ATT_CVT8(p1, 0, wa1, 0); ATT_CVT8(p1, 8, wa1, 2);
  ATT_SBAR(); ATT_PRE(SHM_K);
  ATT_WAITV_NV(); ATT_BARX();
#define ATT_SSTEP(j, WP0, WP1, WC0, WC1) do { \
    if ((j) + 3 < NT) { ATT_ISSUE_K(((j) + 3) & 3, ((j) + 3) * KVBLK); } \
    { const int kbo = ((j) & 3) * SHM_K, vbo = (((j) - 1) & 3) * SHM_V, kbn = (((j) + 1) & 3) * SHM_K; const v4i_att& a0 = WP0; const v4i_att& a1 = WP1; v4i_att& w0 = WC0; v4i_att& w1 = WC1; \
      ATT_STEP_BODY(if ((j) + 2 < NT) { ATT_ISSUE_V(((j) + 2) & 3, ((j) + 2) * KVBLK); }, ATT_PRE(kbn)); } \
    if ((j) + 3 < NT) ATT_WAITV_NV(); else if ((j) + 2 < NT) asm volatile("s_waitcnt vmcnt(1)" ::: "memory"); else asm volatile("s_waitcnt vmcnt(0)" ::: "memory"); \
    ATT_BARX(); } while (0)
  for (int j = 1; j + 1 < NT; j += 2) {
    ATT_SSTEP(j, wa0, wa1, wb0, wb1);
    ATT_SSTEP(j + 1, wb0, wb1, wa0, wa1);
  }
  { const int kbo = ((NT - 1) & 3) * SHM_K, vbo = ((NT - 2) & 3) * SHM_V;
    { const v4i_att& a0 = wa0; const v4i_att& a1 = wa1; v4i_att& w0 = wb0; v4i_att& w1 = wb1;
      ATT_STEP_BODY((void)0, (void)0); }
    pv_cvt<false>(o, lsum, vb0 + ((NT - 1) & 3) * SHM_V, vd0, wb0, wb1, p0, p1, wa0, wa1, bones);
    ATT_SBAR(); asm volatile("s_nop 15\n\ts_nop 15" ::: "memory"); ATT_SBAR(); }
#undef ATT_BARX
#undef ATT_SSTEP
  } else {
  f32x16 pA0, pA1, pB0, pB1; float alA, alB; bf16x8 pa0, pa1, pa2, pa3;
  ATT_WAITV_2NV(); ATT_BAR();
  qkt<Cfg, SA>(pA0, pA1, K_lds, q8, negm, r32, hi); alA = 1.f; alB = 1.f; if constexpr (!STATIC) decideSM<true>(pA0, pA1, max2f(max3f(max8(pA0, 0), max8(pA0, 8), max8(pA1, 0)), max8(pA1, 8)), m_reg, negm, alA);
  ATT_WAITV_NV(); ATT_BAR();
  int bc = 1;
#define ATT_FIN(Y0, Y1, alY) do { if constexpr (STATIC) finishU8(Y0, Y1, pa0, pa1); else finishSM<true>(Y0, Y1, alY, l_reg, pa0, pa1, pa2, pa3); } while (0)
#define ATT_STEP(j, X0, X1, mnX, alX, Y0, Y1, alY) do { const int bp = bc == 0 ? 2 : bc - 1, bn = bc == 2 ? 0 : bc + 1; \
    ATT_SBAR(); qkt<Cfg, SA>(X0, X1, K_lds + bc * SHM_K, q8, negm, r32, hi); \
    ATT_FIN(Y0, Y1, alY); ATT_QK_SCHED(); ATT_SBAR(); \
    if ((j) >= 2 && (j) + 1 < NT) { ATT_ISSUE_V(bn, ((j) + 1) * KVBLK); }     \
    {  if constexpr (STATIC) { pv_d0(o, vb0 + bp * SHM_V, vd0, pa0, pa1, pa2, pa3); rowsum16(lsum, pa0, pa1, bones); } else { const float pm_ = pv_d0_max(o, vb0 + bp * SHM_V, vd0, pa0, pa1, pa2, pa3, X0, X1); decideSM<false>(X0, X1, pm_, m_reg, negm, alX); } } \
    if ((j) + 2 < NT) asm volatile("s_waitcnt vmcnt(1)" ::: "memory"); else asm volatile("s_waitcnt vmcnt(0)" ::: "memory");     \
    ATT_BAR();                                              \
    if ((j) + 2 < NT) { ATT_ISSUE_K(bp, ((j) + 2) * KVBLK); } \
    if constexpr (!STATIC) { ATT_RESC(alX); } bc = bn; } while (0)
  for (int j = 1; j + 1 < NT; j += 2) {
    ATT_STEP(j, pB0, pB1, mnB, alB, pA0, pA1, alA);
    ATT_STEP(j + 1, pA0, pA1, mnA, alA, pB0, pB1, alB);
  }
  { const int bp = bc == 0 ? 2 : bc - 1;
    ATT_SBAR(); qkt<Cfg, SA>(pB0, pB1, K_lds + bc * SHM_K, q8, negm, r32, hi);
    ATT_FIN(pA0, pA1, alA); ATT_SBAR();
    {  if constexpr (STATIC) { pv_d0(o, vb0 + bp * SHM_V, vd0, pa0, pa1, pa2, pa3); rowsum16(lsum, pa0, pa1, bones); } else { const float pm_ = pv_d0_max(o, vb0 + bp * SHM_V, vd0, pa0, pa1, pa2, pa3, pB0, pB1); decideSM<false>(pB0, pB1, pm_, m_reg, negm, alB); } }
    if constexpr (!STATIC) { ATT_RESC(alB); }
    ATT_FIN(pB0, pB1, alB); ATT_SBAR();
    pv_d0(o, vb0 + bc * SHM_V, vd0, pa0, pa1, pa2, pa3); if constexpr (STATIC) rowsum16(lsum, pa0, pa1, bones); ATT_SBAR(); asm volatile("s_nop 15\n\ts_nop 15" ::: "memory"); ATT_SBAR(); }
  }
  float rli[16];
  if constexpr (MSUM) {
#pragma unroll
    for (int r = 0; r < 16; ++r) rli[r] = __builtin_amdgcn_rcpf(lacc[r]);
  } else { if constexpr (STATIC) { if ((lane & 7) == 0) { float* dl = li_l + ((lane & 8) ? 16 : 0) + 4 * (lane >> 4); dl[0] = lsum[0]; dl[1] = lsum[1]; dl[2] = lsum[2]; dl[3] = lsum[3]; } }
    else { if (hi == 0) li_l[r32] = l_reg; }
    asm volatile("s_waitcnt lgkmcnt(0)" ::: "memory");
#pragma unroll
    for (int r = 0; r < 16; ++r) rli[r] = __builtin_amdgcn_rcpf(li_l[crow(r, hi)]); }
  bf16* Ow = Ob + (long)(wid * QBLK) * LDO;
  const int odd = lane & 1;
#pragma unroll
  for (int r = 0; r < 16; r += 2) {
#pragma unroll
    for (int d0 = 0; d0 < 4; ++d0) {
      const float v0 = o[d0][r] * rli[r], v1 = o[d0][r + 1] * rli[r + 1];
      const float snd = odd ? v0 : v1, rcv = att_shx(snd, lane, 1);
      const unsigned w = odd ? cvtpk(rcv, v1) : cvtpk(v0, rcv);
      const int orow = crow(odd ? r + 1 : r, hi);
      *reinterpret_cast<unsigned*>(Ow + (long)orow * LDO + d0 * 32 + (r32 & ~1)) = w; } }
  ATT_BAR();
#undef ATT_ISSUE
#undef ATT_WAITV_NV
#undef ATT_WAITV_2NV
#undef ATT_BAR
#undef ATT_RESC
#undef ATT_STEP
#undef ATT_FIN
#undef ATT_CVT8
#undef ATT_CVT16
#undef ATT_RK
#undef ATT_DSR
#undef ATT_LW
#undef ATT_RV
#undef ATT_QKM
#undef ATT_PVF
#undef ATT_STEP_BODY
#undef ATT_PRE
#undef ATT_CVT1
}
}

constexpr int D = 2048, BATCH = 2, SEQ = 8192, CTX = 256, DEPTH = 4, DFF = 5632;
constexpr int SB = SEQ + CTX;
constexpr int R = BATCH * SB;
constexpr int NMOD = 6 * D;
constexpr float EPS = 1e-6f;
constexpr int NWAVES = 8;
constexpr int PH_PER_LAYER = 11, N_PHASES = 1 + DEPTH * PH_PER_LAYER;

constexpr size_t MiB = 1u << 20;
constexpr size_t WS_CTL = 0, CTL_ZERO_BYTES = 1 * MiB;
constexpr size_t WS_MOD = 1 * MiB;
constexpr size_t WS_ROPE = 2 * MiB;
constexpr size_t WS_W = 4 * MiB;
constexpr size_t SZ_W1 = (size_t)1280 * 2048 * 2, SZ_WUQ = (size_t)3072 * 512 * 2, SZ_WUKV = (size_t)4096 * 512 * 2, SZ_WO = (size_t)2048 * 2048 * 2;
constexpr size_t SZ_WQKV = (size_t)3072 * 2048 * 2, SZ_WUP = (size_t)11264 * 2048 * 2, SZ_WDN = (size_t)2048 * 5632 * 2;
constexpr size_t SZ_MLA = SZ_W1 + SZ_WUQ + SZ_WUKV + SZ_WO, SZ_GQA = SZ_WQKV + SZ_WO, SZ_FFN = SZ_WUP + SZ_WDN;
constexpr size_t WS_WMLA = WS_W, WS_WGQA = WS_WMLA + 2 * SZ_MLA, WS_WFFN = WS_WGQA + 2 * SZ_GQA, WS_WEND = WS_WFFN + 4 * SZ_FFN;
static_assert(WS_WEND <= 376 * MiB, "weights");
constexpr size_t WS_X = 376 * MiB;
constexpr size_t WS_H = 508 * MiB;
constexpr size_t WS_BIG = 576 * MiB;
constexpr size_t WS_U = WS_BIG;
constexpr size_t WS_GH = WS_BIG, WS_VH = WS_BIG + 24 * MiB;
constexpr size_t WS_ACT = 940 * MiB;
constexpr size_t WS_RAW1 = WS_BIG;
constexpr size_t WS_CQ = 660 * MiB, WS_CKV = 677 * MiB, WS_KPE = 694 * MiB;
constexpr size_t WS_QRAW = 700 * MiB;
constexpr size_t WS_KVRAW = 800 * MiB;
constexpr size_t WS_KMLA = 932 * MiB;
constexpr size_t WS_QKV = WS_BIG;
constexpr size_t WS_KGQA = 676 * MiB;
constexpr size_t WS_OGQA = 700 * MiB;
constexpr size_t WS_END = 1124 * MiB;
static_assert(WS_X + (size_t)R * D * 4 <= WS_H && WS_H + (size_t)R * D * 2 <= WS_BIG && WS_GH + (size_t)264 * 4 * 5632 * 4 <= WS_VH && WS_VH + (size_t)264 * 2 * 5632 * 4 <= WS_ACT && WS_ACT + (size_t)R * DFF * 2 <= WS_END, "ws map 1");
static_assert(WS_RAW1 + (size_t)R * 1280 * 4 <= WS_CQ && WS_CQ + (size_t)R * 512 * 2 <= WS_CKV && WS_CKV + (size_t)R * 512 * 2 <= WS_KPE && WS_KPE + (size_t)R * 64 * 2 <= WS_QRAW, "ws map 2");
static_assert(WS_QRAW + (size_t)R * 3072 * 2 <= WS_KVRAW && WS_KVRAW + (size_t)R * 4096 * 2 <= WS_KMLA && WS_KMLA + (size_t)R * 3072 * 2 <= WS_END, "ws map 3");
static_assert(WS_QKV + (size_t)R * 3072 * 2 <= WS_KGQA && WS_KGQA + (size_t)R * 512 * 2 <= WS_OGQA && WS_OGQA + (size_t)R * 2048 * 2 <= WS_END, "ws map 4");
constexpr size_t WS_PART = 800 * MiB;
constexpr int NSPLIT_WO = 8, NSPLIT_DN = 11;
constexpr size_t WS_CB = 352 * MiB;
constexpr size_t WS_STAT = 354 * MiB;
constexpr size_t WS_AV = 355 * MiB;
constexpr size_t WS_W8GQA = 360 * MiB, SZ_W8GQA = (size_t)3072 * 2048;
constexpr size_t WS_V8T_MLA = 990 * MiB, WS_V8T_GQA = 780 * MiB;
constexpr size_t WS_XS8 = 720 * MiB;
constexpr int CBN = 11264;
static_assert(WS_KMLA + (size_t)R * 3072 <= WS_V8T_MLA && WS_V8T_MLA + (size_t)2 * 16 * 128 * 8448 <= WS_END && WS_OGQA + (size_t)R * 2048 * 2 <= WS_V8T_GQA && WS_V8T_GQA + (size_t)2 * 4 * 128 * 8448 <= WS_PART, "ws map 7");
static_assert(WS_W8GQA + 2 * SZ_W8GQA <= WS_X && WS_XS8 + (size_t)R * 2048 <= WS_PART, "ws map 6");
static_assert(WS_WEND <= WS_CB && WS_CB + (size_t)8 * 3 * CBN * 4 <= WS_STAT && WS_STAT + (size_t)8 * R * 4 <= WS_AV && WS_AV + (size_t)8 * 3 * D * 4 <= WS_X, "ws map 5");
constexpr int CW_BAR = 4096;

constexpr int RING_OFF = 0, RING_BYTES = 131072;
constexpr int LDSCTL_OFF = RING_BYTES, MISC_OFF = LDSCTL_OFF + 320;
constexpr int LDS_BYTES = 147456;

struct Args {
    const float* in[28]; float* out; unsigned char* ws; int ph_lo, ph_hi, var;
};

struct Frame {
    LAS unsigned char* lds; char* ldsg;
    int tid, lane, wave, G, gw, NGW, bid;
};

__device__ __forceinline__ float shx(float v, int lane, int o) { return __builtin_bit_cast(float, __builtin_amdgcn_ds_bpermute((lane ^ o) << 2, __builtin_bit_cast(int, v))); }
__device__ __forceinline__ float wave_sum(float v, int lane) {
#pragma unroll
    for (int o = 1; o < 64; o <<= 1) v += shx(v, lane, o);
    return v;
}
__device__ __forceinline__ float sum16(float v, int lane) {
#pragma unroll
    for (int o = 1; o < 16; o <<= 1) v += shx(v, lane, o);
    return v;
}
__device__ __forceinline__ unsigned pk2(float lo, float hi) { unsigned r; asm volatile("v_cvt_pk_bf16_f32 %0, %1, %2" : "=v"(r) : "v"(lo), "v"(hi)); return r; }
__device__ __forceinline__ float bf_lo(unsigned w) { return __uint_as_float(w << 16); }
__device__ __forceinline__ float bf_hi(unsigned w) { return __uint_as_float(w & 0xffff0000u); }
__device__ __forceinline__ float silu_f(float x) { return x / (1.f + __expf(-x)); }

__device__ __forceinline__ unsigned pk4f8(float a, float b, float c, float d) { int w = 0; w = __builtin_amdgcn_cvt_pk_fp8_f32(a, b, w, false); w = __builtin_amdgcn_cvt_pk_fp8_f32(c, d, w, true); return (unsigned)w; }
constexpr float W8_SCALE = 64.0f; constexpr int W8_E8M0 = 0x79797979;
__device__ __forceinline__ void transpose_item(const float* W, int K, int N, bf16* WT, int drow0, int k0, int n0, LAS float* scr, int lane, const float* shv, float* cacc, int f8 = 0, unsigned char* WT8 = nullptr) {
    { f32x4 r[8]; const int kr = lane >> 3, n4 = (lane & 7) * 4;
#pragma unroll
      for (int i = 0; i < 8; ++i) r[i] = *(const f32x4*)(W + (size_t)(k0 + 8 * i + kr) * N + n0 + n4);
      asm volatile("" ::: "memory");
#pragma unroll
      for (int i = 0; i < 8; ++i) { LAS float* d = scr + (8 * i + kr) * 33 + n4; d[0] = r[i].x; d[1] = r[i].y; d[2] = r[i].z; d[3] = r[i].w; } }
    LDS_WAIT(); asm volatile("" ::: "memory");
    const int c = lane & 7;
#pragma unroll
    for (int j = 0; j < 4; ++j) { const int n = (lane >> 3) + 8 * j; const LAS float* s = scr + (8 * c) * 33 + n;
        v4u o; o.x = pk2(s[0 * 33], s[1 * 33]); o.y = pk2(s[2 * 33], s[3 * 33]); o.z = pk2(s[4 * 33], s[5 * 33]); o.w = pk2(s[6 * 33], s[7 * 33]);
        if (f8) { v2u o8; o8.x = pk4f8(s[0 * 33] * W8_SCALE, s[1 * 33] * W8_SCALE, s[2 * 33] * W8_SCALE, s[3 * 33] * W8_SCALE); o8.y = pk4f8(s[4 * 33] * W8_SCALE, s[5 * 33] * W8_SCALE, s[6 * 33] * W8_SCALE, s[7 * 33] * W8_SCALE);
            *(v2u*)((f8 == 2 ? WT8 : (unsigned char*)WT) + (size_t)(drow0 + n) * K + k0 + 8 * c) = o8; }
        if (f8 != 1) *(v4u*)(WT + (size_t)(drow0 + n) * K + k0 + 8 * c) = o; }
    if (shv) {
        const float s0 = shv[k0 + lane], s1 = shv[NMOD + k0 + lane], s2 = shv[2 * NMOD + k0 + lane];
        const int n = lane & 31; float a0 = 0.f, a1 = 0.f, a2 = 0.f;
#pragma unroll 4
        for (int kk = 0; kk < 64; ++kk) { const float w = scr[kk * 33 + n];
            a0 = fmaf(__builtin_bit_cast(float, __builtin_amdgcn_readlane(__builtin_bit_cast(int, s0), kk)), w, a0);
            a1 = fmaf(__builtin_bit_cast(float, __builtin_amdgcn_readlane(__builtin_bit_cast(int, s1), kk)), w, a1);
            a2 = fmaf(__builtin_bit_cast(float, __builtin_amdgcn_readlane(__builtin_bit_cast(int, s2), kk)), w, a2); }
        if (lane < 32) { float* cp = cacc + drow0 + n; unsafeAtomicAdd(cp, a0); unsafeAtomicAdd(cp + CBN, a1); unsafeAtomicAdd(cp + 2 * CBN, a2); }
    }
    LDS_WAIT(); asm volatile("" ::: "memory");
}
__device__ __forceinline__ int dest_row(int mode, int roff, int n0) {
    if (mode == 1) { const int h = n0 / 192, d = n0 - h * 192; return d < 128 ? h * 128 + d : 2048 + h * 64 + (d - 128); }
    if (mode == 2) { const int h = n0 >> 8, d = n0 & 255; return d < 128 ? h * 128 + d : 2048 + h * 128 + (d - 128); }
    if (mode == 3) { const int f = n0 < 5632 ? n0 : n0 - 5632; return (f >> 7) * 256 + (f & 127) + (n0 < 5632 ? 0 : 128); }
    return roff + n0;
}
__device__ __forceinline__ void transpose_matrix(const Frame& F, const float* W, int K, int N, bf16* WT, int mode, int roff, int rot, const float* shv = nullptr, float* cacc = nullptr, int f8 = 0, unsigned char* WT8 = nullptr) {
    LAS float* scr = (LAS float*)(F.lds + RING_OFF + F.wave * 16384);
    const int nblk = N / 32, items = (K / 64) * nblk;
    int g = F.gw + rot; if (g >= F.NGW) g -= F.NGW;
    for (int it = g; it < items; it += F.NGW) { const int kb = it / nblk, nb = it - kb * nblk; transpose_item(W, K, N, WT, dest_row(mode, roff, nb * 32), kb * 64, nb * 32, scr, F.lane, shv, cacc, f8, WT8); }
}

typedef const __attribute__((address_space(4))) Args* KargPtr0;
__device__ __forceinline__ void p0a_prologue(const Frame& F, KargPtr0 ap) {
    unsigned char* ws = ap->ws;
    __syncthreads();
    {
        LAS float* S = (LAS float*)(F.lds + RING_OFF);
        LAS float* P = (LAS float*)(F.lds + RING_OFF + 24576);
        for (int i = F.tid; i < 3 * D; i += 512) { const int v = i / D, k = i - v * D; const float x = v < 2 ? ap->in[1][v * D + k] : ap->in[3][k]; S[i] = silu_f(x); }
        __syncthreads();
        for (int u = F.bid; u < 256; u += F.G) {
            const int l = u >> 6, n0 = (u & 63) * 192;
            const float* Wl = ap->in[4] + (size_t)l * D * NMOD + n0 + 4 * F.lane;
            f32x4 acc0 = {0.f, 0.f, 0.f, 0.f}, acc1 = acc0, acc2 = acc0;
            if (F.lane < 48) {
                const int kb = F.wave * 256;
#pragma unroll 8
                for (int k = 0; k < 256; ++k) { const f32x4 w = *(const f32x4*)(Wl + (size_t)(kb + k) * NMOD); acc0 += w * S[kb + k]; acc1 += w * S[D + kb + k]; acc2 += w * S[2 * D + kb + k]; }
#pragma unroll
                for (int j = 0; j < 4; ++j) { P[(F.wave * 3 + 0) * 192 + 4 * F.lane + j] = acc0[j]; P[(F.wave * 3 + 1) * 192 + 4 * F.lane + j] = acc1[j]; P[(F.wave * 3 + 2) * 192 + 4 * F.lane + j] = acc2[j]; }
            }
            __syncthreads();
            for (int i = F.tid; i < 576; i += 512) { const int v = i / 192, n = i - v * 192; float s = ap->in[5][(size_t)l * NMOD + n0 + n];
#pragma unroll
                for (int w = 0; w < 8; ++w) s += P[(w * 3 + v) * 192 + n];
                ((float*)(ws + WS_MOD))[(size_t)(l * 3 + v) * NMOD + n0 + n] = s; }
            __syncthreads();
        }
    }
    {
        float* T = (float*)(ws + WS_ROPE);
        for (int i = F.bid * 512 + F.tid; i < 128 * 16 + 128 * 32; i += F.G * 512) {
            int p, j, ad, base; if (i < 128 * 16) { p = i >> 4; j = i & 15; ad = 32; base = 0; } else { const int q = i - 128 * 16; p = q >> 5; j = q & 31; ad = 64; base = 2 * 128 * 16; }
            const float e = -(float)(2 * j) / (float)ad, inv = powf(10000.0f, e), ang = (float)p * inv;
            const int J = ad / 2;
            T[base + p * J + j] = cosf(ang); T[base + 128 * J + p * J + j] = sinf(ang);
        }
    }
    { const int gt = F.bid * 512 + F.tid, NT_ = F.G * 512; const v4u z = {0u, 0u, 0u, 0u};
      for (int i = gt; i < 8 * R / 4; i += NT_) ((v4u*)(ws + WS_STAT))[i] = z;
      for (int i = gt; i < 8 * 3 * CBN / 4; i += NT_) ((v4u*)(ws + WS_CB))[i] = z;
      for (int j = 0; j < 2; ++j) { bf16* w1 = (bf16*)(ws + WS_WMLA + j * SZ_MLA); for (int i = gt; i < 192 * 2048 / 8; i += NT_) *(v4u*)(w1 + (size_t)1088 * 2048 + (size_t)i * 8) = z; } }
}
__device__ __forceinline__ void p0b_prologue(const Frame& F, KargPtr0 ap, bool dummy_cb = false) {
    unsigned char* ws = ap->ws;
    const float* MOD = (const float*)(ws + WS_MOD);
    __syncthreads();
    for (int i = F.bid * 512 + F.tid; i < 8 * 3 * D; i += F.G * 512) { const int sl = i / (3 * D), r = i - sl * 3 * D, v = r / D, k = r - v * D, layer = sl >> 1, sub = sl & 1;
        const float g = (sub ? ap->in[7] : ap->in[6])[layer * D + k], sc = MOD[(size_t)(layer * 3 + v) * NMOD + (sub ? 4 : 1) * D + k];
        ((float*)(ws + WS_AV))[i] = g * (1.f + sc); }
    for (int row = F.gw; row < R; row += F.NGW) {
        const int b = row / SB, t = row - b * SB, v = t >= SEQ ? 2 : b;
        const float* src = t < SEQ ? ap->in[0] + ((size_t)b * SEQ + t) * D : ap->in[2] + ((size_t)b * CTX + (t - SEQ)) * D;
        float* dst = (float*)(ws + WS_X) + (size_t)row * D; bf16* xs = (bf16*)(ws + WS_H) + (size_t)row * D;
        const float* gn = ap->in[6]; const float* sc = MOD + (size_t)v * NMOD + D;
        float ss = 0.f;
#pragma unroll
        for (int j = 0; j < 8; ++j) { const int c = 4 * F.lane + 256 * j; const f32x4 x = *(const f32x4*)(src + c); *(f32x4*)(dst + c) = x;
            ss += (x.x * x.x + x.y * x.y) + (x.z * x.z + x.w * x.w);
            const f32x4 y = x * *(const f32x4*)(gn + c) * (*(const f32x4*)(sc + c) + 1.f);
            v2u o; o.x = pk2(y.x, y.y); o.y = pk2(y.z, y.w); *(v2u*)(xs + c) = o; }
        ss = wave_sum(ss, F.lane);
        if (F.lane == 0) ((float*)(ws + WS_STAT))[row] = ss;
    }
    __syncthreads();
    float* CB = (float*)(ws + (dummy_cb ? WS_ACT : WS_CB));
    int rot = 0;
    for (int j = 0; j < 2; ++j) { const int layer = 2 * j;
        bf16* w1 = (bf16*)(ws + WS_WMLA + j * SZ_MLA); bf16* wuq = (bf16*)((unsigned char*)w1 + SZ_W1); bf16* wukv = (bf16*)((unsigned char*)wuq + SZ_WUQ); bf16* wo = (bf16*)((unsigned char*)wukv + SZ_WUKV);
        const float* shv = MOD + (size_t)layer * 3 * NMOD; float* cacc = CB + (size_t)(2 * layer) * 3 * CBN;
        transpose_matrix(F, ap->in[8] + (size_t)j * 2048 * 512, 2048, 512, w1, 0, 0, rot, shv, cacc); rot = (rot + 512) % F.NGW;
        transpose_matrix(F, ap->in[13] + (size_t)j * 2048 * 576, 2048, 576, w1, 0, 512, rot, shv, cacc); rot = (rot + 576) % F.NGW;
        transpose_matrix(F, ap->in[10] + (size_t)j * 512 * 3072, 512, 3072, wuq, 1, 0, rot, nullptr, nullptr, 1); rot = (rot + 768) % F.NGW;
        transpose_matrix(F, ap->in[16] + (size_t)j * 512 * 4096, 512, 4096, wukv, 2, 0, rot); rot = (rot + 1024) % F.NGW;
        transpose_matrix(F, ap->in[18] + (size_t)j * 2048 * 2048, 2048, 2048, wo, 0, 0, rot);
    }
    for (int j = 0; j < 2; ++j) { const int layer = 2 * j + 1;
        bf16* wqkv = (bf16*)(ws + WS_WGQA + j * SZ_GQA); bf16* wo = (bf16*)((unsigned char*)wqkv + SZ_WQKV);
        const float* shv = MOD + (size_t)layer * 3 * NMOD; float* cacc = CB + (size_t)(2 * layer) * 3 * CBN;
        unsigned char* w8 = ws + WS_W8GQA + j * SZ_W8GQA;
        transpose_matrix(F, ap->in[19] + (size_t)j * 2048 * 2048, 2048, 2048, wqkv, 0, 0, rot, shv, cacc, 2, w8);
        transpose_matrix(F, ap->in[21] + (size_t)j * 2048 * 1024, 2048, 1024, wqkv, 0, 2048, rot, shv, cacc, 2, w8);
        transpose_matrix(F, ap->in[23] + (size_t)j * 2048 * 2048, 2048, 2048, wo, 0, 0, rot);
    }
    for (int l = 0; l < 4; ++l) {
        bf16* wup = (bf16*)(ws + WS_WFFN + l * SZ_FFN); bf16* wdn = (bf16*)((unsigned char*)wup + SZ_WUP);
        transpose_matrix(F, ap->in[24] + (size_t)l * 2048 * 11264, 2048, 11264, wup, 3, 0, rot, MOD + (size_t)l * 3 * NMOD + 3 * D, CB + (size_t)(2 * l + 1) * 3 * CBN);
        transpose_matrix(F, ap->in[27] + (size_t)l * 5632 * 2048, 5632, 2048, wdn, 0, 0, rot);
    }
}

__device__ __forceinline__ void ctx_finalize_phase(const Frame& F, float* X, bf16* XS, float* stat, const float* av, const float* P, int nsplit, unsigned char* XS8) {
    LAS float* red = (LAS float*)(F.lds + RING_OFF);
    for (int pr = F.bid; pr < CTX; pr += F.G) {
        const int q = pr * 2 + (F.wave >> 2), b = q >> 8, row = b * SB + SEQ + (q & 255), c0 = (F.wave & 3) * 512 + 4 * F.lane;
        const float* a = av + 2 * D;
        float* xr = X + (size_t)row * D + c0;
        f32x4 x0 = *(const f32x4*)xr, x1 = *(const f32x4*)(xr + 256);
        for (int s = 0; s < nsplit; ++s) { const float* pp = P + ((size_t)s * 512 + q) * D + c0; x0 += *(const f32x4*)pp; x1 += *(const f32x4*)(pp + 256); }
        *(f32x4*)xr = x0; *(f32x4*)(xr + 256) = x1;
        const float ssw = wave_sum((x0.x * x0.x + x0.y * x0.y) + (x0.z * x0.z + x0.w * x0.w) + (x1.x * x1.x + x1.y * x1.y) + (x1.z * x1.z + x1.w * x1.w), F.lane);
        if (F.lane == 0) red[F.wave] = ssw;
        const f32x4 y0 = x0 * *(const f32x4*)(a + c0), y1 = x1 * *(const f32x4*)(a + c0 + 256);
        bf16* hr = XS + (size_t)row * D + c0;
        v2u o0, o1; o0.x = pk2(y0.x, y0.y); o0.y = pk2(y0.z, y0.w); o1.x = pk2(y1.x, y1.y); o1.y = pk2(y1.z, y1.w);
        *(v2u*)hr = o0; *(v2u*)(hr + 256) = o1;
        if (XS8) { unsigned char* h8 = XS8 + (size_t)row * D + c0; *(unsigned*)h8 = pk4f8(y0.x, y0.y, y0.z, y0.w); *(unsigned*)(h8 + 256) = pk4f8(y1.x, y1.y, y1.z, y1.w); }
        __syncthreads();
        if ((F.wave & 3) == 0 && F.lane == 0) { const int w0 = F.wave; stat[row] = (red[w0] + red[w0 + 1]) + (red[w0 + 2] + red[w0 + 3]); }
        __syncthreads();
    }
}
__device__ __forceinline__ void mla_norm_phase(const Frame& F, const float* RAW, bf16* CQ, bf16* CKV, bf16* KPE, const float* g_dq, const float* g_dkv, const float* g_kpe, const float* ropeM) {
    for (int row = F.gw; row < R; row += F.NGW) {
        const int b = row / SB, t = row - b * SB;
        const float* rr = RAW + (size_t)row * 1280;
#pragma unroll
        for (int part = 0; part < 2; ++part) {
            const float* src = rr + part * 512 + 4 * F.lane; const float* g = (part ? g_dkv : g_dq) + 4 * F.lane; bf16* dst = (part ? CKV : CQ) + (size_t)row * 512 + 4 * F.lane;
            const f32x4 a0 = *(const f32x4*)src, a1 = *(const f32x4*)(src + 256);
            const float ss = wave_sum((a0.x * a0.x + a0.y * a0.y) + (a0.z * a0.z + a0.w * a0.w) + (a1.x * a1.x + a1.y * a1.y) + (a1.z * a1.z + a1.w * a1.w), F.lane);
            const float r = rsqrtf(ss * (1.f / 512.f) + EPS);
            const f32x4 y0 = a0 * r * *(const f32x4*)g, y1 = a1 * r * *(const f32x4*)(g + 256);
            if (part) { v2u o0, o1; o0.x = pk2(y0.x, y0.y); o0.y = pk2(y0.z, y0.w); o1.x = pk2(y1.x, y1.y); o1.y = pk2(y1.z, y1.w); *(v2u*)dst = o0; *(v2u*)(dst + 256) = o1; }
            else { unsigned char* d8 = (unsigned char*)CQ + (size_t)row * 512 + 4 * F.lane;
                *(unsigned*)d8 = pk4f8(y0.x, y0.y, y0.z, y0.w); *(unsigned*)(d8 + 256) = pk4f8(y1.x, y1.y, y1.z, y1.w); }
        }
        const int e = F.lane; const float x = rr[1024 + e];
        const float r = rsqrtf(wave_sum(x * x, F.lane) * (1.f / 64.f) + EPS);
        float y = x * r * g_kpe[e];
        const float yp = shx(y, F.lane, 16);
        if (t < SEQ) { const int j = e & 15, p = e < 32 ? (t >> 6) : (t & 63); const float c = ropeM[p * 16 + j], s = ropeM[128 * 16 + p * 16 + j];
            y = (e & 16) ? (y * c + yp * s) : (y * c - yp * s); }
        KPE[(size_t)row * 64 + e] = (bf16)(pk2(y, y) & 0xffffu);
    }
}
typedef float v16f_t __attribute__((ext_vector_type(16)));
typedef unsigned v6u_t __attribute__((ext_vector_type(6)));
constexpr float K6_SCALE = 2.0f;
__device__ __forceinline__ void st24(unsigned char* dst, const v6u_t& o) { v4u a; a.x = o[0]; a.y = o[1]; a.z = o[2]; a.w = o[3]; v2u b; b.x = o[4]; b.y = o[5]; *(v4u*)dst = a; *(v2u*)(dst + 16) = b; }
__device__ __forceinline__ void unpack16(const bf16* src, v16f_t& f) { const v4u w0 = *(const v4u*)src, w1 = *(const v4u*)(src + 8);
    f[0] = bf_lo(w0.x); f[1] = bf_hi(w0.x); f[2] = bf_lo(w0.y); f[3] = bf_hi(w0.y); f[4] = bf_lo(w0.z); f[5] = bf_hi(w0.z); f[6] = bf_lo(w0.w); f[7] = bf_hi(w0.w);
    f[8] = bf_lo(w1.x); f[9] = bf_hi(w1.x); f[10] = bf_lo(w1.y); f[11] = bf_hi(w1.y); f[12] = bf_lo(w1.z); f[13] = bf_hi(w1.z); f[14] = bf_lo(w1.w); f[15] = bf_hi(w1.w); }
__device__ __forceinline__ void mla_kbuild_phase(const Frame& F, const bf16* KVRAW, const bf16* KPE, unsigned char* K, const float* g_kn) {
    const int h = F.lane >> 2, blk = F.lane & 3;
    v16f_t ga, gb;
#pragma unroll
    for (int i = 0; i < 16; ++i) { ga[i] = g_kn[32 * blk + i]; gb[i] = g_kn[32 * blk + 16 + i]; }
    for (int row = F.gw; row < R; row += F.NGW) {
        v16f_t fa, fb; unpack16(KVRAW + (size_t)row * 4096 + h * 128 + 32 * blk, fa); unpack16(KVRAW + (size_t)row * 4096 + h * 128 + 32 * blk + 16, fb);
        float ss = 0.f;
#pragma unroll
        for (int i = 0; i < 16; ++i) ss += fa[i] * fa[i] + fb[i] * fb[i];
        ss += shx(ss, F.lane, 1); ss += shx(ss, F.lane, 2);
        const float r = rsqrtf(ss * (1.f / 128.f) + EPS) * K6_SCALE;
#pragma unroll
        for (int i = 0; i < 16; ++i) { fa[i] *= r * ga[i]; fb[i] *= r * gb[i]; }
        st24(K + (size_t)row * 3072 + h * 192 + 32 * blk, __builtin_amdgcn_cvt_scalef32_2xpk16_fp6_f32(fa, fb, 1.0f));
        if (F.lane < 32) { const int h2 = F.lane >> 1, b2 = F.lane & 1;
            v16f_t pa, pb; unpack16(KPE + (size_t)row * 64 + 32 * b2, pa); unpack16(KPE + (size_t)row * 64 + 32 * b2 + 16, pb);
#pragma unroll
            for (int i = 0; i < 16; ++i) { pa[i] *= K6_SCALE; pb[i] *= K6_SCALE; }
            st24(K + (size_t)row * 3072 + h2 * 192 + 128 + 32 * b2, __builtin_amdgcn_cvt_scalef32_2xpk16_fp6_f32(pa, pb, 1.0f)); }
    }
}
__device__ __forceinline__ void gqa_knorm_phase(const Frame& F, const bf16* QKV, unsigned char* K, const float* g_k, const float* ropeG) {
    const int blk = F.lane & 3, kh = (F.lane >> 2) & 3, rr = F.lane >> 4, s_ = blk >> 1, hi = blk & 1, da = 64 * s_ + 16 * hi, db = da + 32;
    v16f_t ga, gb;
#pragma unroll
    for (int i = 0; i < 16; ++i) { ga[i] = g_k[da + i]; gb[i] = g_k[db + i]; }
    for (int row0 = F.gw * 4; row0 < R; row0 += F.NGW * 4) {
        const int row = row0 + rr, b = row / SB, t = row - b * SB;
        const bf16* src = QKV + (size_t)row * 3072 + 2048 + kh * 128;
        v16f_t fa, fb; unpack16(src + da, fa); unpack16(src + db, fb);
        float ss = 0.f;
#pragma unroll
        for (int i = 0; i < 16; ++i) ss += fa[i] * fa[i] + fb[i] * fb[i];
        ss += shx(ss, F.lane, 1); ss += shx(ss, F.lane, 2);
        const float r = rsqrtf(ss * (1.f / 128.f) + EPS) * K6_SCALE;
#pragma unroll
        for (int i = 0; i < 16; ++i) { fa[i] *= r * ga[i]; fb[i] *= r * gb[i]; }
        if (t < SEQ) { const int p = s_ == 0 ? (t >> 6) : (t & 63); const float* cs = ropeG + p * 32 + 16 * hi; const float* sn = ropeG + 128 * 32 + p * 32 + 16 * hi;
#pragma unroll
            for (int i = 0; i < 16; ++i) { const float c = cs[i], sv = sn[i], x = fa[i], y = fb[i]; fa[i] = x * c - y * sv; fb[i] = y * c + x * sv; } }
        st24(K + (size_t)row * 512 + kh * 128 + 64 * s_ + 32 * hi, __builtin_amdgcn_cvt_scalef32_2xpk16_fp6_f32(fa, fb, 1.0f));
    }
}
__device__ __forceinline__ void tr4x4(unsigned a0, unsigned a1, unsigned a2, unsigned a3, unsigned* t) {
    const unsigned x0 = __builtin_amdgcn_perm(a1, a0, 0x05010400u), x1 = __builtin_amdgcn_perm(a1, a0, 0x07030602u), y0 = __builtin_amdgcn_perm(a3, a2, 0x05010400u), y1 = __builtin_amdgcn_perm(a3, a2, 0x07030602u);
    t[0] = __builtin_amdgcn_perm(y0, x0, 0x05040100u); t[1] = __builtin_amdgcn_perm(y0, x0, 0x07060302u); t[2] = __builtin_amdgcn_perm(y1, x1, 0x05040100u); t[3] = __builtin_amdgcn_perm(y1, x1, 0x07060302u);
}
__device__ __forceinline__ void v8t_items(const Frame& F, const bf16* Vsrc, int ldv, int vcol0, int nkv, unsigned char* V8T) {
    LAS unsigned char* scr = F.lds + RING_OFF + F.wave * 16384;
    const int l16 = F.lane & 15, kq = F.lane >> 4;
    for (int it = F.gw; it < BATCH * nkv * (SB / 64); it += F.NGW) {
        const int tile = it % (SB / 64), bh = it / (SB / 64), kvh = bh % nkv, b = bh / nkv;
        const bf16* src = Vsrc + (size_t)(b * SB + tile * 64 + 4 * kq) * ldv + vcol0 + kvh * 128 + l16 * 8;
        v4u wl[16];
#pragma unroll
        for (int i = 0; i < 16; ++i) wl[i] = *(const v4u*)(src + (size_t)(16 * (i >> 2) + (i & 3)) * ldv);
        asm volatile("" ::: "memory");
#pragma unroll
        for (int g = 0; g < 4; ++g) { unsigned lo[4], hi[4], t[8];
#pragma unroll
            for (int j = 0; j < 4; ++j) { const v4u w = wl[4 * g + j]; lo[j] = pk4f8(bf_lo(w.x), bf_hi(w.x), bf_lo(w.y), bf_hi(w.y)); hi[j] = pk4f8(bf_lo(w.z), bf_hi(w.z), bf_lo(w.w), bf_hi(w.w)); }
            tr4x4(lo[0], lo[1], lo[2], lo[3], t); tr4x4(hi[0], hi[1], hi[2], hi[3], t + 4);
            const int q = 4 * g + kq, sdw = 8 * (q & 1) + 4 * (q >> 3) + ((q & 7) >> 1);
            LAS unsigned* p = (LAS unsigned*)(scr + (l16 * 8) * 64 + 4 * sdw);
#pragma unroll
            for (int e = 0; e < 8; ++e) p[16 * e] = t[e]; }
        LDS_WAIT(); asm volatile("" ::: "memory");
#pragma unroll
        for (int k = 0; k < 8; ++k) { const int d = 16 * k + (F.lane >> 2), c = F.lane & 3;
            *(v4u*)(V8T + ((size_t)bh * 128 + d) * 8448 + tile * 64 + c * 16) = *(const LAS v4u*)(scr + d * 64 + c * 16); }
        LDS_WAIT(); asm volatile("" ::: "memory");
    }
}
__device__ __forceinline__ void conv_fix_phase(const Frame& F, const float* GH, const float* VH, bf16* ACT, const float* cw, const float* cb, bool skip_ctx) {
    constexpr int NCG = DFF / 512, NST = R / 64;
    for (int it = F.gw; it < NST * 2 * NCG; it += F.NGW) {
        const int cg = it % NCG, se = it / NCG, sid = se >> 1, lastedge = se & 1, f0 = cg * 512 + F.lane * 8;
        const int row = sid * 64 + (lastedge ? 63 : 0), t = row % SB;
        if (skip_ctx && t >= SEQ) continue;
        const bool zp = !lastedge && (t == 0 || t == SEQ), zn = lastedge && (t == SEQ - 1 || t == SB - 1);
        const float* gp = lastedge ? GH + ((size_t)sid * 4 + 2) * DFF : GH + ((size_t)sid * 4 - 1) * DFF;
        const float* gc = GH + ((size_t)sid * 4 + (lastedge ? 3 : 0)) * DFF;
        const float* gn = lastedge ? GH + ((size_t)sid * 4 + 4) * DFF : GH + ((size_t)sid * 4 + 1) * DFF;
        const float* vp = VH + ((size_t)sid * 2 + lastedge) * DFF;
        float o[8];
#pragma unroll
        for (int h = 0; h < 2; ++h) {
            const int f = f0 + 4 * h;
            const f32x4 z = {0.f, 0.f, 0.f, 0.f};
            const f32x4 p = zp ? z : *(const f32x4*)(gp + f), c = *(const f32x4*)(gc + f), n = zn ? z : *(const f32x4*)(gn + f), v = *(const f32x4*)(vp + f);
            const f32x4 w0 = *(const f32x4*)(cw + f), w1 = *(const f32x4*)(cw + DFF + f), w2 = *(const f32x4*)(cw + 2 * DFF + f), b = *(const f32x4*)(cb + f);
#pragma unroll
            for (int i = 0; i < 4; ++i) { const float a = fmaf(w0[i], p[i], fmaf(w1[i], c[i], fmaf(w2[i], n[i], b[i]))); o[4 * h + i] = a * __builtin_amdgcn_rcpf(1.f + __builtin_amdgcn_exp2f(a * -1.4426950408889634f)) * v[i]; }
        }
        v4u ow; ow.x = pk2(o[0], o[1]); ow.y = pk2(o[2], o[3]); ow.z = pk2(o[4], o[5]); ow.w = pk2(o[6], o[7]);
        *(v4u*)(ACT + (size_t)row * DFF + f0) = ow;
    }
}

#ifndef UP_PROBE
#define UP_PROBE 0
#endif
#ifndef PROBE_EXTRA
#define PROBE_EXTRA 0
#endif
#ifndef QKV8_N
#define QKV8_N 3072
#endif
#ifndef ATT_STATIC_MAX
#define ATT_STATIC_MAX 29
#endif
#ifndef ATT_FALLBACK
#define ATT_FALLBACK 1
#endif
template <class Cfg>
__device__ __forceinline__ void attention_phase(const Frame& F, const bf16* Q, const unsigned char* K, const unsigned char* V8T, bf16* O, const float* gq_n, const float* gq_p, const float* gk_n, const float* gk_p, const float* rope_tab, bool with_ctx, int var_in) {
    constexpr int QPE = Cfg::MLA ? 2048 : 0, KHD = Cfg::KROWB;
    float mbound;
    { float a = fmaxf(fabsf(gq_n[F.lane]), fabsf(gq_n[64 + F.lane])), b = fmaxf(fabsf(gk_n[F.lane]), fabsf(gk_n[64 + F.lane])), c = 0.f, d = 0.f;
      if constexpr (Cfg::MLA) { c = fabsf(gq_p[F.lane]); d = fabsf(gk_p[F.lane]); }
#pragma unroll
      for (int o = 1; o < 64; o <<= 1) { a = fmaxf(a, shx(a, F.lane, o)); b = fmaxf(b, shx(b, F.lane, o)); if constexpr (Cfg::MLA) { c = fmaxf(c, shx(c, F.lane, o)); d = fmaxf(d, shx(d, F.lane, o)); } }
      const float qn2 = 128.f * a * a + (Cfg::MLA ? 64.f * c * c : 0.f), kn2 = 128.f * b * b + (Cfg::MLA ? 64.f * d * d : 0.f);
      mbound = 1.20f * Cfg::SCALE * 1.4426950408889634f * sqrtf(qn2 * kn2) + 0.5f; }
    const bool use_static = __builtin_amdgcn_readfirstlane((mbound <= ATT_STATIC_MAX) ? 1 : 0) != 0;
    const int var = PROBE_EXTRA ? __builtin_amdgcn_readfirstlane(var_in) : 0;
    const int c = F.bid;
    const int nlat = (F.G == 256) ? 4 : (1024 - c + F.G - 1) / F.G;
    const int ntot = nlat + ((with_ctx && c < 32) ? 1 : 0);
    for (int i = 0; i < ntot; ++i) {
        int bh, qb, seq, t0; size_t row0, krow0;
        if (i < nlat) {
            if (F.G == 256) { bh = i * 8 + (c & 7); qb = c >> 3; }
            else { const int L = i * F.G + c; bh = L >> 5; qb = L & 31; }
            const int b = bh >> 4; row0 = (size_t)b * SB + qb * 256; krow0 = (size_t)b * SB; seq = SB; t0 = qb * 256;
        } else { bh = c; const int b = bh >> 4; row0 = (size_t)b * SB + SEQ; krow0 = row0; seq = CTX; t0 = -1; }
        const int h = bh & 15, kvh = Cfg::MLA ? h : (h >> 2), b_ = bh >> 4;
        if (use_static || !ATT_FALLBACK)
            att::attn_unit<Cfg, true>(Q + row0 * Cfg::LDQ + h * 128, Q + row0 * Cfg::LDQ + QPE + h * 64, K + krow0 * Cfg::LDK + kvh * KHD, V8T + (size_t)((b_ * (Cfg::MLA ? 16 : 4) + kvh) * 128) * Cfg::LDVT + (i < nlat ? 0 : SEQ),
                            O + row0 * Cfg::LDO + h * 128, seq, F.lds + RING_OFF, F.ldsg + RING_OFF, t0, gq_n, gq_p, rope_tab, mbound, F.wave, var);
        else
            att::attn_unit<Cfg, false>(Q + row0 * Cfg::LDQ + h * 128, Q + row0 * Cfg::LDQ + QPE + h * 64, K + krow0 * Cfg::LDK + kvh * KHD, V8T + (size_t)((b_ * (Cfg::MLA ? 16 : 4) + kvh) * 128) * Cfg::LDVT + (i < nlat ? 0 : SEQ),
                            O + row0 * Cfg::LDO + h * 128, seq, F.lds + RING_OFF, F.ldsg + RING_OFF, t0, gq_n, gq_p, rope_tab, mbound, F.wave, var);
    }
}

#ifndef REP_ATT
#define REP_ATT 1
#endif
#ifndef REP_GBF
#define REP_GBF 1
#endif
#ifndef REP_GRES
#define REP_GRES 1
#endif
#ifndef REP_THIN
#define REP_THIN 1
#endif
#ifndef REP_PRO
#define REP_PRO 1
#endif
#ifndef REP_CONV
#define REP_CONV 1
#endif
#ifndef REP_MOD
#define REP_MOD 1
#endif
#ifndef REP_BAR
#define REP_BAR 1
#endif
#ifndef EN_ATT_MLA
#define EN_ATT_MLA 1
#endif
#ifndef EN_ATT_GQA
#define EN_ATT_GQA 1
#endif
#ifndef EN_GEMM
#define EN_GEMM 63
#endif
#ifndef EN_THIN
#define EN_THIN 1
#endif
typedef const __attribute__((address_space(4))) Args* KargPtr;
__device__ __forceinline__ KargPtr kargs() { KargPtr p = (KargPtr)__builtin_amdgcn_kernarg_segment_ptr(); asm volatile("" : "+s"(p)); return p; }

__global__ void __launch_bounds__(NWAVES * 64, 2) fwd_kernel(Args args_unused) {
    extern __shared__ __attribute__((aligned(16))) unsigned char lds[];
#define MKFRAME() Frame F; { int t_; asm volatile("v_mbcnt_lo_u32_b32 %0, -1, 0\n\tv_mbcnt_hi_u32_b32 %0, -1, %0" : "=&v"(t_)); t_ |= wave_s << 6;     F.lds = (LAS unsigned char*)lds; F.ldsg = (char*)lds; F.tid = t_; F.lane = t_ & 63; F.wave = wave_s; \
    F.bid = blockIdx.x; asm volatile("" : "+s"(F.bid)); F.G = gridDim.x; F.gw = F.bid * NWAVES + F.wave; F.NGW = F.G * NWAVES; }
    LAS unsigned char* const ldsl = (LAS unsigned char*)lds;
    const int wave_s = __builtin_amdgcn_readfirstlane(threadIdx.x >> 6);
    for (int u = threadIdx.x; u < (LDS_BYTES - LDSCTL_OFF) / 4; u += NWAVES * 64) ((LAS unsigned*)(ldsl + LDSCTL_OFF))[u] = 0u;
    __syncthreads();
    const int lo = kargs()->ph_lo, hi = kargs()->ph_hi;
    if (hi - lo > 1) { MKFRAME(); (void)xcd_barrier_post((unsigned*)(kargs()->ws + WS_CTL) + CW_BAR, (volatile LAS unsigned*)(ldsl + MISC_OFF) + 8, F.tid); }
#define IN(k) (lo <= (k) && (k) < hi)
#define SEAM(k) do { if (IN(k) && IN((k) + 1)) { MKFRAME(); XcdBarrier bar_; bar_.tid = F.tid; bar_.bar = (unsigned*)(kargs()->ws + WS_CTL) + CW_BAR; bar_.x = xb_xcc_id(); bar_.st = (volatile LAS unsigned*)(ldsl + MISC_OFF) + 8; _Pragma("unroll 1") for (int rb_ = 0; rb_ < REP_BAR; ++rb_) xcd_barrier(bar_); } } while (0)
#define WSP(off) (kargs()->ws + (off))

    if (EN_THIN && IN(0)) { MKFRAME(); p0a_prologue(F, kargs()); } SEAM(0);

    for (int layer = 0; layer < DEPTH; ++layer) {
        const int pb = 1 + layer * PH_PER_LAYER, j = layer >> 1; const bool mla = (layer & 1) == 0, last = layer == DEPTH - 1;
        if (EN_THIN && IN(pb + 0)) { MKFRAME(); KargPtr a = kargs(); unsigned char* ws = a->ws;
            if (layer == 0) { if (REP_PRO > 1) p0b_prologue(F, a, true); p0b_prologue(F, a); }
            else ctx_finalize_phase(F, (float*)(ws + WS_X), (bf16*)(ws + WS_H), (float*)(ws + WS_STAT) + (size_t)(2 * layer) * R, (const float*)(ws + WS_AV) + (size_t)(2 * layer) * 3 * D, (const float*)(ws + WS_PART), NSPLIT_DN, mla ? nullptr : ws + WS_XS8); }
        SEAM(pb + 0);
        if (mla) {
            if ((EN_GEMM & 1) && IN(pb + 1)) {
                MKFRAME(); unsigned char* ws = WSP(0);
                pg8::Gemm g{(const bf16*)(ws + WS_H), (const bf16*)(ws + WS_WMLA + j * SZ_MLA), R, 1280, 2048}; pg8::PanelOrder S; S.init2(1280, 2048, F.G, F.bid, 0);
                pg8::EpiF32 E{(float*)(ws + WS_RAW1), 1280, (const float*)(ws + WS_STAT) + (size_t)(2 * layer) * R, (const float*)(ws + WS_CB) + (size_t)(2 * layer) * 3 * CBN};
                _Pragma("unroll 1") for (int rp_ = 0; rp_ < REP_GBF; ++rp_) pg8::gemm_phase<pg8::EpiF32, pg8::PanelOrder, true, true>(F.lds + RING_OFF, g, S, E, F.wave);
            }
            SEAM(pb + 1);
            if (EN_THIN && IN(pb + 2)) { MKFRAME(); KargPtr a = kargs(); unsigned char* ws = a->ws;
                _Pragma("unroll 1") for (int rp_ = 0; rp_ < REP_THIN; ++rp_) mla_norm_phase(F, (const float*)(ws + WS_RAW1), (bf16*)(ws + WS_CQ), (bf16*)(ws + WS_CKV), (bf16*)(ws + WS_KPE), a->in[9] + j * 512, a->in[14] + j * 512, a->in[15] + j * 64, (const float*)(ws + WS_ROPE)); }
            SEAM(pb + 2);
            if ((EN_GEMM & 2) && IN(pb + 3)) {
                { MKFRAME(); unsigned char* ws = WSP(0);
                  pg8::Gemm g{(const bf16*)(ws + WS_CQ), (const bf16*)(ws + WS_WMLA + j * SZ_MLA + SZ_W1), R, 3072, 256, W8_E8M0, 0x7f7f7f7f}; pg8::PanelOrder S; S.init2(3072, 256, F.G, F.bid, 0);
                  pg8::EpiBf16 E{(bf16*)(ws + WS_QRAW), 3072, nullptr, nullptr};
                  _Pragma("unroll 1") for (int rp_ = 0; rp_ < REP_GBF; ++rp_) pg8::gemm_phase<pg8::EpiBf16, pg8::PanelOrder, true, true, true>(F.lds + RING_OFF, g, S, E, F.wave); }
                { MKFRAME(); unsigned char* ws = WSP(0);
                  pg8::Gemm g{(const bf16*)(ws + WS_CKV), (const bf16*)(ws + WS_WMLA + j * SZ_MLA + SZ_W1 + SZ_WUQ), R, 4096, 512}; pg8::PanelOrder S; S.init2(4096, 512, F.G, F.bid, 0);
                  pg8::EpiBf16 E{(bf16*)(ws + WS_KVRAW), 4096, nullptr, nullptr};
                  _Pragma("unroll 1") for (int rp_ = 0; rp_ < REP_GBF; ++rp_) pg8::gemm_phase<pg8::EpiBf16, pg8::PanelOrder, true, true>(F.lds + RING_OFF, g, S, E, F.wave); }
            }
            SEAM(pb + 3);
            if (EN_THIN && IN(pb + 4)) { MKFRAME(); KargPtr a = kargs(); unsigned char* ws = a->ws; _Pragma("unroll 1") for (int rp_ = 0; rp_ < REP_THIN; ++rp_) { mla_kbuild_phase(F, (const bf16*)(ws + WS_KVRAW), (const bf16*)(ws + WS_KPE), (unsigned char*)(ws + WS_KMLA), a->in[17] + j * 128); v8t_items(F, (const bf16*)(ws + WS_KVRAW), 4096, 2048, 16, ws + WS_V8T_MLA); } }
            SEAM(pb + 4);
            if (EN_ATT_MLA && IN(pb + 5)) { MKFRAME(); KargPtr a = kargs(); unsigned char* ws = a->ws; __syncthreads();
                _Pragma("unroll 1") for (int rp_ = 0; rp_ < REP_ATT; ++rp_)
                attention_phase<att::CfgMLA>(F, (const bf16*)(ws + WS_QRAW), (const unsigned char*)(ws + WS_KMLA), (const unsigned char*)(ws + WS_V8T_MLA), (bf16*)(ws + WS_RAW1), a->in[11] + j * 128, a->in[12] + j * 64, a->in[17] + j * 128, a->in[15] + j * 64, (const float*)(ws + WS_ROPE), !last, PROBE_EXTRA ? a->var : 0); }
            SEAM(pb + 5);
        } else {
            if ((EN_GEMM & 4) && IN(pb + 1)) {
                { MKFRAME(); unsigned char* ws = WSP(0);
                  pg8::Gemm g{(const bf16*)(ws + WS_XS8), (const bf16*)(ws + WS_W8GQA + j * SZ_W8GQA), R, QKV8_N, 1024, W8_E8M0, 0x7f7f7f7f}; pg8::PanelOrder S; S.init2(QKV8_N, 1024, F.G, F.bid, 0);
                  pg8::EpiBf16 E{(bf16*)(ws + WS_QKV), 3072, (const float*)(ws + WS_STAT) + (size_t)(2 * layer) * R, (const float*)(ws + WS_CB) + (size_t)(2 * layer) * 3 * CBN};
                  pg8::gemm_phase<pg8::EpiBf16, pg8::PanelOrder, true, true, true>(F.lds + RING_OFF, g, S, E, F.wave); }
                if (QKV8_N == 2560) { MKFRAME(); unsigned char* ws = WSP(0);
                  pg8::Gemm g{(const bf16*)(ws + WS_H), (const bf16*)(ws + WS_WGQA + j * SZ_GQA) + (size_t)2560 * 2048, R, 512, 2048}; pg8::PanelOrder S; S.init2(512, 2048, F.G, F.bid, 0);
                  pg8::EpiBf16 E{(bf16*)(ws + WS_QKV) + 2560, 3072, (const float*)(ws + WS_STAT) + (size_t)(2 * layer) * R, (const float*)(ws + WS_CB) + (size_t)(2 * layer) * 3 * CBN + 2560};
                  pg8::gemm_phase<pg8::EpiBf16, pg8::PanelOrder, true, true>(F.lds + RING_OFF, g, S, E, F.wave); }
            }
            SEAM(pb + 1);
            if (EN_THIN && IN(pb + 2)) { MKFRAME(); KargPtr a = kargs(); unsigned char* ws = a->ws; _Pragma("unroll 1") for (int rp_ = 0; rp_ < REP_THIN; ++rp_) { gqa_knorm_phase(F, (const bf16*)(ws + WS_QKV), (unsigned char*)(ws + WS_KGQA), a->in[22] + j * 128, (const float*)(ws + WS_ROPE) + 2 * 128 * 16); v8t_items(F, (const bf16*)(ws + WS_QKV), 3072, 2560, 4, ws + WS_V8T_GQA); } }
            SEAM(pb + 2);
            if (EN_ATT_GQA && IN(pb + 5)) { MKFRAME(); KargPtr a = kargs(); unsigned char* ws = a->ws; __syncthreads();
                _Pragma("unroll 1") for (int rp_ = 0; rp_ < REP_ATT; ++rp_)
                attention_phase<att::CfgGQA>(F, (const bf16*)(ws + WS_QKV), (const unsigned char*)(ws + WS_KGQA), (const unsigned char*)(ws + WS_V8T_GQA), (bf16*)(ws + WS_OGQA), a->in[20] + j * 128, nullptr, a->in[22] + j * 128, nullptr, (const float*)(ws + WS_ROPE) + 2 * 128 * 16, !last, PROBE_EXTRA ? a->var : 0); }
            SEAM(pb + 5);
        }
        if ((EN_GEMM & 8) && IN(pb + 6)) {
            MKFRAME(); unsigned char* ws = WSP(0);
            const bf16* wo = mla ? (const bf16*)(ws + WS_WMLA + j * SZ_MLA + SZ_W1 + SZ_WUQ + SZ_WUKV) : (const bf16*)(ws + WS_WGQA + j * SZ_GQA + SZ_WQKV);
            const bf16* O = mla ? (const bf16*)(ws + WS_RAW1) : (const bf16*)(ws + WS_OGQA);
            pg8::Gemm g{O, wo, R, 2048, 2048}; pg8::ResOrder S; S.init2(2048, F.G, F.bid, last ? 0 : NSPLIT_WO);
            pg8::EpiRes E{(const float*)(ws + WS_X), (float*)(ws + WS_X), (const float*)(ws + WS_MOD) + (size_t)layer * 3 * NMOD + 2 * D, 0, (float*)(ws + WS_PART), 2048 / 64,
                          (bf16*)(ws + WS_H), (const float*)(ws + WS_AV) + (size_t)(2 * layer + 1) * 3 * D, (float*)(ws + WS_STAT) + (size_t)(2 * layer + 1) * R, nullptr};
            pg8::gemm_phase<pg8::EpiRes, pg8::ResOrder, true, true>(F.lds + RING_OFF, g, S, E, F.wave);
        }
        SEAM(pb + 6);
        if (EN_THIN && IN(pb + 7) && !last) { MKFRAME(); KargPtr a = kargs(); unsigned char* ws = a->ws;
            ctx_finalize_phase(F, (float*)(ws + WS_X), (bf16*)(ws + WS_H), (float*)(ws + WS_STAT) + (size_t)(2 * layer + 1) * R, (const float*)(ws + WS_AV) + (size_t)(2 * layer + 1) * 3 * D, (const float*)(ws + WS_PART), NSPLIT_WO, nullptr); }
        if (!last) SEAM(pb + 7);
        if ((EN_GEMM & 16) && IN(pb + 8)) {
            MKFRAME(); KargPtr ka_ = kargs(); unsigned char* ws = ka_->ws;
            pg8::Gemm g{(const bf16*)(ws + WS_H), (const bf16*)(ws + WS_WFFN + layer * SZ_FFN), R, 11264, 2048}; pg8::PanelOrder S; S.init2(11264, 2048, F.G, F.bid, last ? 1 : 0);
            pg8::EpiConv E{(bf16*)(ws + WS_ACT), (float*)(ws + WS_GH), (float*)(ws + WS_VH), ka_->in[25] + (size_t)layer * 3 * DFF, ka_->in[26] + (size_t)layer * DFF,
                           (const float*)(ws + WS_STAT) + (size_t)(2 * layer + 1) * R, (const float*)(ws + WS_CB) + (size_t)(2 * layer + 1) * 3 * CBN};
            if (UP_PROBE == 1) { pg8::EpiConv E2 = E; pg8::gemm_phase<pg8::EpiConv, pg8::PanelOrder, true, true>(F.lds + RING_OFF, g, S, E2, F.wave); }
            if (UP_PROBE == 2) { pg8::EpiBf16 E3{(bf16*)(ws + WS_PART), 11264, nullptr, nullptr}; pg8::gemm_phase<pg8::EpiBf16, pg8::PanelOrder, true, true>(F.lds + RING_OFF, g, S, E3, F.wave); }
            _Pragma("unroll 1") for (int rp_ = 0; rp_ < REP_GBF; ++rp_) pg8::gemm_phase<pg8::EpiConv, pg8::PanelOrder, true, true>(F.lds + RING_OFF, g, S, E, F.wave);
        }
        SEAM(pb + 8);
        if (EN_THIN && IN(pb + 9)) { MKFRAME(); KargPtr a = kargs(); _Pragma("unroll 1") for (int rp_ = 0; rp_ < REP_CONV; ++rp_) conv_fix_phase(F, (const float*)(a->ws + WS_GH), (const float*)(a->ws + WS_VH), (bf16*)(a->ws + WS_ACT), a->in[25] + (size_t)layer * 3 * DFF, a->in[26] + (size_t)layer * DFF, last); }
        SEAM(pb + 9);
        if ((EN_GEMM & 32) && IN(pb + 10)) {
            MKFRAME(); KargPtr a = kargs(); unsigned char* ws = a->ws;
            pg8::Gemm g{(const bf16*)(ws + WS_ACT), (const bf16*)(ws + WS_WFFN + layer * SZ_FFN + SZ_WUP), R, 2048, 5632}; pg8::ResOrder S; S.init2(5632, F.G, F.bid, last ? 0 : NSPLIT_DN);
            pg8::EpiRes E{(const float*)(ws + WS_X), last ? a->out : (float*)(ws + WS_X), (const float*)(ws + WS_MOD) + (size_t)layer * 3 * NMOD + 5 * D, last ? 1 : 0, (float*)(ws + WS_PART), 5632 / 64,
                          (bf16*)(ws + WS_H), (const float*)(ws + WS_AV) + (size_t)(last ? 0 : 2 * layer + 2) * 3 * D, last ? nullptr : (float*)(ws + WS_STAT) + (size_t)(2 * layer + 2) * R, (!last && mla) ? ws + WS_XS8 : nullptr};
            pg8::gemm_phase<pg8::EpiRes, pg8::ResOrder, true, true>(F.lds + RING_OFF, g, S, E, F.wave);
        }
        SEAM(pb + 10);
    }
#undef IN
#undef SEAM
#undef WSP
}

#ifndef PROBE_EXTRA
#define PROBE_EXTRA 0
#endif
#ifndef PROBE_VAR
#define PROBE_VAR 0
#endif
#ifndef MK_PER_PHASE
#define MK_PER_PHASE 0
#endif
extern "C" void kernel_launch(void* const* d_in, const int* in_sizes, int n_in, void* d_out, int out_size, void* d_ws, size_t ws_size, hipStream_t stream) {
    static int grid = 0;
    if (grid == 0) {
        if (n_in != 28 || out_size != BATCH * SEQ * D || ws_size < WS_END) { fprintf(stderr, "kernel_launch: unexpected shapes: n_in %d out %d ws %zu (need %zu)\n", n_in, out_size, ws_size, (size_t)WS_END); grid = -1; return; }
        int dev = 0, cus = 0;
        if (hipGetDevice(&dev) != hipSuccess || hipDeviceGetAttribute(&cus, hipDeviceAttributeMultiprocessorCount, dev) != hipSuccess) { grid = -1; return; }
        if (hipFuncSetAttribute((const void*)fwd_kernel, hipFuncAttributeMaxDynamicSharedMemorySize, LDS_BYTES) != hipSuccess) { fprintf(stderr, "kernel_launch: hipFuncSetAttribute failed\n"); grid = -1; return; }
        int per_cu = 0;
        if (hipOccupancyMaxActiveBlocksPerMultiprocessor(&per_cu, (const void*)fwd_kernel, NWAVES * 64, LDS_BYTES) != hipSuccess || per_cu < 1) { fprintf(stderr, "kernel_launch: occupancy query says %d\n", per_cu); }
        (void)hipGetLastError();
        grid = cus;
    }
    if (grid < 0) return;
    (void)hipMemsetAsync((char*)d_ws + WS_CTL, 0, CTL_ZERO_BYTES, stream);
    Args a{};
    for (int i = 0; i < 28; ++i) a.in[i] = (const float*)d_in[i];
    a.out = (float*)d_out; a.ws = (unsigned char*)d_ws;
#if MK_PER_PHASE
    for (int ph = 0; ph < N_PHASES; ++ph) {
        if (ph >= 1) { const int l = (ph - 1) / PH_PER_LAYER, s = (ph - 1) % PH_PER_LAYER; if ((l & 1) && (s == 3 || s == 4)) continue; }
        a.ph_lo = ph; a.ph_hi = ph + 1;
        hipLaunchKernelGGL(fwd_kernel, dim3(grid), dim3(NWAVES * 64), LDS_BYTES, stream, a);
    }
#else
    a.ph_lo = 0; a.ph_hi = N_PHASES; a.var = 0;
    hipLaunchKernelGGL(fwd_kernel, dim3(grid), dim3(NWAVES * 64), LDS_BYTES, stream, a);
#if PROBE_EXTRA
    for (int l = 0; l < 4; ++l) for (int sl = 0; sl < PH_PER_LAYER; ++sl) if ((PROBE_EXTRA >> sl) & 1) { if ((l & 1) && (sl == 3 || sl == 4)) continue; a.ph_lo = 1 + l * PH_PER_LAYER + sl; a.ph_hi = a.ph_lo + 1; a.var = PROBE_VAR;
        hipLaunchKernelGGL(fwd_kernel, dim3(grid), dim3(NWAVES * 64), LDS_BYTES, stream, a); }
#endif
#endif
    const hipError_t le = hipPeekAtLastError();
    if (le != hipSuccess) fprintf(stderr, "kernel_launch: launch failed: %s\n", hipGetErrorName(le));
}
```
